# Optimizing an MI355X kernel written in HIP

```python
import math
import jax, jax.numpy as jnp
from jax import lax
import numpy as np

D_MODEL = 1024
BATCH = 4
SEQ = 8192
DEPTH = 2

DN_ALPHA = (2 * DEPTH) ** 0.25
DN_BETA = (8 * DEPTH) ** -0.25
LN_EPS = 1e-5

CONV_WIDTH = D_MODEL // 2
CONV_GROUPS = 8
CONV_TAPS = 3
LRU_WIDTH = D_MODEL // 2
LRU_HEADS = 8
LRU_HEAD_DIM = LRU_WIDTH // LRU_HEADS
LRU_CONV_TAPS = 4
LRU_C = 8.0
L0_IN_COLS = 3 * CONV_WIDTH + 2 * LRU_WIDTH

N_HEADS = 16
HEAD_DIM = 64
N_KV_GROUPS = 4
HEADS_PER_GROUP = N_HEADS // N_KV_GROUPS
KV_WIDTH = N_KV_GROUPS * HEAD_DIM
CMP_STRIDE = 16
CMP_BLOCK = 2 * CMP_STRIDE
CMP_HIDDEN = 256
SEL_BLOCK = 64
N_SEL = 16
WINDOW = 512
Q_BLOCK = 128
ROPE_THETA = 10000.0
L1_IN_COLS = N_HEADS * HEAD_DIM + 6 * KV_WIDTH + 3 * N_HEADS
FORCE = 1e4
NEG = -1e30
TINY = 1e-30

N_GROUPS = 4
EXPERTS_PER_GROUP = 8
N_EXPERTS = N_GROUPS * EXPERTS_PER_GROUP
TOP_K = 2
EXPERT_FF = 512
MOE_BLOCK = 256

kernel_name = "hybrid_conv_rglru_nsa_hiermoe_deepnorm"

F32 = jnp.float32


def _layernorm(x, g, b):
    xf = x.astype(F32)
    mu = jnp.mean(xf, -1, keepdims=True)
    var = jnp.mean(jnp.square(xf - mu), -1, keepdims=True)
    y = (xf - mu) * lax.rsqrt(var + LN_EPS)
    return (y * g.astype(F32) + b.astype(F32)).astype(x.dtype)


def _causal_dwconv(x, w):
    taps, S = w.shape[0], x.shape[1]
    xp = jnp.pad(x, ((0, 0), (taps - 1, 0), (0, 0)))
    y = xp[:, 0:S] * w[0]
    for k in range(1, taps):
        y = y + xp[:, k:k + S] * w[k]
    return y


def _rglru(xc, w_a, b_a, w_x, b_x, lam):
    Bn, S, C = xc.shape
    xh = xc.reshape(Bn, S, LRU_HEADS, LRU_HEAD_DIM)
    r = jax.nn.sigmoid((jnp.einsum('bshi,hij->bshj', xh, w_a).reshape(Bn, S, C) + b_a).astype(F32))
    i = jax.nn.sigmoid((jnp.einsum('bshi,hij->bshj', xh, w_x).reshape(Bn, S, C) + b_x).astype(F32))
    log_a = -LRU_C * r * jax.nn.softplus(-lam.astype(F32))
    a = jnp.exp(log_a)
    mult = jnp.sqrt(jnp.maximum(-jnp.expm1(2.0 * log_a), 0.0))
    u = mult * i * xc.astype(F32)

    def comb(left, right):
        a1, b1 = left
        a2, b2 = right
        return a1 * a2, a2 * b1 + b2

    _, h = lax.associative_scan(comb, (a, u), axis=1)
    return h.astype(xc.dtype)


def _even_mixer(x, w_in, conv_w, lru_conv_w, lru_conv_b, w_a, b_a, w_x, b_x, lam, w_out):
    z = x @ w_in
    W = CONV_WIDTH
    bg, cg, hc, gate, xl = jnp.split(z, [W, 2 * W, 3 * W, 3 * W + LRU_WIDTH], axis=-1)
    y_conv = bg * _causal_dwconv(cg * hc, conv_w)
    xc = _causal_dwconv(xl, lru_conv_w) + lru_conv_b
    y_lru = _rglru(xc, w_a, b_a, w_x, b_x, lam) * jax.nn.gelu(gate)
    return jnp.concatenate([y_conv, y_lru], axis=-1) @ w_out


def _rope(x, cos, sin):
    xf = x.astype(F32)
    x1, x2 = jnp.split(xf, 2, axis=-1)
    c = cos[None, :, None, :]
    s = sin[None, :, None, :]
    return jnp.concatenate([x1 * c - x2 * s, x2 * c + x1 * s], axis=-1).astype(x.dtype)


def _masked_softmax(s, mask):
    s = jnp.where(mask, s, NEG)
    s = s - jnp.max(s, axis=-1, keepdims=True)
    p = jnp.exp(s) * mask
    return p / jnp.maximum(jnp.sum(p, axis=-1, keepdims=True), TINY)


def _compress(k, pe, w1, w2):
    Bn, S, G, dk = k.shape
    ch = k.reshape(Bn, S // CMP_STRIDE, CMP_STRIDE, G, dk)
    blocks = jnp.concatenate([ch[:, :-1], ch[:, 1:]], axis=2)
    blocks = blocks + pe[None, None, :, None, :]
    flat = blocks.transpose(0, 1, 3, 2, 4).reshape(Bn, blocks.shape[1], G, CMP_BLOCK * dk)
    return jax.nn.gelu(flat @ w1) @ w2


def _nsa_mixer(x, w_in, cmp_k_pe, cmp_k_w1, cmp_k_w2, cmp_v_pe, cmp_v_w1, cmp_v_w2, w_out):
    Bn, S, _ = x.shape
    G, R, dk = N_KV_GROUPS, HEADS_PER_GROUP, HEAD_DIM
    z = x @ w_in
    qd = N_HEADS * HEAD_DIM
    cuts = [qd + j * KV_WIDTH for j in range(7)]
    q, kc, vc, ks, vs, kw, vw, gl = jnp.split(z, cuts, axis=-1)
    q = q.reshape(Bn, S, N_HEADS, dk)
    kc, vc, ks, vs, kw, vw = [t.reshape(Bn, S, G, dk) for t in (kc, vc, ks, vs, kw, vw)]

    pos = jnp.arange(S, dtype=F32)
    inv = ROPE_THETA ** (-jnp.arange(0, dk, 2, dtype=F32) / dk)
    ang = pos[:, None] * inv[None, :]
    cos, sin = jnp.cos(ang), jnp.sin(ang)
    q = _rope(q, cos, sin)
    kc = _rope(kc, cos, sin)
    ks = _rope(ks, cos, sin)
    kw = _rope(kw, cos, sin)
    gates = jax.nn.sigmoid(gl.astype(F32)).reshape(Bn, S, G, R, 3)

    kcmp = _compress(kc, cmp_k_pe, cmp_k_w1, cmp_k_w2)
    vcmp = _compress(vc, cmp_v_pe, cmp_v_w1, cmp_v_w2)
    n_cmp = kcmp.shape[1]
    n_slc = S // SEL_BLOCK
    n_top = min(N_SEL, n_slc)
    ksb = ks.reshape(Bn, n_slc, SEL_BLOCK, G, dk).transpose(0, 3, 1, 2, 4)
    vsb = vs.reshape(Bn, n_slc, SEL_BLOCK, G, dk).transpose(0, 3, 1, 2, 4)
    kwp = jnp.pad(kw, ((0, 0), (WINDOW, 0), (0, 0), (0, 0)))
    vwp = jnp.pad(vw, ((0, 0), (WINDOW, 0), (0, 0), (0, 0)))

    c_start = jnp.arange(n_cmp) * CMP_STRIDE
    j_idx = jnp.arange(n_slc)
    j_start = j_idx * SEL_BLOCK
    overlap = ((c_start[:, None] < j_start[None, :] + SEL_BLOCK)
               & (c_start[:, None] + CMP_BLOCK > j_start[None, :])).astype(F32)
    scale = HEAD_DIM ** -0.5
    bidx = jnp.arange(Bn)[:, None, None, None]
    gidx = jnp.arange(G)[None, :, None, None]

    def block(qi):
        qs = qi * Q_BLOCK
        t = qs + jnp.arange(Q_BLOCK)
        qb = lax.dynamic_slice_in_dim(q, qs, Q_BLOCK, 1).reshape(Bn, Q_BLOCK, G, R, dk)
        gb = lax.dynamic_slice_in_dim(gates, qs, Q_BLOCK, 1)
        s_c = jnp.einsum('bqgrd,bcgd->bgrqc', qb, kcmp).astype(F32) * scale
        m_c = (c_start + CMP_BLOCK - 1)[None, :] <= t[:, None]
        p_c = _masked_softmax(s_c, m_c)
        o_c = jnp.einsum('bgrqc,bcgd->bqgrd', p_c.astype(x.dtype), vcmp)
        imp = jnp.einsum('bgrqc,cj->bgqj', p_c, overlap)
        bt = t // SEL_BLOCK
        forced = ((j_idx[None, :] == 0) | (j_idx[None, :] == bt[:, None])
                  | (j_idx[None, :] == bt[:, None] - 1))
        future = j_idx[None, :] > bt[:, None]
        imp = jnp.where(forced, FORCE, jnp.where(future, -FORCE, imp))
        _, sel = lax.top_k(imp, n_top)
        ksel = ksb[bidx, gidx, sel]
        vsel = vsb[bidx, gidx, sel]
        s_s = jnp.einsum('bqgrd,bgqnkd->bgrqnk', qb, ksel).astype(F32) * scale
        kpos = sel[..., None] * SEL_BLOCK + jnp.arange(SEL_BLOCK)
        m_s = (kpos <= t[None, None, :, None, None]).reshape(Bn, G, 1, Q_BLOCK, n_top * SEL_BLOCK)
        p_s = _masked_softmax(s_s.reshape(Bn, G, R, Q_BLOCK, n_top * SEL_BLOCK), m_s)
        p_s = p_s.reshape(Bn, G, R, Q_BLOCK, n_top, SEL_BLOCK).astype(x.dtype)
        o_s = jnp.einsum('bgrqnk,bgqnkd->bqgrd', p_s, vsel)
        kwb = lax.dynamic_slice_in_dim(kwp, qs, WINDOW + Q_BLOCK, 1)
        vwb = lax.dynamic_slice_in_dim(vwp, qs, WINDOW + Q_BLOCK, 1)
        wpos = qs - WINDOW + jnp.arange(WINDOW + Q_BLOCK)
        m_w = ((wpos[None, :] <= t[:, None]) & (wpos[None, :] > t[:, None] - WINDOW)
               & (wpos[None, :] >= 0))
        s_w = jnp.einsum('bqgrd,bkgd->bgrqk', qb, kwb).astype(F32) * scale
        p_w = _masked_softmax(s_w, m_w).astype(x.dtype)
        o_w = jnp.einsum('bgrqk,bkgd->bqgrd', p_w, vwb)
        o = gb[..., 0:1] * o_c + gb[..., 1:2] * o_s + gb[..., 2:3] * o_w
        return o.astype(x.dtype).reshape(Bn, Q_BLOCK, N_HEADS * dk)

    out = lax.map(block, jnp.arange(S // Q_BLOCK))
    out = out.transpose(1, 0, 2, 3).reshape(Bn, S, N_HEADS * dk)
    return out @ w_out


def _hier_moe(x, w_rg, b_rg, w_re, b_re, w_gate, w_up, w_down):
    Bn, S, D = x.shape
    T = Bn * S
    xf = x.reshape(T, D)
    tok_ar = jnp.arange(T)
    lg = (xf @ w_rg).astype(F32) + b_rg.astype(F32)
    pg = jax.nn.softmax(lg, axis=-1)
    g_star = jnp.argmax(lg, axis=-1)
    p_grp = pg[tok_ar, g_star][:, None]
    le = ((xf @ w_re).astype(F32) + b_re.astype(F32)).reshape(T, N_GROUPS, EXPERTS_PER_GROUP)
    pe = jax.nn.softmax(le[tok_ar, g_star], axis=-1)
    v, idx = lax.top_k(pe, TOP_K)
    w = p_grp * v / jnp.sum(v, axis=-1, keepdims=True)
    e = g_star[:, None] * EXPERTS_PER_GROUP + idx

    A = T * TOP_K
    e_flat = e.reshape(A)
    w_flat = w.reshape(A)
    tok = jnp.repeat(tok_ar, TOP_K)
    order = jnp.argsort(e_flat)
    e_s, tok_s, w_s = e_flat[order], tok[order], w_flat[order]
    counts = jnp.bincount(e_flat, length=N_EXPERTS)
    starts = jnp.cumsum(counts) - counts
    padded = (counts + MOE_BLOCK - 1) // MOE_BLOCK * MOE_BLOCK
    pad_end = jnp.cumsum(padded)
    pad_start = pad_end - padded
    dest = pad_start[e_s] + jnp.arange(A) - starts[e_s]
    n_blocks = -(-A // MOE_BLOCK) + N_EXPERTS
    P = n_blocks * MOE_BLOCK
    xs = jnp.zeros((P, D), x.dtype).at[dest].set(xf[tok_s])
    block_e = jnp.minimum(jnp.searchsorted(pad_end, jnp.arange(n_blocks) * MOE_BLOCK, side='right'),
                          N_EXPERTS - 1)

    def expert_block(args):
        xb, eb = args
        h = jax.nn.silu(xb @ w_gate[eb]) * (xb @ w_up[eb])
        return h @ w_down[eb]

    ys = lax.map(expert_block, (xs.reshape(n_blocks, MOE_BLOCK, D), block_e)).reshape(P, D)
    y = jnp.zeros((T, D), x.dtype).at[tok_s].add(ys[dest] * w_s[:, None].astype(x.dtype))
    return y.reshape(Bn, S, D)


def _moe_params(key, prefix):
    k = jax.random.split(key, 7)
    D = D_MODEL
    return {
        prefix + "router_group_w": jax.random.normal(k[0], (D, N_GROUPS), F32) * D ** -0.5,
        prefix + "router_group_b": jax.random.normal(k[1], (N_GROUPS,), F32) * 0.01,
        prefix + "router_expert_w": jax.random.normal(k[2], (D, N_EXPERTS), F32) * D ** -0.5,
        prefix + "router_expert_b": jax.random.normal(k[3], (N_EXPERTS,), F32) * 0.01,
        prefix + "expert_w_gate": jax.random.normal(k[4], (N_EXPERTS, D, EXPERT_FF), F32) * D ** -0.5,
        prefix + "expert_w_up": jax.random.normal(k[5], (N_EXPERTS, D, EXPERT_FF), F32) * D ** -0.5,
        prefix + "expert_w_down": jax.random.normal(k[6], (N_EXPERTS, EXPERT_FF, D), F32)
        * (EXPERT_FF ** -0.5 * DN_BETA),
    }


def _ln_params(key, prefix):
    k1, k2 = jax.random.split(key)
    return {prefix + "_g": 1.0 + 0.02 * jax.random.normal(k1, (D_MODEL,), F32),
            prefix + "_b": 0.02 * jax.random.normal(k2, (D_MODEL,), F32)}


def setup_inputs(seed: int = 0) -> dict:
    key = jax.random.key(seed)
    ks = jax.random.split(key, 32)
    D = D_MODEL
    p = {}
    p["x"] = jax.random.normal(ks[0], (BATCH, SEQ, D), F32)
    p["l0_w_in"] = jax.random.normal(ks[1], (D, L0_IN_COLS), F32) * D ** -0.5
    p["l0_conv_w"] = jax.random.normal(ks[2], (CONV_TAPS, CONV_WIDTH), F32) * CONV_TAPS ** -0.5
    p["l0_lru_conv_w"] = jax.random.normal(ks[3], (LRU_CONV_TAPS, LRU_WIDTH), F32) * LRU_CONV_TAPS ** -0.5
    p["l0_lru_conv_b"] = jax.random.normal(ks[4], (LRU_WIDTH,), F32) * 0.01
    p["l0_lru_w_a"] = jax.random.normal(ks[5], (LRU_HEADS, LRU_HEAD_DIM, LRU_HEAD_DIM), F32) * LRU_HEAD_DIM ** -0.5
    p["l0_lru_b_a"] = jax.random.normal(ks[6], (LRU_WIDTH,), F32) * 0.01
    p["l0_lru_w_x"] = jax.random.normal(ks[7], (LRU_HEADS, LRU_HEAD_DIM, LRU_HEAD_DIM), F32) * LRU_HEAD_DIM ** -0.5
    p["l0_lru_b_x"] = jax.random.normal(ks[8], (LRU_WIDTH,), F32) * 0.01
    u = jax.random.uniform(ks[9], (LRU_WIDTH,), F32, minval=0.9, maxval=0.999)
    a0 = u ** (1.0 / LRU_C)
    p["l0_lru_lambda"] = jnp.log(a0) - jnp.log1p(-a0)
    p["l0_w_out"] = jax.random.normal(ks[10], (CONV_WIDTH + LRU_WIDTH, D), F32) * (D ** -0.5 * DN_BETA)
    p.update(_ln_params(ks[11], "l0_ln1"))
    p.update(_moe_params(ks[12], "l0_"))
    p.update(_ln_params(ks[13], "l0_ln2"))
    ones_kv = jnp.ones((KV_WIDTH,), F32)
    beta_kv = jnp.full((KV_WIDTH,), DN_BETA, F32)
    col_scale = jnp.concatenate([jnp.ones((N_HEADS * HEAD_DIM,), F32), ones_kv, beta_kv, ones_kv, beta_kv,
                                 ones_kv, beta_kv, jnp.ones((3 * N_HEADS,), F32)])
    p["l1_w_in"] = jax.random.normal(ks[14], (D, L1_IN_COLS), F32) * (D ** -0.5) * col_scale[None, :]
    p["l1_cmp_k_pe"] = jax.random.normal(ks[15], (CMP_BLOCK, HEAD_DIM), F32) * 0.02
    p["l1_cmp_k_w1"] = jax.random.normal(ks[16], (CMP_BLOCK * HEAD_DIM, CMP_HIDDEN), F32) * (CMP_BLOCK * HEAD_DIM) ** -0.5
    p["l1_cmp_k_w2"] = jax.random.normal(ks[17], (CMP_HIDDEN, HEAD_DIM), F32) * CMP_HIDDEN ** -0.5
    p["l1_cmp_v_pe"] = jax.random.normal(ks[18], (CMP_BLOCK, HEAD_DIM), F32) * 0.02
    p["l1_cmp_v_w1"] = jax.random.normal(ks[19], (CMP_BLOCK * HEAD_DIM, CMP_HIDDEN), F32) * (CMP_BLOCK * HEAD_DIM) ** -0.5
    p["l1_cmp_v_w2"] = jax.random.normal(ks[20], (CMP_HIDDEN, HEAD_DIM), F32) * CMP_HIDDEN ** -0.5
    p["l1_w_out"] = jax.random.normal(ks[21], (N_HEADS * HEAD_DIM, D), F32) * (D ** -0.5 * DN_BETA)
    p.update(_ln_params(ks[22], "l1_ln1"))
    p.update(_moe_params(ks[23], "l1_"))
    p.update(_ln_params(ks[24], "l1_ln2"))
    return p


def reference(x,
              l0_w_in, l0_conv_w, l0_lru_conv_w, l0_lru_conv_b, l0_lru_w_a, l0_lru_b_a, l0_lru_w_x,
              l0_lru_b_x, l0_lru_lambda, l0_w_out, l0_ln1_g, l0_ln1_b,
              l0_router_group_w, l0_router_group_b, l0_router_expert_w, l0_router_expert_b,
              l0_expert_w_gate, l0_expert_w_up, l0_expert_w_down, l0_ln2_g, l0_ln2_b,
              l1_w_in, l1_cmp_k_pe, l1_cmp_k_w1, l1_cmp_k_w2, l1_cmp_v_pe, l1_cmp_v_w1, l1_cmp_v_w2,
              l1_w_out, l1_ln1_g, l1_ln1_b,
              l1_router_group_w, l1_router_group_b, l1_router_expert_w, l1_router_expert_b,
              l1_expert_w_gate, l1_expert_w_up, l1_expert_w_down, l1_ln2_g, l1_ln2_b):
    mixers = (
        lambda h: _even_mixer(h, l0_w_in, l0_conv_w, l0_lru_conv_w, l0_lru_conv_b, l0_lru_w_a, l0_lru_b_a,
                              l0_lru_w_x, l0_lru_b_x, l0_lru_lambda, l0_w_out),
        lambda h: _nsa_mixer(h, l1_w_in, l1_cmp_k_pe, l1_cmp_k_w1, l1_cmp_k_w2, l1_cmp_v_pe, l1_cmp_v_w1,
                             l1_cmp_v_w2, l1_w_out),
    )
    norms1 = ((l0_ln1_g, l0_ln1_b), (l1_ln1_g, l1_ln1_b))
    norms2 = ((l0_ln2_g, l0_ln2_b), (l1_ln2_g, l1_ln2_b))
    moes = ((l0_router_group_w, l0_router_group_b, l0_router_expert_w, l0_router_expert_b,
             l0_expert_w_gate, l0_expert_w_up, l0_expert_w_down),
            (l1_router_group_w, l1_router_group_b, l1_router_expert_w, l1_router_expert_b,
             l1_expert_w_gate, l1_expert_w_up, l1_expert_w_down))
    for layer in range(DEPTH):
        x = _layernorm(DN_ALPHA * x + mixers[layer](x), *norms1[layer])
        x = _layernorm(DN_ALPHA * x + _hier_moe(x, *moes[layer]), *norms2[layer])
    return x
```

```cpp
#include <hip/hip_runtime.h>
#include <hip/hip_cooperative_groups.h>
#include <cstdio>
#include <cstdint>
#include <cmath>
namespace cg = cooperative_groups;

#define LAS __attribute__((address_space(3)))
#define DI __device__ __forceinline__
typedef unsigned short bf16_t;
typedef short bf16x8 __attribute__((ext_vector_type(8)));
typedef short s16x4 __attribute__((ext_vector_type(4)));
typedef float f32x2 __attribute__((ext_vector_type(2)));
typedef float f32x4 __attribute__((ext_vector_type(4)));
typedef float f32x16 __attribute__((ext_vector_type(16)));
typedef unsigned u32x2 __attribute__((ext_vector_type(2)));
typedef unsigned u32x4 __attribute__((ext_vector_type(4)));

constexpr int NB = 4, SEQ = 8192, T = NB * SEQ, D = 1024;
constexpr int L0N = 2560;
constexpr int L1N = 2608, L1NP = 2816;
constexpr int NEXP = 32, FF = 512;
constexpr float DN_ALPHA = 1.4142135623730951f;
constexpr float LN_EPS = 1e-5f;
constexpr int NWAVES = 8, NTHR = 512;
constexpr int NCMP = 512;

constexpr size_t MiB = 1u << 20;
constexpr size_t WS_CTL = 0;
constexpr size_t WS_COS = 1 * MiB, WS_SIN = 2 * MiB;
constexpr size_t WS_SMALL = 3 * MiB;
constexpr size_t SM_LRUBT = 0;
constexpr size_t SM_CBIAS = 256 * 1024;
constexpr size_t SM_RWT = 320 * 1024;
constexpr size_t WS_W0IN = 4 * MiB, WS_W0OUT = 9 * MiB, WS_W1IN = 11 * MiB, WS_W1OUT = 17 * MiB;
constexpr size_t WS_WC1 = 19 * MiB;
constexpr size_t WS_WC2 = 21 * MiB;
constexpr size_t WS_LIST = 22 * MiB;
constexpr size_t WS_WSLOT = 26 * MiB;
constexpr size_t WS_SCAN = 27 * MiB;
constexpr size_t WS_WGU0 = 32 * MiB, WS_WD0 = 96 * MiB, WS_WGU1 = 128 * MiB, WS_WD1 = 192 * MiB;
constexpr size_t WS_ACT = 224 * MiB;
constexpr size_t WS_XB = WS_ACT;
constexpr size_t WS_Z = WS_ACT + 64 * MiB;
constexpr size_t WS_H = WS_ACT + 64 * MiB;
constexpr size_t WS_Y = WS_ACT + 136 * MiB;
constexpr size_t WS_Q = WS_ACT + 64 * MiB;
constexpr size_t WS_KV = WS_ACT + 128 * MiB;
constexpr size_t KV_STRIDE = 17 * MiB;
constexpr size_t WS_GATES = WS_ACT + 232 * MiB;
constexpr size_t WS_CMPH = WS_ACT + 240 * MiB;
constexpr size_t WS_CMPO = WS_ACT + 248 * MiB;
constexpr size_t WS_END = WS_ACT + 264 * MiB;
constexpr int CW_CNT = 64;

DI unsigned f2bf(float f) { unsigned u = __builtin_bit_cast(unsigned, f); return (u + 0x7fffu + ((u >> 16) & 1u)) >> 16; }
DI unsigned pk2(float lo, float hi) { return f2bf(lo) | (f2bf(hi) << 16); }
DI float bf2f(unsigned short b) { return __builtin_bit_cast(float, (unsigned)b << 16); }
DI float bflo(unsigned w) { return __builtin_bit_cast(float, w << 16); }
DI float bfhi(unsigned w) { return __builtin_bit_cast(float, w & 0xffff0000u); }
DI unsigned cvt_pk_bf16(float lo, float hi) { unsigned r; asm volatile("v_cvt_pk_bf16_f32 %0, %1, %2" : "=v"(r) : "v"(lo), "v"(hi)); return r; }
DI float wave_sum(float v) {
#pragma unroll
    for (int o = 1; o < 64; o <<= 1) v += __shfl_xor(v, o);
    return v;
}
DI float sigmoidf_(float x) { return 1.0f / (1.0f + __expf(-x)); }
DI float gelu_tanh(float x) { const float u = 0.7978845608028654f * (x + 0.044715f * x * x * x); return x / (1.0f + __expf(-2.0f * u)); }
#define LDS_WAIT() asm volatile("s_waitcnt lgkmcnt(0)" ::: "memory")

namespace pg8 {
constexpr int BM = 256, BK = 64, HALF = 128, HTB = HALF * BK * 2, STAGE_BYTES = 8 * HTB;
__host__ __device__ __forceinline__ int lds_byte(int r, int c) { const int st = (r >> 4) * 2 + (c >> 5), rr = r & 15, cc = c & 31, ob = rr * 64 + cc * 2; return st * 1024 + (ob ^ (((ob >> 9) & 1) << 5)); }
__host__ __device__ __forceinline__ void stage_rc(int b, int& R, int& C) { const int st = b / 1024, sb = b % 1024, swz = sb ^ (((sb >> 9) & 1) << 5); R = (st >> 1) * 16 + swz / 64; C = (st & 1) * 32 + (swz % 64) / 2; }
__host__ __device__ __forceinline__ int perm32(int rho) { const int n = rho >> 4, i = rho & 15; return 8 * (i >> 2) + 4 * n + (i & 3); }
struct GU { int pm, pn, e; };
template <class P>
__device__ __forceinline__ void gemm_phase(LAS unsigned char* lds, const P& p) {
    const int tid = threadIdx.x, wid = __builtin_amdgcn_readfirstlane(tid >> 6), lane = tid & 63, wr = wid >> 2, wc = wid & 3, fr = lane & 15, fq = lane >> 4;
    const int nt = p.K / BK;
    int Rr[2]; unsigned Cc2[2], voffB[2];
#pragma unroll
    for (int i = 0; i < 2; ++i) { int R, C; stage_rc(tid * 16 + i * 8192, R, C); const int Rb = P::PERM ? ((R & ~31) + perm32(R & 31)) : R;
        Rr[i] = R; Cc2[i] = (unsigned)C * 2u; voffB[i] = (unsigned)Rb * p.ldb2 + (unsigned)C * 2u; }
    const size_t kstep = (size_t)(BK * 2);
    const size_t hstepB = (size_t)HALF * p.ldb2;
    const unsigned ldsw = (unsigned)wid * 1024u;
    const int aoff = lds_byte(wr * 64 + fr, fq * 8), boff = lds_byte(wc * 32 + fr, fq * 8);
#define PG8_SA(b, h) (((b) * 2 + (h)) * HTB)
#define PG8_SB(b, h) ((4 + (b) * 2 + (h)) * HTB)
#define PG8_STAGE(bufoff, gbase, voff) do { _Pragma("unroll") for (int _i = 0; _i < 2; ++_i) \
        __builtin_amdgcn_global_load_lds((const unsigned*)((const char*)(gbase) + (voff)[_i]), (LAS unsigned*)(lds + (bufoff) + ldsw + _i * 8192), 16, 0, 0); } while (0)
#define PG8_LDA(dst, b, h) do { _Pragma("unroll") for (int m = 0; m < 4; ++m) _Pragma("unroll") for (int k = 0; k < 2; ++k) dst[m][k] = *(const LAS bf16x8*)(lds + PG8_SA(b, h) + aoff + m * 2048 + k * 1024); } while (0)
#define PG8_LDB(dst, b, h) do { _Pragma("unroll") for (int n = 0; n < 2; ++n) _Pragma("unroll") for (int k = 0; k < 2; ++k) dst[n][k] = *(const LAS bf16x8*)(lds + PG8_SB(b, h) + boff + n * 2048 + k * 1024); } while (0)
#define PG8_MMA(ai, bj, At, Bt) do { __builtin_amdgcn_s_setprio(1); _Pragma("unroll") for (int m = 0; m < 4; ++m) _Pragma("unroll") for (int n = 0; n < 2; ++n) _Pragma("unroll") for (int k = 0; k < 2; ++k) \
        acc[ai][bj][m][n] = __builtin_amdgcn_mfma_f32_16x16x32_bf16(Bt[n][k], At[m][k], acc[ai][bj][m][n], 0, 0, 0); __builtin_amdgcn_s_setprio(0); } while (0)
#define PG8_WAIT_V(n) asm volatile("s_waitcnt vmcnt(" #n ")" ::: "memory")
#define PG8_WAIT_L(n) asm volatile("s_waitcnt lgkmcnt(" #n ")" ::: "memory")
#define PG8_BAR __builtin_amdgcn_s_barrier()
#define PG8_SCHED __builtin_amdgcn_sched_barrier(0)
    GU cur, nxt; int ui = 0;
    if (!p.next(0, cur)) return;
    f32x4 acc[2][2][4][2];
#pragma unroll
    for (int a = 0; a < 2; ++a)
#pragma unroll
        for (int b = 0; b < 2; ++b)
#pragma unroll
            for (int m = 0; m < 4; ++m)
#pragma unroll
                for (int n = 0; n < 2; ++n) acc[a][b][m][n] = (f32x4){0.f, 0.f, 0.f, 0.f};
    bf16x8 At[4][2], B0[2][2], B1[2][2];
    unsigned cA0[2], cA1[2], nA0[2], nA1[2];
#pragma unroll
    for (int i = 0; i < 2; ++i) { cA0[i] = p.a_row_off(cur, Rr[i]) + Cc2[i]; cA1[i] = p.a_row_off(cur, HALF + Rr[i]) + Cc2[i]; }
    const char* const Ab = p.A;
    const char* cB = p.b_tile(cur);
    PG8_STAGE(PG8_SB(0, 0), cB, voffB); PG8_STAGE(PG8_SB(0, 1), cB + hstepB, voffB); PG8_STAGE(PG8_SA(0, 0), Ab, cA0); PG8_STAGE(PG8_SA(0, 1), Ab, cA1);
    if (wr == 1) PG8_BAR;
    PG8_WAIT_V(2); PG8_BAR;
    PG8_STAGE(PG8_SB(1, 0), cB + kstep, voffB); PG8_STAGE(PG8_SA(1, 0), Ab + kstep, cA0); PG8_STAGE(PG8_SB(1, 1), cB + hstepB + kstep, voffB);
    PG8_WAIT_V(6); PG8_BAR;
    for (;;) {
        const bool has_next = p.next(ui + 1, nxt);
        const char* nB = has_next ? p.b_tile(nxt) : cB;
#pragma unroll
        for (int i = 0; i < 2; ++i) { nA0[i] = has_next ? p.a_row_off(nxt, Rr[i]) + Cc2[i] : cA0[i]; nA1[i] = has_next ? p.a_row_off(nxt, HALF + Rr[i]) + Cc2[i] : cA1[i]; }
        for (int t = 0; t < nt; t += 2) {
            const bool last = (t == nt - 2);
            const char* a1 = Ab + (size_t)(t + 1) * kstep;
            const char* a2 = last ? Ab : Ab + (size_t)(t + 2) * kstep; const char* b2 = last ? nB : cB + (size_t)(t + 2) * kstep;
            const char* a3 = a2 + kstep; const char* b3 = b2 + kstep;
            unsigned o0[2], o1[2];
#pragma unroll
            for (int i = 0; i < 2; ++i) { o0[i] = last ? nA0[i] : cA0[i]; o1[i] = last ? nA1[i] : cA1[i]; }
            PG8_LDB(B0, 0, 0); PG8_LDB(B1, 0, 1); PG8_SCHED; PG8_LDA(At, 0, 0); PG8_STAGE(PG8_SA(1, 1), a1, cA1);
            PG8_WAIT_V(8); PG8_WAIT_L(0); PG8_BAR; PG8_MMA(0, 0, At, B0); PG8_MMA(0, 1, At, B1); PG8_BAR; PG8_SCHED;
            PG8_LDA(At, 0, 1); PG8_STAGE(PG8_SB(0, 0), b2, voffB); PG8_STAGE(PG8_SB(0, 1), b2 + hstepB, voffB); PG8_STAGE(PG8_SA(0, 0), a2, o0);
            PG8_WAIT_V(8); PG8_WAIT_L(0); PG8_BAR; PG8_MMA(1, 0, At, B0); PG8_MMA(1, 1, At, B1); PG8_BAR; PG8_SCHED;
            PG8_LDB(B0, 1, 0); PG8_LDB(B1, 1, 1); PG8_SCHED; PG8_LDA(At, 1, 0); PG8_STAGE(PG8_SA(0, 1), a2, o1);
            PG8_WAIT_V(8); PG8_WAIT_L(0); PG8_BAR; PG8_MMA(0, 0, At, B0); PG8_MMA(0, 1, At, B1); PG8_BAR; PG8_SCHED;
            PG8_LDA(At, 1, 1); PG8_STAGE(PG8_SB(1, 0), b3, voffB); PG8_STAGE(PG8_SB(1, 1), b3 + hstepB, voffB); PG8_STAGE(PG8_SA(1, 0), a3, o0);
            PG8_WAIT_V(8); PG8_WAIT_L(0); PG8_BAR; PG8_MMA(1, 0, At, B0); PG8_MMA(1, 1, At, B1); PG8_BAR; PG8_SCHED;
        }
        if (wr == 0) PG8_BAR;
        p.epi(acc, cur, wr, wc, fr, fq);
        if (!has_next) break;
#pragma unroll
        for (int a = 0; a < 2; ++a)
#pragma unroll
            for (int b = 0; b < 2; ++b)
#pragma unroll
                for (int m = 0; m < 4; ++m)
#pragma unroll
                    for (int n = 0; n < 2; ++n) acc[a][b][m][n] = (f32x4){0.f, 0.f, 0.f, 0.f};
        cur = nxt; cB = nB; ++ui;
#pragma unroll
        for (int i = 0; i < 2; ++i) { cA0[i] = nA0[i]; cA1[i] = nA1[i]; }
        if (wr == 1) PG8_BAR;
    }
    PG8_WAIT_V(0);
    PG8_BAR;
#undef PG8_SA
#undef PG8_SB
#undef PG8_STAGE
#undef PG8_LDA
#undef PG8_LDB
#undef PG8_MMA
#undef PG8_WAIT_V
#undef PG8_WAIT_L
#undef PG8_BAR
#undef PG8_SCHED
}
struct TileOrder {
    int nM, nN, nwg, G, c;
    __device__ void init(int M, int N, int G_, int c_) { nM = M / BM; nN = N / BM; nwg = nM * nN; G = G_; c = c_; }
    __device__ bool next(int i, GU& u) const {
        const long L = (long)i * G + c; if (L >= nwg) return false;
        int wgid = (int)L; { const int q = nwg / 8, r = nwg % 8, xcd = wgid % 8, off = wgid / 8; wgid = (xcd < r ? xcd * (q + 1) : r * (q + 1) + (xcd - r) * q) + off; }
        const int WGM = 8; const int nig = WGM * nN, gid = wgid / nig, fm = gid * WGM, gsz = (nM - fm) < WGM ? (nM - fm) : WGM;
        u.pm = fm + ((wgid % nig) % gsz); u.pn = (wgid % nig) / gsz; u.e = 0; return true;
    }
};
}
using pg8::GU;

struct Args { const float* in[41]; float* out; unsigned char* ws; int ph_lo, ph_hi; };

struct GemmPlain {
    static constexpr bool PERM = true;
    const char* A; int K; unsigned lda2, ldb2; const char* Bt; pg8::TileOrder ord;
    bf16_t* C; int ldc;
    DI bool next(int i, GU& u) const { return ord.next(i, u); }
    DI unsigned a_row_off(const GU& u, int r) const { return (unsigned)(u.pm * 256 + r) * lda2; }
    DI const char* b_tile(const GU& u) const { return Bt + (size_t)u.pn * 256 * ldb2; }
    DI void epi(const f32x4 (&acc)[2][2][4][2], const GU& u, int wr, int wc, int fr, int fq) const {
        const int row0 = u.pm * 256 + wr * 64 + fr, col0 = u.pn * 256 + wc * 32 + 8 * fq;
#pragma unroll
        for (int ai = 0; ai < 2; ++ai)
#pragma unroll
            for (int m = 0; m < 4; ++m) { bf16_t* rowp = C + (size_t)(row0 + ai * 128 + m * 16) * ldc + col0;
#pragma unroll
                for (int bj = 0; bj < 2; ++bj) { const f32x4 v0 = acc[ai][bj][m][0], v1 = acc[ai][bj][m][1];
                    u32x4 w; w.x = cvt_pk_bf16(v0[0], v0[1]); w.y = cvt_pk_bf16(v0[2], v0[3]); w.z = cvt_pk_bf16(v1[0], v1[1]); w.w = cvt_pk_bf16(v1[2], v1[3]);
                    *(u32x4*)(rowp + bj * 128) = w; } }
    }
};
struct GemmResid {
    static constexpr bool PERM = false;
    const char* A; int K; unsigned lda2, ldb2; const char* Bt; pg8::TileOrder ord;
    const float* res; float* out;
    DI bool next(int i, GU& u) const { return ord.next(i, u); }
    DI unsigned a_row_off(const GU& u, int r) const { return (unsigned)(u.pm * 256 + r) * lda2; }
    DI const char* b_tile(const GU& u) const { return Bt + (size_t)u.pn * 256 * ldb2; }
    DI void epi(const f32x4 (&acc)[2][2][4][2], const GU& u, int wr, int wc, int fr, int fq) const {
        const int col0 = u.pn * 256 + wc * 32 + 4 * fq;
#pragma unroll
        for (int ai = 0; ai < 2; ++ai)
#pragma unroll
            for (int m = 0; m < 4; ++m) { const size_t off = (size_t)(u.pm * 256 + ai * 128 + wr * 64 + m * 16 + fr) * D + col0;
#pragma unroll
                for (int bj = 0; bj < 2; ++bj)
#pragma unroll
                    for (int n = 0; n < 2; ++n) { const f32x4 r = *(const f32x4*)(res + off + bj * 128 + n * 16); *(f32x4*)(out + off + bj * 128 + n * 16) = r * DN_ALPHA + acc[ai][bj][m][n]; } }
    }
};
struct MoeTab { const LAS int* tbase; const LAS int* cnt; int ntiles; };
struct GemmMoeUp {
    static constexpr bool PERM = true;
    const char* A; int K; unsigned lda2, ldb2; const char* Bt; int G, c;
    MoeTab tab; const unsigned* list; bf16_t* H;
    DI bool next(int i, GU& u) const {
        const int L = i * G + c; if (L >= tab.ntiles * 4) return false;
        const int tile = L >> 2; u.pn = L & 3; int e = 0;
#pragma unroll 1
        while (tab.tbase[e + 1] <= tile) ++e;
        u.e = e; u.pm = tile - tab.tbase[e]; return true;
    }
    DI unsigned a_row_off(const GU& u, int r) const {
        const int li = u.pm * 256 + r; const int cn = tab.cnt[u.e];
        const unsigned slot = li < cn ? list[(size_t)u.e * T + li] : 0u;
        return (slot >> 1) * lda2;
    }
    DI const char* b_tile(const GU& u) const { return Bt + ((size_t)u.e * 1024 + (size_t)u.pn * 256) * ldb2; }
    DI void epi(const f32x4 (&acc)[2][2][4][2], const GU& u, int wr, int wc, int fr, int fq) const {
        const int hrow0 = (tab.tbase[u.e] + u.pm) * 256 + wr * 64 + fr, col0 = u.pn * 128 + wc * 32 + 8 * fq;
#pragma unroll
        for (int ai = 0; ai < 2; ++ai)
#pragma unroll
            for (int m = 0; m < 4; ++m) { bf16_t* rowp = H + (size_t)(hrow0 + ai * 128 + m * 16) * FF + col0;
                float h[8];
#pragma unroll
                for (int n = 0; n < 2; ++n)
#pragma unroll
                    for (int j = 0; j < 4; ++j) { const float g = acc[ai][0][m][n][j], uu = acc[ai][1][m][n][j]; h[n * 4 + j] = g * uu / (1.0f + __expf(-g)); }
                u32x4 w; w.x = cvt_pk_bf16(h[0], h[1]); w.y = cvt_pk_bf16(h[2], h[3]); w.z = cvt_pk_bf16(h[4], h[5]); w.w = cvt_pk_bf16(h[6], h[7]);
                *(u32x4*)rowp = w; }
    }
};
struct GemmMoeDown {
    static constexpr bool PERM = true;
    const char* A; int K; unsigned lda2, ldb2; const char* Bt; int G, c;
    MoeTab tab; const unsigned* list; const float* wslot; bf16_t* Y;
    DI bool next(int i, GU& u) const {
        const int L = i * G + c; if (L >= tab.ntiles * 4) return false;
        const int tile = L >> 2; u.pn = L & 3; int e = 0;
#pragma unroll 1
        while (tab.tbase[e + 1] <= tile) ++e;
        u.e = e; u.pm = tile - tab.tbase[e]; return true;
    }
    DI unsigned a_row_off(const GU& u, int r) const { return (unsigned)((tab.tbase[u.e] + u.pm) * 256 + r) * lda2; }
    DI const char* b_tile(const GU& u) const { return Bt + ((size_t)u.e * 1024 + (size_t)u.pn * 256) * ldb2; }
    DI void epi(const f32x4 (&acc)[2][2][4][2], const GU& u, int wr, int wc, int fr, int fq) const {
        const int cn = tab.cnt[u.e]; const int col0 = u.pn * 256 + wc * 32 + 8 * fq;
#pragma unroll
        for (int ai = 0; ai < 2; ++ai)
#pragma unroll
            for (int m = 0; m < 4; ++m) { const int li = u.pm * 256 + ai * 128 + wr * 64 + m * 16 + fr;
                if (li < cn) { const unsigned slot = list[(size_t)u.e * T + li]; const float ws = wslot[slot]; bf16_t* rowp = Y + (size_t)slot * D + col0;
#pragma unroll
                    for (int bj = 0; bj < 2; ++bj) { const f32x4 v0 = acc[ai][bj][m][0] * ws, v1 = acc[ai][bj][m][1] * ws;
                        u32x4 w; w.x = cvt_pk_bf16(v0[0], v0[1]); w.y = cvt_pk_bf16(v0[2], v0[3]); w.z = cvt_pk_bf16(v1[0], v1[1]); w.w = cvt_pk_bf16(v1[2], v1[3]);
                        *(u32x4*)(rowp + bj * 128) = w; } } }
    }
};

struct Frame {
    LAS unsigned char* lds;
    int tid, lane, wave, vcu, G;
    const float* const* in; float* out; unsigned char* ws;
};
constexpr int LDS_RING = 131072;
constexpr int LDS_MISC = LDS_RING;
constexpr int LDS_BYTES = 147456;

template <class Map>
DI void p0_transpose_item(const float* W, int K, int N, bf16_t* WT, const Map& map, LAS float* scr, int item, int lane) {
    const int nblk = (N + 31) / 32, kb = item / nblk, nb = item % nblk, k0 = 64 * kb, n0 = 32 * nb;
    const bool nok = (n0 + (lane & 31)) < N;
#pragma unroll 8
    for (int i = 0; i < 32; ++i) { const int kk = 2 * i + (lane >> 5); scr[kk * 33 + (lane & 31)] = nok ? W[(size_t)(k0 + kk) * N + n0 + (lane & 31)] : 0.f; }
    LDS_WAIT(); asm volatile("" ::: "memory");
    const int c = lane & 7;
#pragma unroll
    for (int j = 0; j < 4; ++j) { const int n = (lane >> 3) + 8 * j; const LAS float* s = scr + (8 * c) * 33 + n;
        u32x4 o; o.x = pk2(s[0 * 33], s[1 * 33]); o.y = pk2(s[2 * 33], s[3 * 33]); o.z = pk2(s[4 * 33], s[5 * 33]); o.w = pk2(s[6 * 33], s[7 * 33]);
        if (n0 + n < N) *(u32x4*)(WT + (size_t)map(n0 + n) * K + k0 + 8 * c) = o; }
    LDS_WAIT(); asm volatile("" ::: "memory");
}
struct MapId { int off; DI int operator()(int n) const { return n + off; } };
DI int rope_perm(int d) { return (d & 15) | ((d & 16) << 1) | ((d & 32) >> 1); }
struct MapL1In { DI int operator()(int n) const {
    if (n < 1024) return (n & ~63) | rope_perm(n & 63);
    if (n < 2560) { const int j = (n - 1024) >> 8; return (j & 1) ? n : ((n & ~63) | rope_perm(n & 63)); }
    return n; } };
struct MapGU { int up; DI int operator()(int c) const { return (c >> 7) * 256 + up * 128 + (c & 127); } };

DI void p0_prep(Frame& F) {
    LAS float* scr = (LAS float*)(F.lds + F.wave * 16384);
    const int gw = F.vcu * NWAVES + F.wave, NGW = F.G * NWAVES;
    const int gt = F.vcu * NTHR + F.tid, NGT = F.G * NTHR;
    unsigned char* ws = F.ws;
    for (int i = gt; i < 1024; i += NGT) ((unsigned*)(ws + WS_CTL))[i] = 0u;
    constexpr int I_W0IN = 16 * 80, I_W0OUT = 16 * 32, I_W1IN = 16 * 82, I_W1OUT = 16 * 32, I_WC1 = 32 * 8, I_WC2 = 4 * 2, I_MOE = 32 * 256;
    constexpr int NITEMS = I_W0IN + I_W0OUT + I_W1IN + I_W1OUT + 2 * I_WC1 + 2 * I_WC2 + 6 * I_MOE;
    for (int it = gw; it < NITEMS; it += NGW) {
        int r = it;
        if (r < I_W0IN) { p0_transpose_item(F.in[1], 1024, L0N, (bf16_t*)(ws + WS_W0IN), MapId{0}, scr, r, F.lane); continue; } r -= I_W0IN;
        if (r < I_W0OUT) { p0_transpose_item(F.in[10], 1024, 1024, (bf16_t*)(ws + WS_W0OUT), MapId{0}, scr, r, F.lane); continue; } r -= I_W0OUT;
        if (r < I_W1IN) { p0_transpose_item(F.in[22], 1024, L1N, (bf16_t*)(ws + WS_W1IN), MapL1In{}, scr, r, F.lane); continue; } r -= I_W1IN;
        if (r < I_W1OUT) { p0_transpose_item(F.in[29], 1024, 1024, (bf16_t*)(ws + WS_W1OUT), MapId{0}, scr, r, F.lane); continue; } r -= I_W1OUT;
        if (r < I_WC1) { p0_transpose_item(F.in[24], 2048, 256, (bf16_t*)(ws + WS_WC1), MapId{0}, scr, r, F.lane); continue; } r -= I_WC1;
        if (r < I_WC1) { p0_transpose_item(F.in[27], 2048, 256, (bf16_t*)(ws + WS_WC1) + 256 * 2048, MapId{0}, scr, r, F.lane); continue; } r -= I_WC1;
        if (r < I_WC2) { p0_transpose_item(F.in[25], 256, 64, (bf16_t*)(ws + WS_WC2), MapId{0}, scr, r, F.lane); continue; } r -= I_WC2;
        if (r < I_WC2) { p0_transpose_item(F.in[28], 256, 64, (bf16_t*)(ws + WS_WC2) + 256 * 256, MapId{0}, scr, r, F.lane); continue; } r -= I_WC2;
#pragma unroll 1
        for (int l = 0; l < 2; ++l) {
            const int ib = l ? 36 : 17; bf16_t* wgu = (bf16_t*)(ws + (l ? WS_WGU1 : WS_WGU0)); bf16_t* wd = (bf16_t*)(ws + (l ? WS_WD1 : WS_WD0));
            if (r < I_MOE) { const int e = r >> 8; p0_transpose_item(F.in[ib] + (size_t)e * 1024 * 512, 1024, 512, wgu + (size_t)e * 1024 * 1024, MapGU{0}, scr, r & 255, F.lane); r = -1; break; } r -= I_MOE;
            if (r < I_MOE) { const int e = r >> 8; p0_transpose_item(F.in[ib + 1] + (size_t)e * 1024 * 512, 1024, 512, wgu + (size_t)e * 1024 * 1024, MapGU{1}, scr, r & 255, F.lane); r = -1; break; } r -= I_MOE;
            if (r < I_MOE) { const int e = r >> 8; p0_transpose_item(F.in[ib + 2] + (size_t)e * 512 * 1024, 512, 1024, wd + (size_t)e * 1024 * 512, MapId{0}, scr, r & 255, F.lane); r = -1; break; } r -= I_MOE;
        }
    }
    { u32x4 z = (u32x4){0u, 0u, 0u, 0u};
      u32x4* p1 = (u32x4*)((bf16_t*)(ws + WS_W1IN) + (size_t)L1N * 1024); const int n1 = (L1NP - L1N) * 1024 / 8;
      for (int i = gt; i < n1; i += NGT) p1[i] = z;
      for (int kv = 0; kv < 2; ++kv) { u32x4* p2 = (u32x4*)((bf16_t*)(ws + WS_WC2) + (size_t)kv * 65536 + 64 * 256); const int n2 = 192 * 256 / 8; for (int i = gt; i < n2; i += NGT) p2[i] = z; } }
    { const float* x = F.in[0]; bf16_t* xb = (bf16_t*)(ws + WS_XB);
      for (int m = gw; m < T; m += NGW) { const f32x4* xr = (const f32x4*)(x + (size_t)m * D) + F.lane; u32x2* o = (u32x2*)(xb + (size_t)m * D) + F.lane;
#pragma unroll
          for (int j = 0; j < 4; ++j) { const f32x4 v = xr[64 * j]; o[64 * j] = (u32x2){pk2(v.x, v.y), pk2(v.z, v.w)}; } } }
    { float* ct = (float*)(ws + WS_COS); float* st = (float*)(ws + WS_SIN);
      for (int i = gt; i < SEQ * 32; i += NGT) { const int pos = i >> 5, k = i & 31; const float inv = (float)pow(10000.0, -(double)(2 * k) / 64.0); const float ang = (float)pos * inv;
          ct[i] = (float)cos((double)ang); st[i] = (float)sin((double)ang); } }
    { bf16_t* bt = (bf16_t*)(ws + WS_SMALL + SM_LRUBT);
      for (int i = gt; i < 2 * 8 * 4096; i += NGT) { const int g = i >> 15, h = (i >> 12) & 7, j = (i >> 6) & 63, ii = i & 63; const float* w = F.in[g ? 7 : 5];
          bt[i] = (bf16_t)f2bf(w[h * 4096 + ii * 64 + j]); } }
    { float* rw = (float*)(ws + WS_SMALL + SM_RWT);
      for (int i = gt; i < 2 * 36 * 1024; i += NGT) { const int l = i / (36 * 1024), o = (i / 1024) % 36, k = i & 1023; const float* wg = F.in[l ? 32 : 13]; const float* we = F.in[l ? 34 : 15];
          rw[i] = o < 4 ? wg[k * 4 + o] : we[k * 32 + (o - 4)]; } }
    { float* cb = (float*)(ws + WS_SMALL + SM_CBIAS);
      for (int o = gw; o < 512; o += NGW) { const int kv = o >> 8, j = o & 255; const float* pe = F.in[kv ? 26 : 23]; const float* w1 = F.in[kv ? 27 : 24];
          float s = 0.f; for (int k = F.lane; k < 2048; k += 64) s += pe[k] * w1[(size_t)k * 256 + j];
          s = wave_sum(s); if (F.lane == 0) cb[o] = s; } }
}

constexpr int XCL_STRIDE = 520;
constexpr int LDS_XC = 0, LDS_GT = 66560, LDS_HIN = 133120;
DI f32x2 lds_swap(float v) { auto rr = __builtin_amdgcn_permlane32_swap(__float_as_uint(v), __float_as_uint(v), false, false); return (f32x2){__uint_as_float(rr[0]), __uint_as_float(rr[1])}; }

template <bool FINAL>
DI void lru_tile(Frame& F, int b, int ch) {
    const unsigned char* ws = F.ws;
    const bf16_t* z = (const bf16_t*)(ws + WS_Z);
    bf16_t* ycat = (bf16_t*)(ws + WS_XB);
    float* SA = (float*)(ws + WS_SCAN); float* SH = SA + 4 * 128 * 512;
    LAS bf16_t* xcL = (LAS bf16_t*)(F.lds + LDS_XC); LAS bf16_t* gL = (LAS bf16_t*)(F.lds + LDS_GT); LAS float* hin = (LAS float*)(F.lds + LDS_HIN);
    const int tid = F.tid, lane = F.lane, wave = F.wave;
    const int t0 = ch * 64; const size_t row0 = (size_t)b * SEQ + t0;
    const int c8 = tid & 63, tg = tid >> 6;
    {
        float w[4][8], bias[8];
        const float* cw = F.in[3]; const float* cbv = F.in[4];
#pragma unroll
        for (int k = 0; k < 4; ++k)
#pragma unroll
            for (int j = 0; j < 8; ++j) w[k][j] = cw[k * 512 + c8 * 8 + j];
#pragma unroll
        for (int j = 0; j < 8; ++j) bias[j] = cbv[c8 * 8 + j];
        float xv[11][8];
#pragma unroll
        for (int i = 0; i < 11; ++i) { const int t = t0 + tg * 8 + i - 3;
            if (t >= 0) { const u32x4 v = *(const u32x4*)(z + ((size_t)b * SEQ + t) * L0N + 2048 + c8 * 8);
                xv[i][0] = bflo(v.x); xv[i][1] = bfhi(v.x); xv[i][2] = bflo(v.y); xv[i][3] = bfhi(v.y); xv[i][4] = bflo(v.z); xv[i][5] = bfhi(v.z); xv[i][6] = bflo(v.w); xv[i][7] = bfhi(v.w); }
            else {
#pragma unroll
                for (int j = 0; j < 8; ++j) xv[i][j] = 0.f; } }
#pragma unroll
        for (int i = 0; i < 8; ++i) { float o[8];
#pragma unroll
            for (int j = 0; j < 8; ++j) o[j] = bias[j] + w[0][j] * xv[i][j] + w[1][j] * xv[i + 1][j] + w[2][j] * xv[i + 2][j] + w[3][j] * xv[i + 3][j];
            u32x4 pk; pk.x = pk2(o[0], o[1]); pk.y = pk2(o[2], o[3]); pk.z = pk2(o[4], o[5]); pk.w = pk2(o[6], o[7]);
            *(LAS u32x4*)(xcL + (tg * 8 + i) * XCL_STRIDE + c8 * 8) = pk; }
    }
    if constexpr (FINAL) {
#pragma unroll
        for (int i = 0; i < 8; ++i) { const int tl = tg * 8 + i; const u32x4 v = *(const u32x4*)(z + (row0 + tl) * L0N + 1536 + c8 * 8); *(LAS u32x4*)(gL + tl * XCL_STRIDE + c8 * 8) = v; }
        float w[3][8]; const float* cw = F.in[2];
#pragma unroll
        for (int k = 0; k < 3; ++k)
#pragma unroll
            for (int j = 0; j < 8; ++j) w[k][j] = cw[k * 512 + c8 * 8 + j];
        float pv[10][8];
#pragma unroll
        for (int i = 0; i < 10; ++i) { const int t = t0 + tg * 8 + i - 2;
            if (t >= 0) { const bf16_t* zr = z + ((size_t)b * SEQ + t) * L0N + c8 * 8; const u32x4 a = *(const u32x4*)(zr + 512), c = *(const u32x4*)(zr + 1024);
                pv[i][0] = bflo(a.x) * bflo(c.x); pv[i][1] = bfhi(a.x) * bfhi(c.x); pv[i][2] = bflo(a.y) * bflo(c.y); pv[i][3] = bfhi(a.y) * bfhi(c.y);
                pv[i][4] = bflo(a.z) * bflo(c.z); pv[i][5] = bfhi(a.z) * bfhi(c.z); pv[i][6] = bflo(a.w) * bflo(c.w); pv[i][7] = bfhi(a.w) * bfhi(c.w); }
            else {
#pragma unroll
                for (int j = 0; j < 8; ++j) pv[i][j] = 0.f; } }
#pragma unroll
        for (int i = 0; i < 8; ++i) { const int tl = tg * 8 + i; const u32x4 bgv = *(const u32x4*)(z + (row0 + tl) * L0N + c8 * 8);
            const float bgf[8] = {bflo(bgv.x), bfhi(bgv.x), bflo(bgv.y), bfhi(bgv.y), bflo(bgv.z), bfhi(bgv.z), bflo(bgv.w), bfhi(bgv.w)};
            float o[8];
#pragma unroll
            for (int j = 0; j < 8; ++j) o[j] = bgf[j] * (w[0][j] * pv[i][j] + w[1][j] * pv[i + 1][j] + w[2][j] * pv[i + 2][j]);
            u32x4 pk; pk.x = pk2(o[0], o[1]); pk.y = pk2(o[2], o[3]); pk.z = pk2(o[4], o[5]); pk.w = pk2(o[6], o[7]);
            *(u32x4*)(ycat + (row0 + tl) * D + c8 * 8) = pk; }
        { float h = 0.f; const float* sa = SA + (size_t)b * 128 * 512 + tid; const float* sh = SH + (size_t)b * 128 * 512 + tid;
#pragma unroll 8
          for (int k = 0; k < ch; ++k) h = sa[k * 512] * h + sh[k * 512];
          hin[tid] = h; }
    }
    __syncthreads();
    {
        const int head = wave, r32 = lane & 31, hh = lane >> 5;
        const bf16_t* lbt = (const bf16_t*)(ws + WS_SMALL + SM_LRUBT);
        const float* b_a = F.in[6]; const float* b_x = F.in[8]; const float* lam = F.in[9];
#pragma unroll 1
        for (int ct = 0; ct < 2; ++ct) {
            const int c = head * 64 + ct * 32 + r32;
            f32x16 acc[2][2];
#pragma unroll
            for (int g = 0; g < 2; ++g)
#pragma unroll
                for (int rt = 0; rt < 2; ++rt)
#pragma unroll
                    for (int i = 0; i < 16; ++i) acc[g][rt][i] = 0.f;
#pragma unroll
            for (int ks = 0; ks < 4; ++ks) {
                bf16x8 af[2], bfr[2];
#pragma unroll
                for (int rt = 0; rt < 2; ++rt) af[rt] = *(const LAS bf16x8*)(xcL + (rt * 32 + r32) * XCL_STRIDE + head * 64 + ks * 16 + hh * 8);
#pragma unroll
                for (int g = 0; g < 2; ++g) bfr[g] = *(const bf16x8*)(lbt + ((size_t)(g * 8 + head) * 64 + ct * 32 + r32) * 64 + ks * 16 + hh * 8);
#pragma unroll
                for (int g = 0; g < 2; ++g)
#pragma unroll
                    for (int rt = 0; rt < 2; ++rt) acc[g][rt] = __builtin_amdgcn_mfma_f32_32x32x16_bf16(af[rt], bfr[g], acc[g][rt], 0, 0, 0);
            }
            const float ba = b_a[c], bx = b_x[c]; const float lm = lam[c];
            const float sp = (lm > 15.f) ? __expf(-lm) : log1pf(__expf(-lm));
            float carry = FINAL ? hin[c] : 0.f, atot = 1.f;
#pragma unroll
            for (int rt = 0; rt < 2; ++rt) {
#pragma unroll
                for (int g4 = 0; g4 < 4; ++g4) {
                    float av[4], uv[4]; float Ag = 1.f, Hg = 0.f;
#pragma unroll
                    for (int j = 0; j < 4; ++j) { const int reg = g4 * 4 + j; const int tl = rt * 32 + 8 * g4 + 4 * hh + j;
                        const float r = sigmoidf_(acc[0][rt][reg] + ba), ig = sigmoidf_(acc[1][rt][reg] + bx);
                        const float la = -8.0f * r * sp; const float a = __expf(la); const float mult = sqrtf(fmaxf(-expm1f(2.0f * la), 0.f));
                        const float xc = bf2f(xcL[tl * XCL_STRIDE + c]);
                        av[j] = a; uv[j] = mult * ig * xc; Ag = a * Ag; Hg = a * Hg + uv[j]; }
                    const f32x2 As = lds_swap(Ag), Hs = lds_swap(Hg);
                    const float mid = As[0] * carry + Hs[0];
                    if constexpr (FINAL) {
                        float s = hh ? mid : carry;
#pragma unroll
                        for (int j = 0; j < 4; ++j) { const int tl = rt * 32 + 8 * g4 + 4 * hh + j; s = av[j] * s + uv[j];
                            const float gv = bf2f(gL[tl * XCL_STRIDE + c]); gL[tl * XCL_STRIDE + c] = (bf16_t)f2bf(s * gelu_tanh(gv)); }
                    }
                    carry = As[1] * mid + Hs[1]; atot = atot * As[0] * As[1];
                }
            }
            if constexpr (!FINAL) { if (hh == 0) { SA[((size_t)b * 128 + ch) * 512 + c] = atot; SH[((size_t)b * 128 + ch) * 512 + c] = carry; } }
        }
    }
    __syncthreads();
    if constexpr (FINAL) {
#pragma unroll
        for (int i = 0; i < 8; ++i) { const int tl = tg * 8 + i; const u32x4 v = *(const LAS u32x4*)(gL + tl * XCL_STRIDE + c8 * 8); *(u32x4*)(ycat + (row0 + tl) * D + 512 + c8 * 8) = v; }
        __syncthreads();
    }
}

constexpr int LDS_RI = 0;
constexpr int LDS_HIST = 4096;
template <bool SCALE_IN>
DI void ln_router_phase(Frame& F, int layer) {
    float* xs = F.out; bf16_t* xb = (bf16_t*)(F.ws + WS_XB);
    const float* gam = F.in[layer ? 30 : 11]; const float* bet = F.in[layer ? 31 : 12];
    const float* rw = (const float*)(F.ws + WS_SMALL + SM_RWT) + (size_t)layer * 36 * 1024;
    const float* bg = F.in[layer ? 33 : 14]; const float* be = F.in[layer ? 35 : 16];
    unsigned* cnt = (unsigned*)(F.ws + WS_CTL) + CW_CNT + layer * 32;
    unsigned* list = (unsigned*)(F.ws + WS_LIST); float* wslot = (float*)(F.ws + WS_WSLOT);
    LAS int* e0s = (LAS int*)(F.lds + LDS_RI); LAS int* e1s = e0s + 128; LAS float* w0s = (LAS float*)(e1s + 128); LAS float* w1s = w0s + 128;
    LAS int* hist = (LAS int*)(F.lds + LDS_HIST); LAS int* base = hist + 32;
    const int lane = F.lane;
    f32x4 gv[4], bv[4];
#pragma unroll
    for (int j = 0; j < 4; ++j) { gv[j] = ((const f32x4*)gam)[lane + 64 * j]; bv[j] = ((const f32x4*)bet)[lane + 64 * j]; }
    for (int chunk = F.vcu; chunk < T / 128; chunk += F.G) {
        if (F.tid < 32) hist[F.tid] = 0;
        __syncthreads();
        for (int rr = F.wave; rr < 128; rr += NWAVES) {
            const size_t row = (size_t)chunk * 128 + rr;
            f32x4* xr = (f32x4*)(xs + row * D) + lane;
            f32x4 v[4]; float s = 0.f;
#pragma unroll
            for (int j = 0; j < 4; ++j) { v[j] = xr[64 * j]; if (SCALE_IN) v[j] = v[j] * DN_ALPHA; s += (v[j].x + v[j].y) + (v[j].z + v[j].w); }
            const float mean = wave_sum(s) * (1.f / D); float s2 = 0.f;
#pragma unroll
            for (int j = 0; j < 4; ++j) { v[j] = v[j] - mean; s2 += (v[j].x * v[j].x + v[j].y * v[j].y) + (v[j].z * v[j].z + v[j].w * v[j].w); }
            const float rstd = 1.f / sqrtf(wave_sum(s2) * (1.f / D) + LN_EPS);
            u32x2* ob = (u32x2*)(xb + row * D) + lane;
#pragma unroll
            for (int j = 0; j < 4; ++j) { v[j] = v[j] * rstd * gv[j] + bv[j]; xr[64 * j] = v[j]; ob[64 * j] = (u32x2){pk2(v[j].x, v[j].y), pk2(v[j].z, v[j].w)}; }
            float gl[4];
#pragma unroll
            for (int o = 0; o < 4; ++o) { const f32x4* wr_ = (const f32x4*)(rw + o * 1024) + lane; float a = 0.f;
#pragma unroll
                for (int j = 0; j < 4; ++j) { const f32x4 w = wr_[64 * j]; a += (v[j].x * w.x + v[j].y * w.y) + (v[j].z * w.z + v[j].w * w.w); }
                gl[o] = wave_sum(a) + bg[o]; }
            float g0 = gl[0]; int gs = 0;
#pragma unroll
            for (int o = 1; o < 4; ++o) if (gl[o] > g0) { g0 = gl[o]; gs = o; }
            float gsum = 0.f;
#pragma unroll
            for (int o = 0; o < 4; ++o) gsum += __expf(gl[o] - g0);
            const float pgrp = 1.0f / gsum;
            gs = __builtin_amdgcn_readfirstlane(gs);
            float le[8];
#pragma unroll
            for (int hf = 0; hf < 2; ++hf) {
#pragma unroll
                for (int oo = 0; oo < 4; ++oo) { const int o = hf * 4 + oo; const f32x4* wr_ = (const f32x4*)(rw + (4 + gs * 8 + o) * 1024) + lane; float a = 0.f;
#pragma unroll
                    for (int j = 0; j < 4; ++j) { const f32x4 w = wr_[64 * j]; a += (v[j].x * w.x + v[j].y * w.y) + (v[j].z * w.z + v[j].w * w.w); }
                    le[o] = wave_sum(a) + be[gs * 8 + o]; }
                asm volatile("" ::: "memory"); }
            float m0 = le[0]; int i0 = 0;
#pragma unroll
            for (int o = 1; o < 8; ++o) if (le[o] > m0) { m0 = le[o]; i0 = o; }
            float m1 = -3.0e38f; int i1 = 0;
#pragma unroll
            for (int o = 0; o < 8; ++o) if (o != i0 && le[o] > m1) { m1 = le[o]; i1 = o; }
            const float e1 = __expf(m1 - m0); const float w0 = pgrp / (1.0f + e1), w1 = pgrp * e1 / (1.0f + e1);
            if (lane == 0) { e0s[rr] = gs * 8 + i0; e1s[rr] = gs * 8 + i1; w0s[rr] = w0; w1s[rr] = w1; }
        }
        __syncthreads();
        int myrank = 0, mye = 0;
        if (F.tid < 256) { const int rr = F.tid >> 1, k = F.tid & 1; mye = k ? e1s[rr] : e0s[rr]; myrank = atomicAdd((int*)&hist[mye], 1); }
        __syncthreads();
        if (F.tid < 32) { const int h = hist[F.tid]; base[F.tid] = h ? (int)atomicAdd(&cnt[F.tid], (unsigned)h) : 0; }
        __syncthreads();
        if (F.tid < 256) { const int rr = F.tid >> 1, k = F.tid & 1; const unsigned slot = (unsigned)((chunk * 128 + rr) * 2 + k);
            list[(size_t)mye * T + base[mye] + myrank] = slot; wslot[slot] = k ? w1s[rr] : w0s[rr]; }
        __syncthreads();
    }
}

DI MoeTab moe_tables(Frame& F, int layer) {
    LAS int* tb = (LAS int*)(F.lds + LDS_MISC); LAS int* cn = tb + 64; LAS int* nt = cn + 64;
    const unsigned* cnt = (const unsigned*)(F.ws + WS_CTL) + CW_CNT + layer * 32;
    if (F.tid == 0) { int acc = 0; for (int e = 0; e < 32; ++e) { const int c = (int)__hip_atomic_load(cnt + e, __ATOMIC_RELAXED, __HIP_MEMORY_SCOPE_AGENT); cn[e] = c; tb[e] = acc; acc += (c + 255) >> 8; } tb[32] = acc; nt[0] = acc; }
    __syncthreads();
    MoeTab t; t.tbase = tb; t.cnt = cn; t.ntiles = nt[0]; return t;
}

template <bool WRITE_BF>
DI void ln2_phase(Frame& F, int layer) {
    float* xs = F.out; bf16_t* xb = (bf16_t*)(F.ws + WS_XB); const bf16_t* Y = (const bf16_t*)(F.ws + WS_Y);
    const float* gam = F.in[layer ? 39 : 20]; const float* bet = F.in[layer ? 40 : 21];
    const int lane = F.lane; const int gw = F.vcu * NWAVES + F.wave, NGW = F.G * NWAVES;
    f32x4 gv[4], bv[4];
#pragma unroll
    for (int j = 0; j < 4; ++j) { gv[j] = ((const f32x4*)gam)[lane + 64 * j]; bv[j] = ((const f32x4*)bet)[lane + 64 * j]; }
    for (int row = gw; row < T; row += NGW) {
        f32x4* xr = (f32x4*)(xs + (size_t)row * D) + lane;
        const u32x2* y0 = (const u32x2*)(Y + (size_t)(2 * row) * D) + lane; const u32x2* y1 = (const u32x2*)(Y + (size_t)(2 * row + 1) * D) + lane;
        f32x4 v[4]; float s = 0.f;
#pragma unroll
        for (int j = 0; j < 4; ++j) { const u32x2 a = y0[64 * j], c = y1[64 * j]; v[j] = xr[64 * j] * DN_ALPHA;
            v[j].x += bflo(a.x) + bflo(c.x); v[j].y += bfhi(a.x) + bfhi(c.x); v[j].z += bflo(a.y) + bflo(c.y); v[j].w += bfhi(a.y) + bfhi(c.y);
            s += (v[j].x + v[j].y) + (v[j].z + v[j].w); }
        const float mean = wave_sum(s) * (1.f / D); float s2 = 0.f;
#pragma unroll
        for (int j = 0; j < 4; ++j) { v[j] = v[j] - mean; s2 += (v[j].x * v[j].x + v[j].y * v[j].y) + (v[j].z * v[j].z + v[j].w * v[j].w); }
        const float rstd = 1.f / sqrtf(wave_sum(s2) * (1.f / D) + LN_EPS);
        u32x2* ob = (u32x2*)(xb + (size_t)row * D) + lane;
#pragma unroll
        for (int j = 0; j < 4; ++j) { v[j] = v[j] * rstd * gv[j] + bv[j]; xr[64 * j] = v[j]; if (WRITE_BF) ob[64 * j] = (u32x2){pk2(v[j].x, v[j].y), pk2(v[j].z, v[j].w)}; }
    }
}

constexpr float QSCALE = 0.125f * 1.4426950408889634f;
struct GemmL1In {
    static constexpr bool PERM = false;
    const char* A; int K; unsigned lda2, ldb2; const char* Bt; pg8::TileOrder ord;
    bf16_t* Q; unsigned char* KV; float* gates; const float* cosT; const float* sinT;
    DI bool next(int i, GU& u) const { return ord.next(i, u); }
    DI unsigned a_row_off(const GU& u, int r) const { return (unsigned)(u.pm * 256 + r) * lda2; }
    DI const char* b_tile(const GU& u) const { return Bt + (size_t)u.pn * 256 * ldb2; }
    DI void epi(const f32x4 (&acc)[2][2][4][2], const GU& u, int wr, int wc, int fr, int fq) const {
        const int pn = u.pn;
#pragma unroll
        for (int ai = 0; ai < 2; ++ai)
#pragma unroll
            for (int m = 0; m < 4; ++m) {
                const int row = u.pm * 256 + ai * 128 + wr * 64 + m * 16 + fr; const int pos = row & (SEQ - 1), b = row >> 13;
                if (pn == 10) {
                    if (wc < 2) {
#pragma unroll
                        for (int n = 0; n < 2; ++n) { if (n == 1 && wc == 1) continue; const f32x4 v = acc[ai][0][m][n];
                            f32x4 o; o.x = sigmoidf_(v.x); o.y = sigmoidf_(v.y); o.z = sigmoidf_(v.z); o.w = sigmoidf_(v.w);
                            *(f32x4*)(gates + (size_t)row * 48 + 32 * wc + 16 * n + 4 * fq) = o; }
                    }
                } else if (pn < 5 || pn == 6 || pn == 8) {
                    const int a = wc & 1, i0 = 16 * a + 4 * fq;
                    const f32x4 c4 = *(const f32x4*)(cosT + pos * 32 + i0), s4 = *(const f32x4*)(sinT + pos * 32 + i0);
#pragma unroll
                    for (int bj = 0; bj < 2; ++bj) { const f32x4 x1 = acc[ai][bj][m][0], x2 = acc[ai][bj][m][1];
                        f32x4 o1 = x1 * c4 - x2 * s4, o2 = x2 * c4 + x1 * s4;
                        const int hl = bj * 2 + (wc >> 1); bf16_t* dst;
                        if (pn < 4) { o1 = o1 * QSCALE; o2 = o2 * QSCALE; dst = Q + ((size_t)row * 16 + pn * 4 + hl) * 64; }
                        else dst = (bf16_t*)(KV + (size_t)(pn - 4) * KV_STRIDE) + ((size_t)(b * 4 + hl) * SEQ + pos) * 64;
                        *(u32x2*)(dst + i0) = (u32x2){cvt_pk_bf16(o1.x, o1.y), cvt_pk_bf16(o1.z, o1.w)};
                        *(u32x2*)(dst + 32 + i0) = (u32x2){cvt_pk_bf16(o2.x, o2.y), cvt_pk_bf16(o2.z, o2.w)}; }
                } else {
#pragma unroll
                    for (int bj = 0; bj < 2; ++bj) { const int gg = bj * 2 + (wc >> 1);
                        bf16_t* dst = (bf16_t*)(KV + (size_t)(pn - 4) * KV_STRIDE) + ((size_t)(b * 4 + gg) * SEQ + pos) * 64 + 32 * (wc & 1) + 4 * fq;
#pragma unroll
                        for (int n = 0; n < 2; ++n) { const f32x4 v = acc[ai][bj][m][n]; *(u32x2*)(dst + 16 * n) = (u32x2){cvt_pk_bf16(v.x, v.y), cvt_pk_bf16(v.z, v.w)}; } }
                }
            }
    }
};
struct GemmCmp1 {
    static constexpr bool PERM = true;
    const char* A; int K; unsigned lda2, ldb2; const char* Bt; int G, c;
    const float* cbias; bf16_t* Hd;
    DI bool next(int i, GU& u) const { const int L = i * G + c; if (L >= 64) return false; u.e = L >> 5; u.pm = L & 31; u.pn = 0; return true; }
    DI unsigned a_row_off(const GU& u, int r) const { return (unsigned)u.e * (unsigned)KV_STRIDE + (unsigned)(u.pm * 256 + r) * lda2; }
    DI const char* b_tile(const GU& u) const { return Bt + (size_t)u.e * 256 * ldb2; }
    DI void epi(const f32x4 (&acc)[2][2][4][2], const GU& u, int wr, int wc, int fr, int fq) const {
        const int row0 = u.pm * 256 + wr * 64 + fr, col0 = wc * 32 + 8 * fq;
        f32x4 bv[2][2];
#pragma unroll
        for (int bj = 0; bj < 2; ++bj)
#pragma unroll
            for (int n = 0; n < 2; ++n) bv[bj][n] = *(const f32x4*)(cbias + u.e * 256 + col0 + bj * 128 + 4 * n);
#pragma unroll
        for (int ai = 0; ai < 2; ++ai)
#pragma unroll
            for (int m = 0; m < 4; ++m) { bf16_t* rowp = Hd + ((size_t)u.e * 8192 + row0 + ai * 128 + m * 16) * 256 + col0;
#pragma unroll
                for (int bj = 0; bj < 2; ++bj) { const f32x4 v0 = acc[ai][bj][m][0] + bv[bj][0], v1 = acc[ai][bj][m][1] + bv[bj][1];
                    u32x4 w; w.x = cvt_pk_bf16(gelu_tanh(v0[0]), gelu_tanh(v0[1])); w.y = cvt_pk_bf16(gelu_tanh(v0[2]), gelu_tanh(v0[3]));
                    w.z = cvt_pk_bf16(gelu_tanh(v1[0]), gelu_tanh(v1[1])); w.w = cvt_pk_bf16(gelu_tanh(v1[2]), gelu_tanh(v1[3]));
                    *(u32x4*)(rowp + bj * 128) = w; } }
    }
};
struct GemmCmp2 {
    static constexpr bool PERM = true;
    const char* A; int K; unsigned lda2, ldb2; const char* Bt; int G, c;
    bf16_t* O;
    DI bool next(int i, GU& u) const { const int L = i * G + c; if (L >= 64) return false; u.e = L >> 5; u.pm = L & 31; u.pn = 0; return true; }
    DI unsigned a_row_off(const GU& u, int r) const { return (unsigned)(u.e * 8192 + u.pm * 256 + r) * lda2; }
    DI const char* b_tile(const GU& u) const { return Bt + (size_t)u.e * 256 * ldb2; }
    DI void epi(const f32x4 (&acc)[2][2][4][2], const GU& u, int wr, int wc, int fr, int fq) const {
        if (wc >= 2) return;
        const int row0 = u.pm * 256 + wr * 64 + fr, col0 = wc * 32 + 8 * fq;
#pragma unroll
        for (int ai = 0; ai < 2; ++ai)
#pragma unroll
            for (int m = 0; m < 4; ++m) { bf16_t* rowp = O + ((size_t)u.e * 8192 + row0 + ai * 128 + m * 16) * 64 + col0;
                const f32x4 v0 = acc[ai][0][m][0], v1 = acc[ai][0][m][1];
                u32x4 w; w.x = cvt_pk_bf16(v0[0], v0[1]); w.y = cvt_pk_bf16(v0[2], v0[3]); w.z = cvt_pk_bf16(v1[0], v1[1]); w.w = cvt_pk_bf16(v1[2], v1[3]);
                *(u32x4*)rowp = w; }
    }
};

constexpr int AL_KB = 0, AL_VB = 16384, AL_FAC = 32768, AL_SELM = 33792, AL_IMPS = 34816, IMP_STRIDE = 129, AL_IMPC = AL_IMPS + 64 * IMP_STRIDE * 4, AL_OT = AL_IMPS  , OT_STRIDE = 68;
static_assert(AL_OT + 8 * 32 * OT_STRIDE * 4 <= LDS_BYTES, "attention LDS map");
typedef short v4i16_t __attribute__((ext_vector_type(4)));
typedef __bf16 bf16x2_t __attribute__((ext_vector_type(2)));
DI unsigned cvtpk_s(float lo, float hi) { f32x2 v = {lo, hi}; bf16x2_t b = __builtin_convertvector(v, bf16x2_t); return __builtin_bit_cast(unsigned, b); }
DI int crow(int r, int hi) { return (r & 3) + 8 * (r >> 2) + 4 * hi; }
#define NEGINF (-__builtin_inff())

struct AttnW {
    int tid, lane, wave, r32, hh;
    LAS unsigned char* lds; LAS float* fac; LAS float* ot;
};
DI void at_load(const bf16_t* slab, int tile, int tid, u32x4& r) { r = *(const u32x4*)(slab + (size_t)tile * 4096 + tid * 8); }
DI void at_store_k(LAS unsigned char* kb, int tid, const u32x4& r) { const int key = tid >> 3, ch = tid & 7; *(LAS u32x4*)(kb + key * 128 + ((ch ^ ((key >> 1) & 7)) << 4)) = r; }
DI void at_store_v(LAS unsigned char* vb, int tid, const u32x4& r) { *(LAS u32x4*)(vb + tid * 16) = r; }
DI void at_qk(const LAS unsigned char* kb, const bf16x8 (&qf)[4], int r32, int hh, f32x16& p0, f32x16& p1) {
#pragma unroll
    for (int i = 0; i < 16; ++i) { p0[i] = 0.f; p1[i] = 0.f; }
    const int sw = (r32 >> 1) & 7;
#pragma unroll
    for (int d0 = 0; d0 < 4; ++d0) {
        const bf16x8 a0 = *(const LAS bf16x8*)(kb + r32 * 128 + (((2 * d0 + hh) ^ sw) << 4));
        const bf16x8 a1 = *(const LAS bf16x8*)(kb + (32 + r32) * 128 + (((2 * d0 + hh) ^ sw) << 4));
        p0 = __builtin_amdgcn_mfma_f32_32x32x16_bf16(a0, qf[d0], p0, 0, 0, 0);
        p1 = __builtin_amdgcn_mfma_f32_32x32x16_bf16(a1, qf[d0], p1, 0, 0, 0);
    }
}
DI void at_pv(const LAS unsigned char* vb, const f32x16& p0, const f32x16& p1, f32x16 (&o)[2], int lane) {
    const int hh = lane >> 5;
    u32x4 pw[4];
#pragma unroll
    for (int s = 0; s < 2; ++s) {
        pw[s] = (u32x4){cvtpk_s(p0[8 * s], p0[8 * s + 1]), cvtpk_s(p0[8 * s + 2], p0[8 * s + 3]), cvtpk_s(p0[8 * s + 4], p0[8 * s + 5]), cvtpk_s(p0[8 * s + 6], p0[8 * s + 7])};
        pw[2 + s] = (u32x4){cvtpk_s(p1[8 * s], p1[8 * s + 1]), cvtpk_s(p1[8 * s + 2], p1[8 * s + 3]), cvtpk_s(p1[8 * s + 4], p1[8 * s + 5]), cvtpk_s(p1[8 * s + 6], p1[8 * s + 7])};
    }
    const LAS unsigned char* vp = vb + (4 * hh + ((lane & 15) >> 2)) * 128 + (16 * ((lane >> 4) & 1) + 4 * (lane & 3)) * 2;
#pragma unroll
    for (int s = 0; s < 4; ++s)
#pragma unroll
        for (int d0 = 0; d0 < 2; ++d0) {
            const s16x4 lo = __builtin_bit_cast(s16x4, __builtin_amdgcn_ds_read_tr16_b64_v4i16((LAS v4i16_t*)(vp + s * 2048 + d0 * 64)));
            const s16x4 hi = __builtin_bit_cast(s16x4, __builtin_amdgcn_ds_read_tr16_b64_v4i16((LAS v4i16_t*)(vp + s * 2048 + d0 * 64 + 1024)));
            const bf16x8 vf = (bf16x8){lo[0], lo[1], lo[2], lo[3], hi[0], hi[1], hi[2], hi[3]};
            o[d0] = __builtin_amdgcn_mfma_f32_32x32x16_bf16(__builtin_bit_cast(bf16x8, pw[s]), vf, o[d0], 0, 0, 0);
        }
}
DI float at_rowmax(const f32x16& p0, const f32x16& p1) {
    float a = fmaxf(p0[0], p1[0]);
#pragma unroll
    for (int r = 1; r < 16; ++r) a = fmaxf(a, fmaxf(p0[r], p1[r]));
    const f32x2 s = lds_swap(a); return fmaxf(s[0], s[1]);
}
DI void at_scale_rows(f32x16 (&o)[2], float f, const AttnW& W) {
    if (W.hh == 0) W.fac[W.r32] = f;
#pragma unroll
    for (int g4 = 0; g4 < 4; ++g4) { const f32x4 fv = *(const LAS f32x4*)(W.fac + 8 * g4 + 4 * W.hh);
#pragma unroll
        for (int j = 0; j < 4; ++j) { o[0][4 * g4 + j] *= fv[j]; o[1][4 * g4 + j] *= fv[j]; } }
}
template <bool FIRST> DI void at_axpy_rows(const f32x16 (&o)[2], float f, const AttnW& W) {
    if (W.hh == 0) W.fac[W.r32] = f;
#pragma unroll
    for (int g4 = 0; g4 < 4; ++g4) { const f32x4 fv = *(const LAS f32x4*)(W.fac + 8 * g4 + 4 * W.hh);
#pragma unroll
        for (int j = 0; j < 4; ++j) { LAS float* d = W.ot + (8 * g4 + 4 * W.hh + j) * OT_STRIDE + W.r32;
            if (FIRST) { d[0] = fv[j] * o[0][4 * g4 + j]; d[32] = fv[j] * o[1][4 * g4 + j]; }
            else { d[0] += fv[j] * o[0][4 * g4 + j]; d[32] += fv[j] * o[1][4 * g4 + j]; } } }
}
template <bool GT> DI void at_mask(f32x16& p0, f32x16& p1, int lim, int hh) {
#pragma unroll
    for (int r = 0; r < 16; ++r) { const int kv = crow(r, hh);
        if (GT) { if (kv > lim) p0[r] = NEGINF; if (kv + 32 > lim) p1[r] = NEGINF; }
        else { if (kv <= lim) p0[r] = NEGINF; if (kv + 32 <= lim) p1[r] = NEGINF; } }
}
struct Flash { float m, l; f32x16 o[2]; };
DI void flash_init(Flash& s) { s.m = NEGINF; s.l = 0.f;
#pragma unroll
    for (int i = 0; i < 16; ++i) { s.o[0][i] = 0.f; s.o[1][i] = 0.f; } }
template <bool WITH_O> DI void flash_update(Flash& s, f32x16& p0, f32x16& p1, const AttnW& W) {
    const float mx = at_rowmax(p0, p1);
    const float mn = fmaxf(s.m, mx);
    if (__any(mn > s.m)) {
        const float mu = (mn == NEGINF) ? 0.f : mn;
        const float alpha = __builtin_amdgcn_exp2f(s.m - mu);
        s.l *= alpha;
        if (WITH_O) at_scale_rows(s.o, alpha, W);
        s.m = mn;
    }
    const float mu = (s.m == NEGINF) ? 0.f : s.m;
    float sum = 0.f;
#pragma unroll
    for (int r = 0; r < 16; ++r) { p0[r] = __builtin_amdgcn_exp2f(p0[r] - mu); p1[r] = __builtin_amdgcn_exp2f(p1[r] - mu); sum += p0[r] + p1[r]; }
    s.l += sum;
}

DI void attn_unit(Frame& F, int bg, int qblk, int& it) {
    AttnW W; W.tid = F.tid; W.lane = F.lane; W.wave = F.wave; W.r32 = F.lane & 31; W.hh = F.lane >> 5; W.lds = F.lds; W.fac = (LAS float*)(F.lds + AL_FAC) + F.wave * 32; W.ot = (LAS float*)(F.lds + AL_OT) + F.wave * 32 * OT_STRIDE;
    const int tid = W.tid, lane = W.lane, wave = W.wave, r32 = W.r32, hh = W.hh;
    const int b = bg >> 2, g = bg & 3;
    unsigned char* ws = F.ws;
    bf16_t* Qb = (bf16_t*)(ws + WS_Q);
    const float* gates = (const float*)(ws + WS_GATES);
    const bf16_t* kcmp = (const bf16_t*)(ws + WS_CMPO) + (size_t)bg * 512 * 64; const bf16_t* vcmp = kcmp + (size_t)8192 * 64;
    const bf16_t* ksl = (const bf16_t*)(ws + WS_KV + 2 * KV_STRIDE) + (size_t)bg * SEQ * 64; const bf16_t* vsl = (const bf16_t*)(ws + WS_KV + 3 * KV_STRIDE) + (size_t)bg * SEQ * 64;
    const bf16_t* kwl = (const bf16_t*)(ws + WS_KV + 4 * KV_STRIDE) + (size_t)bg * SEQ * 64; const bf16_t* vwl = (const bf16_t*)(ws + WS_KV + 5 * KV_STRIDE) + (size_t)bg * SEQ * 64;
    LAS unsigned char* KB = F.lds + AL_KB; LAS unsigned char* VB = F.lds + AL_VB;
    LAS unsigned* selm = (LAS unsigned*)(F.lds + AL_SELM); LAS float* impS = (LAS float*)(F.lds + AL_IMPS); LAS float* impC = (LAS float*)(F.lds + AL_IMPC);
    const int tl = wave * 8 + (r32 >> 2), hd = r32 & 3, t = qblk * 64 + tl;
    const size_t qrow = ((size_t)(b * SEQ + t) * 16 + g * 4 + hd) * 64;
    bf16x8 qf[4];
#pragma unroll
    for (int d0 = 0; d0 < 4; ++d0) qf[d0] = *(const bf16x8*)(Qb + qrow + d0 * 16 + hh * 8);
    const float* gp = gates + (size_t)(b * SEQ + t) * 48 + (g * 4 + hd) * 3;
    const float gate_c = gp[0], gate_s = gp[1], gate_w = gp[2];
    const bool need_topk = qblk >= 16;
    f32x16 p0, p1; u32x4 kr, vr;

    const int nct = (4 * qblk + 2) / 64 + 1;
    const int cmax = (t - 31) >> 4;
    Flash fc; flash_init(fc);
    at_load(kcmp, 0, tid, kr);
    for (int ti = 0; ti < nct; ++ti, ++it) {
        LAS unsigned char* kb = KB + (it & 1) * 8192;
        at_store_k(kb, tid, kr); __syncthreads();
        if (ti + 1 < nct) at_load(kcmp, ti + 1, tid, kr);
        at_qk(kb, qf, r32, hh, p0, p1);
        if (ti == nct - 1 || cmax - 64 * ti < 63) at_mask<true>(p0, p1, cmax - 64 * ti, hh);
        flash_update<false>(fc, p0, p1, W);
    }
    { const f32x2 ls = lds_swap(fc.l); fc.l = ls[0] + ls[1]; }
    const float inv_lc = 1.0f / fmaxf(fc.l, 1e-30f);
    const float mu_c = (fc.m == NEGINF) ? 0.f : fc.m;
    if (need_topk) { for (int i = tid; i < 64 * IMP_STRIDE; i += NTHR) { impS[i] = 0.f; impC[i] = 0.f; } }
    at_load(kcmp, 0, tid, kr); at_load(vcmp, 0, tid, vr);
    for (int ti = 0; ti < nct; ++ti, ++it) {
        LAS unsigned char* kb = KB + (it & 1) * 8192; LAS unsigned char* vb = VB + (it & 1) * 8192;
        at_store_k(kb, tid, kr); at_store_v(vb, tid, vr); __syncthreads();
        if (ti + 1 < nct) { at_load(kcmp, ti + 1, tid, kr); at_load(vcmp, ti + 1, tid, vr); }
        at_qk(kb, qf, r32, hh, p0, p1);
        if (ti == nct - 1 || cmax - 64 * ti < 63) at_mask<true>(p0, p1, cmax - 64 * ti, hh);
#pragma unroll
        for (int r = 0; r < 16; ++r) { p0[r] = __builtin_amdgcn_exp2f(p0[r] - mu_c) * inv_lc; p1[r] = __builtin_amdgcn_exp2f(p1[r] - mu_c) * inv_lc; }
        at_pv(vb, p0, p1, fc.o, lane);
        if (need_topk) {
#pragma unroll
            for (int half = 0; half < 2; ++half)
#pragma unroll
                for (int g4 = 0; g4 < 4; ++g4) {
                    const f32x16& p = half ? p1 : p0;
                    float s4 = (p[4 * g4] + p[4 * g4 + 1]) + (p[4 * g4 + 2] + p[4 * g4 + 3]), c3 = p[4 * g4 + 3];
                    s4 += __shfl_xor(s4, 1); c3 += __shfl_xor(c3, 1); s4 += __shfl_xor(s4, 2); c3 += __shfl_xor(c3, 2);
                    const int j = 16 * ti + 8 * half + 2 * g4 + hh;
                    if (hd == 0) { impS[tl * IMP_STRIDE + j] = s4; impC[tl * IMP_STRIDE + j] = c3; }
                }
        }
    }
    __syncthreads();
    if (need_topk) {
#pragma unroll 1
        for (int tt = 0; tt < 8; ++tt) {
            const int tk = wave * 8 + tt; const LAS float* S = impS + tk * IMP_STRIDE; const LAS float* C = impC + tk * IMP_STRIDE;
            const int j0 = lane, j1 = 64 + lane;
            const float v0 = S[j0] + (j0 > 0 ? C[j0 - 1] : 0.f), v1 = S[j1] + C[j1 - 1];
            const bool c0 = (j0 >= 1) && (j0 <= qblk - 2), c1 = (j1 <= qblk - 2);
            const unsigned k0 = c0 ? __float_as_uint(v0) + 1u : 0u, k1 = c1 ? __float_as_uint(v1) + 1u : 0u;
            unsigned prefix = 0u;
#pragma unroll 1
            for (int bit = 31; bit >= 0; --bit) { const unsigned trial = prefix | (1u << bit);
                const int cnt = __popcll(__ballot(k0 >= trial)) + __popcll(__ballot(k1 >= trial));
                if (cnt >= 13) prefix = trial; }
            const int G = __popcll(__ballot(k0 > prefix)) + __popcll(__ballot(k1 > prefix)); const int need = 13 - G;
            const unsigned long long e0 = __ballot(k0 == prefix), e1 = __ballot(k1 == prefix);
            const unsigned long long lt = (1ull << lane) - 1ull;
            const int rk0 = __popcll(e0 & lt), rk1 = __popcll(e0) + __popcll(e1 & lt);
            const bool s0 = (k0 > prefix) || (k0 == prefix && rk0 < need) || j0 == 0 || j0 == qblk || j0 == qblk - 1;
            const bool s1 = (k1 > prefix) || (k1 == prefix && rk1 < need) || j1 == qblk || j1 == qblk - 1;
            const unsigned long long m0 = __ballot(s0), m1 = __ballot(s1);
            if (lane == 0) { selm[tk * 4 + 0] = (unsigned)m0; selm[tk * 4 + 1] = (unsigned)(m0 >> 32); selm[tk * 4 + 2] = (unsigned)m1; selm[tk * 4 + 3] = (unsigned)(m1 >> 32); }
        }
    } else {
        if (tid < 256) selm[tid] = 0xffffffffu;
    }
    __syncthreads();
    const unsigned sm0 = selm[tl * 4 + 0], sm1 = selm[tl * 4 + 1], sm2 = selm[tl * 4 + 2], sm3 = selm[tl * 4 + 3];
    at_axpy_rows<true>(fc.o, gate_c, W);

    {
        Flash fs; flash_init(fs);
        at_load(ksl, 0, tid, kr); at_load(vsl, 0, tid, vr);
        for (int ti = 0; ti <= qblk; ++ti, ++it) {
            LAS unsigned char* kb = KB + (it & 1) * 8192; LAS unsigned char* vb = VB + (it & 1) * 8192;
            at_store_k(kb, tid, kr); at_store_v(vb, tid, vr); __syncthreads();
            if (ti < qblk) { at_load(ksl, ti + 1, tid, kr); at_load(vsl, ti + 1, tid, vr); }
            at_qk(kb, qf, r32, hh, p0, p1);
            const unsigned wsel = ti < 32 ? sm0 : ti < 64 ? sm1 : ti < 96 ? sm2 : sm3;
            if (!((wsel >> (ti & 31)) & 1u)) {
#pragma unroll
                for (int r = 0; r < 16; ++r) { p0[r] = NEGINF; p1[r] = NEGINF; } }
            if (ti == qblk) at_mask<true>(p0, p1, tl, hh);
            flash_update<true>(fs, p0, p1, W);
            at_pv(vb, p0, p1, fs.o, lane);
        }
        const f32x2 ls = lds_swap(fs.l); const float l = ls[0] + ls[1];
        at_axpy_rows<false>(fs.o, gate_s / fmaxf(l, 1e-30f), W);
    }
    {
        Flash fw; flash_init(fw);
        const int tb = qblk >= 8 ? qblk - 8 : 0;
        at_load(kwl, tb, tid, kr); at_load(vwl, tb, tid, vr);
        for (int ti = tb; ti <= qblk; ++ti, ++it) {
            LAS unsigned char* kb = KB + (it & 1) * 8192; LAS unsigned char* vb = VB + (it & 1) * 8192;
            at_store_k(kb, tid, kr); at_store_v(vb, tid, vr); __syncthreads();
            if (ti < qblk) { at_load(kwl, ti + 1, tid, kr); at_load(vwl, ti + 1, tid, vr); }
            at_qk(kb, qf, r32, hh, p0, p1);
            if (ti == qblk - 8) at_mask<false>(p0, p1, tl, hh);
            if (ti == qblk) at_mask<true>(p0, p1, tl, hh);
            flash_update<true>(fw, p0, p1, W);
            at_pv(vb, p0, p1, fw.o, lane);
        }
        const f32x2 ls = lds_swap(fw.l); const float l = ls[0] + ls[1];
        at_axpy_rows<false>(fw.o, gate_w / fmaxf(l, 1e-30f), W);
    }
    { const int q = lane >> 1, hf = lane & 1; const LAS float* src = W.ot + q * OT_STRIDE + hf * 32; const int tq = qblk * 64 + wave * 8 + (q >> 2);
      bf16_t* dst = Qb + ((size_t)(b * SEQ + tq) * 16 + g * 4 + (q & 3)) * 64 + hf * 32;
#pragma unroll
      for (int c = 0; c < 4; ++c) { const f32x4 a = *(const LAS f32x4*)(src + 8 * c), d = *(const LAS f32x4*)(src + 8 * c + 4);
          *(u32x4*)(dst + 8 * c) = (u32x4){pk2(a.x, a.y), pk2(a.z, a.w), pk2(d.x, d.y), pk2(d.z, d.w)}; } }
    __syncthreads();
}
DI void attn_phase(Frame& F) {
    int it = 0;
    if (F.G == 256) {
        const int bg = F.vcu >> 4, s = F.vcu & 15;
#pragma unroll 1
        for (int i = 0; i < 8; ++i) { const int base = (i >> 1) * 32; const int qblk = (i & 1) ? base + 31 - s : base + s; attn_unit(F, bg, 127 - qblk, it); }
    } else {
#pragma unroll 1
        for (int u = F.vcu; u < 2048; u += F.G) attn_unit(F, u >> 7, 127 - (u & 127), it);
    }
}

constexpr int NPHASE = 18;
__global__ void __launch_bounds__(NTHR, 2) fwd_kernel(Args args) {
    extern __shared__ __attribute__((aligned(16))) unsigned char lds_raw[];
    cg::grid_group grid = cg::this_grid();
    Frame F;
    F.lds = (LAS unsigned char*)lds_raw;
    F.tid = threadIdx.x; F.lane = F.tid & 63; F.wave = __builtin_amdgcn_readfirstlane(F.tid >> 6);
    F.G = gridDim.x; { const int bx = blockIdx.x; F.vcu = (F.G % 8 == 0) ? (bx % 8) * (F.G / 8) + bx / 8 : bx; }
    F.in = args.in; F.out = args.out; F.ws = args.ws;
    unsigned char* ws = args.ws;
    const int lo = args.ph_lo, hi = args.ph_hi;
#ifndef PHMASK
#define PHMASK 0xFFFFFFFFu
#endif
#define IN(k) (((PHMASK >> (k)) & 1u) && lo <= (k) && (k) < hi)
#define SEAM(k) do { if (IN(k) && IN((k) + 1)) grid.sync(); } while (0)

    if (IN(0)) { p0_prep(F); } SEAM(0);
    if (IN(1)) { GemmPlain g; g.A = (const char*)(ws + WS_XB); g.K = 1024; g.lda2 = 2048; g.ldb2 = 2048; g.Bt = (const char*)(ws + WS_W0IN); g.ord.init(T, L0N, F.G, (int)blockIdx.x);
        g.C = (bf16_t*)(ws + WS_Z); g.ldc = L0N; pg8::gemm_phase(F.lds, g); } SEAM(1);
    if (IN(2)) { for (int u = F.vcu; u < 512; u += F.G) lru_tile<false>(F, u >> 7, u & 127); } SEAM(2);
    if (IN(3)) { for (int u = F.vcu; u < 512; u += F.G) lru_tile<true>(F, u >> 7, u & 127); } SEAM(3);
    if (IN(4)) { GemmResid g; g.A = (const char*)(ws + WS_XB); g.K = 1024; g.lda2 = 2048; g.ldb2 = 2048; g.Bt = (const char*)(ws + WS_W0OUT); g.ord.init(T, D, F.G, (int)blockIdx.x);
        g.res = F.in[0]; g.out = F.out; pg8::gemm_phase(F.lds, g); } SEAM(4);
#define MOE_LAYER(layer, pb, SC, WB) do { \
        if (IN(pb)) { ln_router_phase<SC>(F, layer); } SEAM(pb); \
        if (IN((pb) + 1)) { MoeTab tab = moe_tables(F, layer); \
            GemmMoeUp g; g.A = (const char*)(ws + WS_XB); g.K = 1024; g.lda2 = 2048; g.ldb2 = 2048; g.Bt = (const char*)(ws + ((layer) ? WS_WGU1 : WS_WGU0)); g.G = F.G; g.c = (int)blockIdx.x; \
            g.tab = tab; g.list = (const unsigned*)(ws + WS_LIST); g.H = (bf16_t*)(ws + WS_H); pg8::gemm_phase(F.lds, g); } SEAM((pb) + 1); \
        if (IN((pb) + 2)) { MoeTab tab = moe_tables(F, layer); \
            GemmMoeDown g; g.A = (const char*)(ws + WS_H); g.K = 512; g.lda2 = 1024; g.ldb2 = 1024; g.Bt = (const char*)(ws + ((layer) ? WS_WD1 : WS_WD0)); g.G = F.G; g.c = (int)blockIdx.x; \
            g.tab = tab; g.list = (const unsigned*)(ws + WS_LIST); g.wslot = (const float*)(ws + WS_WSLOT); g.Y = (bf16_t*)(ws + WS_Y); pg8::gemm_phase(F.lds, g); } SEAM((pb) + 2); \
        if (IN((pb) + 3)) { ln2_phase<WB>(F, layer); } } while (0)
    MOE_LAYER(0, 5, false, true); SEAM(8);
    if (IN(9)) { GemmL1In g; g.A = (const char*)(ws + WS_XB); g.K = 1024; g.lda2 = 2048; g.ldb2 = 2048; g.Bt = (const char*)(ws + WS_W1IN); g.ord.init(T, L1NP, F.G, (int)blockIdx.x);
        g.Q = (bf16_t*)(ws + WS_Q); g.KV = ws + WS_KV; g.gates = (float*)(ws + WS_GATES); g.cosT = (const float*)(ws + WS_COS); g.sinT = (const float*)(ws + WS_SIN); pg8::gemm_phase(F.lds, g); } SEAM(9);
    if (IN(10)) { GemmCmp1 g; g.A = (const char*)(ws + WS_KV); g.K = 2048; g.lda2 = 2048; g.ldb2 = 4096; g.Bt = (const char*)(ws + WS_WC1); g.G = F.G; g.c = (int)blockIdx.x;
        g.cbias = (const float*)(ws + WS_SMALL + SM_CBIAS); g.Hd = (bf16_t*)(ws + WS_CMPH); pg8::gemm_phase(F.lds, g); } SEAM(10);
    if (IN(11)) { GemmCmp2 g; g.A = (const char*)(ws + WS_CMPH); g.K = 256; g.lda2 = 512; g.ldb2 = 512; g.Bt = (const char*)(ws + WS_WC2); g.G = F.G; g.c = (int)blockIdx.x;
        g.O = (bf16_t*)(ws + WS_CMPO); pg8::gemm_phase(F.lds, g); } SEAM(11);
    if (IN(12)) { attn_phase(F); } SEAM(12);
    if (IN(13)) { GemmResid g; g.A = (const char*)(ws + WS_Q); g.K = 1024; g.lda2 = 2048; g.ldb2 = 2048; g.Bt = (const char*)(ws + WS_W1OUT); g.ord.init(T, D, F.G, (int)blockIdx.x);
        g.res = F.out; g.out = F.out; pg8::gemm_phase(F.lds, g); } SEAM(13);
    MOE_LAYER(1, 14, false, false);
#undef MOE_LAYER
#undef IN
#undef SEAM
}

extern "C" void kernel_launch(void* const* d_in, const int* in_sizes, int n_in, void* d_out, int out_size, void* d_ws, size_t ws_size, hipStream_t stream) {
    static int grid = 0;
    if (grid == 0) {
        if (n_in != 41 || out_size != T * D || ws_size < WS_END) { fprintf(stderr, "kernel_launch: unexpected problem (n_in %d out %d ws %zu, need %zu)\n", n_in, out_size, ws_size, (size_t)WS_END); grid = -1; return; }
        int dev = 0, cus = 0, per_cu = 0;
        hipGetDevice(&dev); hipDeviceGetAttribute(&cus, hipDeviceAttributeMultiprocessorCount, dev);
        hipFuncSetAttribute((const void*)fwd_kernel, hipFuncAttributeMaxDynamicSharedMemorySize, LDS_BYTES);
        hipOccupancyMaxActiveBlocksPerMultiprocessor(&per_cu, (const void*)fwd_kernel, NTHR, LDS_BYTES);
        if (per_cu < 1) { fprintf(stderr, "kernel_launch: occupancy query says %d blocks/CU\n", per_cu); per_cu = 1; }
        grid = cus * per_cu; if (grid > cus) grid = cus;
        (void)hipGetLastError();
    }
    if (grid < 0) return;
    Args a{};
    for (int i = 0; i < 41; ++i) a.in[i] = (const float*)d_in[i];
    a.out = (float*)d_out; a.ws = (unsigned char*)d_ws; a.ph_lo = 0; a.ph_hi = NPHASE;
    void* kargs[] = {&a};
    hipError_t e = hipLaunchCooperativeKernel((const void*)fwd_kernel, dim3(grid), dim3(NTHR), kargs, LDS_BYTES, stream);
    if (e != hipSuccess) fprintf(stderr, "cooperative launch failed: %s (grid %d)\n", hipGetErrorString(e), grid);
}
```

```cpp
#include <hip/hip_runtime.h>
#include <hip/hip_cooperative_groups.h>
#include <cstdio>
#include <cstdint>
#include <cmath>
namespace cg = cooperative_groups;

#define LAS __attribute__((address_space(3)))
#define DI __device__ __forceinline__
typedef unsigned short bf16_t;
typedef short bf16x8 __attribute__((ext_vector_type(8)));
typedef short s16x4 __attribute__((ext_vector_type(4)));
typedef float f32x2 __attribute__((ext_vector_type(2)));
typedef float f32x4 __attribute__((ext_vector_type(4)));
typedef float f32x16 __attribute__((ext_vector_type(16)));
typedef unsigned u32x2 __attribute__((ext_vector_type(2)));
typedef unsigned u32x4 __attribute__((ext_vector_type(4)));

constexpr int NB = 4, SEQ = 8192, T = NB * SEQ, D = 1024;
constexpr int L0N = 2560;
constexpr int L1N = 2608, L1NP = 2816;
constexpr int NEXP = 32, FF = 512;
constexpr float DN_ALPHA = 1.4142135623730951f;
constexpr float LN_EPS = 1e-5f;
constexpr int NWAVES = 8, NTHR = 512;
constexpr int NCMP = 512;

constexpr size_t MiB = 1u << 20;
constexpr size_t WS_CTL = 0;
constexpr size_t WS_COS = 1 * MiB, WS_SIN = 2 * MiB;
constexpr size_t WS_SMALL = 3 * MiB;
constexpr size_t SM_LRUBT = 0;
constexpr size_t SM_CBIAS = 256 * 1024;
constexpr size_t SM_RWT = 320 * 1024;
constexpr size_t WS_W0IN = 4 * MiB, WS_W0OUT = 9 * MiB, WS_W1IN = 11 * MiB, WS_W1OUT = 17 * MiB;
constexpr size_t WS_WC1 = 19 * MiB;
constexpr size_t WS_WC2 = 21 * MiB;
constexpr size_t WS_LIST = 22 * MiB;
constexpr size_t WS_WSLOT = 26 * MiB;
constexpr size_t WS_POSLOC = WS_WSLOT + 256 * 1024;
constexpr size_t WS_SCAN = 27 * MiB;
constexpr size_t WS_WGU0 = 32 * MiB, WS_WD0 = 96 * MiB, WS_WGU1 = 128 * MiB, WS_WD1 = 192 * MiB;
constexpr size_t WS_ACT = 224 * MiB;
constexpr size_t WS_XB = WS_ACT;
constexpr size_t WS_Z = WS_ACT + 64 * MiB;
constexpr size_t WS_H = WS_ACT + 64 * MiB;
constexpr size_t WS_Y = WS_ACT + 136 * MiB;
constexpr size_t WS_Q = WS_ACT + 64 * MiB;
constexpr size_t WS_KV = WS_ACT + 128 * MiB;
constexpr size_t KV_STRIDE = 17 * MiB;
constexpr size_t WS_GATES = WS_ACT + 232 * MiB;
constexpr size_t WS_CMPH = WS_ACT + 240 * MiB;
constexpr size_t WS_CMPO = WS_ACT + 248 * MiB;
constexpr size_t WS_END = WS_ACT + 280 * MiB;
constexpr int CW_CNT = 64;
constexpr int CW_BAR = 1024;
constexpr int CTL_WORDS = 8192;

DI unsigned f2bf(float f) { unsigned u = __builtin_bit_cast(unsigned, f); return (u + 0x7fffu + ((u >> 16) & 1u)) >> 16; }
DI unsigned pk2(float lo, float hi) { return f2bf(lo) | (f2bf(hi) << 16); }
DI float bf2f(unsigned short b) { return __builtin_bit_cast(float, (unsigned)b << 16); }
DI float bflo(unsigned w) { return __builtin_bit_cast(float, w << 16); }
DI float bfhi(unsigned w) { return __builtin_bit_cast(float, w & 0xffff0000u); }
DI unsigned cvt_pk_bf16(float lo, float hi) { unsigned r; asm volatile("v_cvt_pk_bf16_f32 %0, %1, %2" : "=v"(r) : "v"(lo), "v"(hi)); return r; }
DI float wave_sum(float v) {
#pragma unroll
    for (int o = 1; o < 64; o <<= 1) v += __shfl_xor(v, o);
    return v;
}
DI float sigmoidf_(float x) { return __builtin_amdgcn_rcpf(1.0f + __builtin_amdgcn_exp2f(-1.4426950408889634f * x)); }
DI float gelu_tanh(float x) { const float u = 0.7978845608028654f * (x + 0.044715f * x * x * x); return x * __builtin_amdgcn_rcpf(1.0f + __builtin_amdgcn_exp2f(-2.8853900817779268f * u)); }
#define LDS_WAIT() asm volatile("s_waitcnt lgkmcnt(0)" ::: "memory")

namespace pg8 {
constexpr int BM = 256, BK = 64, HALF = 128, HTB = HALF * BK * 2, STAGE_BYTES = 8 * HTB;
__host__ __device__ __forceinline__ int lds_byte(int r, int c) { const int st = (r >> 4) * 2 + (c >> 5), rr = r & 15, cc = c & 31, ob = rr * 64 + cc * 2; return st * 1024 + (ob ^ (((ob >> 9) & 1) << 5)); }
__host__ __device__ __forceinline__ void stage_rc(int b, int& R, int& C) { const int st = b / 1024, sb = b % 1024, swz = sb ^ (((sb >> 9) & 1) << 5); R = (st >> 1) * 16 + swz / 64; C = (st & 1) * 32 + (swz % 64) / 2; }
__host__ __device__ __forceinline__ int perm32(int rho) { const int n = rho >> 4, i = rho & 15; return 8 * (i >> 2) + 4 * n + (i & 3); }
struct GU { int pm, pn, e; };
template <class P>
__device__ __forceinline__ void gemm_phase(LAS unsigned char* lds, const P& p) {
    const int tid = threadIdx.x, wid = __builtin_amdgcn_readfirstlane(tid >> 6), lane = tid & 63, wr = wid >> 2, wc = wid & 3, fr = lane & 15, fq = lane >> 4;
    const int nt = p.K / BK;
    int Rr[2]; unsigned Cc2[2], voffB[2];
#pragma unroll
    for (int i = 0; i < 2; ++i) { int R, C; stage_rc(tid * 16 + i * 8192, R, C); const int Rb = P::PERM ? ((R & ~31) + perm32(R & 31)) : R;
        Rr[i] = R; Cc2[i] = (unsigned)C * 2u; voffB[i] = (unsigned)Rb * p.ldb2 + (unsigned)C * 2u; }
    const size_t kstep = (size_t)(BK * 2);
    const size_t hstepB = (size_t)HALF * p.ldb2;
    const unsigned ldsw = (unsigned)wid * 1024u;
    const int aoff = lds_byte(wr * 64 + fr, fq * 8), boff = lds_byte(wc * 32 + fr, fq * 8);
#define PG8_SA(b, h) (((b) * 2 + (h)) * HTB)
#define PG8_SB(b, h) ((4 + (b) * 2 + (h)) * HTB)
#define PG8_STAGE(bufoff, gbase, voff) do { _Pragma("unroll") for (int _i = 0; _i < 2; ++_i) \
        __builtin_amdgcn_global_load_lds((const unsigned*)((const char*)(gbase) + (voff)[_i]), (LAS unsigned*)(lds + (bufoff) + ldsw + _i * 8192), 16, 0, 0); } while (0)
#define PG8_LDA(dst, b, h) do { _Pragma("unroll") for (int m = 0; m < 4; ++m) _Pragma("unroll") for (int k = 0; k < 2; ++k) dst[m][k] = *(const LAS bf16x8*)(lds + PG8_SA(b, h) + aoff + m * 2048 + k * 1024); } while (0)
#define PG8_LDB(dst, b, h) do { _Pragma("unroll") for (int n = 0; n < 2; ++n) _Pragma("unroll") for (int k = 0; k < 2; ++k) dst[n][k] = *(const LAS bf16x8*)(lds + PG8_SB(b, h) + boff + n * 2048 + k * 1024); } while (0)
#define PG8_MMA(ai, bj, At, Bt) do { __builtin_amdgcn_s_setprio(1); _Pragma("unroll") for (int m = 0; m < 4; ++m) _Pragma("unroll") for (int n = 0; n < 2; ++n) _Pragma("unroll") for (int k = 0; k < 2; ++k) \
        acc[ai][bj][m][n] = __builtin_amdgcn_mfma_f32_16x16x32_bf16(Bt[n][k], At[m][k], acc[ai][bj][m][n], 0, 0, 0); __builtin_amdgcn_s_setprio(0); } while (0)
#define PG8_WAIT_V(n) asm volatile("s_waitcnt vmcnt(" #n ")" ::: "memory")
#define PG8_WAIT_L(n) asm volatile("s_waitcnt lgkmcnt(" #n ")" ::: "memory")
#define PG8_BAR __builtin_amdgcn_s_barrier()
#define PG8_SCHED __builtin_amdgcn_sched_barrier(0)
    GU cur, nxt; int ui = 0;
    if (!p.next(0, cur)) return;
    f32x4 acc[2][2][4][2];
#pragma unroll
    for (int a = 0; a < 2; ++a)
#pragma unroll
        for (int b = 0; b < 2; ++b)
#pragma unroll
            for (int m = 0; m < 4; ++m)
#pragma unroll
                for (int n = 0; n < 2; ++n) acc[a][b][m][n] = (f32x4){0.f, 0.f, 0.f, 0.f};
    bf16x8 At[4][2], B0[2][2], B1[2][2];
    unsigned cA0[2], cA1[2], nA0[2], nA1[2];
#pragma unroll
    for (int i = 0; i < 2; ++i) { cA0[i] = p.a_row_off(cur, Rr[i]) + Cc2[i]; cA1[i] = p.a_row_off(cur, HALF + Rr[i]) + Cc2[i]; }
    const char* const Ab = p.A;
    const char* cB = p.b_tile(cur);
    PG8_STAGE(PG8_SB(0, 0), cB, voffB); PG8_STAGE(PG8_SB(0, 1), cB + hstepB, voffB); PG8_STAGE(PG8_SA(0, 0), Ab, cA0); PG8_STAGE(PG8_SA(0, 1), Ab, cA1);
    if (wr == 1) PG8_BAR;
    PG8_WAIT_V(2); PG8_BAR;
    PG8_STAGE(PG8_SB(1, 0), cB + kstep, voffB); PG8_STAGE(PG8_SA(1, 0), Ab + kstep, cA0); PG8_STAGE(PG8_SB(1, 1), cB + hstepB + kstep, voffB);
    PG8_WAIT_V(6); PG8_BAR;
    for (;;) {
        const bool has_next = p.next(ui + 1, nxt);
        const char* nB = has_next ? p.b_tile(nxt) : cB;
#pragma unroll
        for (int i = 0; i < 2; ++i) { nA0[i] = has_next ? p.a_row_off(nxt, Rr[i]) + Cc2[i] : cA0[i]; nA1[i] = has_next ? p.a_row_off(nxt, HALF + Rr[i]) + Cc2[i] : cA1[i]; }
        for (int t = 0; t < nt; t += 2) {
            const bool last = (t == nt - 2);
            const char* a1 = Ab + (size_t)(t + 1) * kstep;
            const char* a2 = last ? Ab : Ab + (size_t)(t + 2) * kstep; const char* b2 = last ? nB : cB + (size_t)(t + 2) * kstep;
            const char* a3 = a2 + kstep; const char* b3 = b2 + kstep;
            unsigned o0[2], o1[2];
#pragma unroll
            for (int i = 0; i < 2; ++i) { o0[i] = last ? nA0[i] : cA0[i]; o1[i] = last ? nA1[i] : cA1[i]; }
            PG8_LDB(B0, 0, 0); PG8_LDB(B1, 0, 1); PG8_SCHED; PG8_LDA(At, 0, 0); PG8_STAGE(PG8_SA(1, 1), a1, cA1);
            PG8_WAIT_V(8); PG8_WAIT_L(0); PG8_BAR; PG8_MMA(0, 0, At, B0); PG8_MMA(0, 1, At, B1); PG8_BAR; PG8_SCHED;
            PG8_LDA(At, 0, 1); PG8_STAGE(PG8_SB(0, 0), b2, voffB); PG8_STAGE(PG8_SB(0, 1), b2 + hstepB, voffB); PG8_STAGE(PG8_SA(0, 0), a2, o0);
            PG8_WAIT_V(8); PG8_WAIT_L(0); PG8_BAR; PG8_MMA(1, 0, At, B0); PG8_MMA(1, 1, At, B1); PG8_BAR; PG8_SCHED;
            PG8_LDB(B0, 1, 0); PG8_LDB(B1, 1, 1); PG8_SCHED; PG8_LDA(At, 1, 0); PG8_STAGE(PG8_SA(0, 1), a2, o1);
            PG8_WAIT_V(8); PG8_WAIT_L(0); PG8_BAR; PG8_MMA(0, 0, At, B0); PG8_MMA(0, 1, At, B1); PG8_BAR; PG8_SCHED;
            PG8_LDA(At, 1, 1); PG8_STAGE(PG8_SB(1, 0), b3, voffB); PG8_STAGE(PG8_SB(1, 1), b3 + hstepB, voffB); PG8_STAGE(PG8_SA(1, 0), a3, o0);
            PG8_WAIT_V(8); PG8_WAIT_L(0); PG8_BAR; PG8_MMA(1, 0, At, B0); PG8_MMA(1, 1, At, B1); PG8_BAR; PG8_SCHED;
        }
#ifndef PG8_NOALIGN
        if (wr == 0) PG8_BAR;
#endif
        p.epi(acc, cur, wr, wc, fr, fq);
        if (!has_next) break;
#pragma unroll
        for (int a = 0; a < 2; ++a)
#pragma unroll
            for (int b = 0; b < 2; ++b)
#pragma unroll
                for (int m = 0; m < 4; ++m)
#pragma unroll
                    for (int n = 0; n < 2; ++n) acc[a][b][m][n] = (f32x4){0.f, 0.f, 0.f, 0.f};
        cur = nxt; cB = nB; ++ui;
#pragma unroll
        for (int i = 0; i < 2; ++i) { cA0[i] = nA0[i]; cA1[i] = nA1[i]; }
#ifndef PG8_NOALIGN
        if (wr == 1) PG8_BAR;
#endif
    }
    PG8_WAIT_V(0);
#ifdef PG8_NOALIGN
    if (wr == 0) PG8_BAR;
#endif
    PG8_BAR;
#undef PG8_SA
#undef PG8_SB
#undef PG8_STAGE
#undef PG8_LDA
#undef PG8_LDB
#undef PG8_MMA
#undef PG8_WAIT_V
#undef PG8_WAIT_L
#undef PG8_BAR
#undef PG8_SCHED
}
struct TileOrder {
    int nM, nN, nwg, G, c;
    __device__ void init(int M, int N, int G_, int c_) { nM = M / BM; nN = N / BM; nwg = nM * nN; G = G_; c = c_; }
    __device__ bool next(int i, GU& u) const {
        const long L = (long)i * G + c; if (L >= nwg) return false;
        int wgid = (int)L; { const int q = nwg / 8, r = nwg % 8, xcd = wgid % 8, off = wgid / 8; wgid = (xcd < r ? xcd * (q + 1) : r * (q + 1) + (xcd - r) * q) + off; }
        const int WGM = 8; const int nig = WGM * nN, gid = wgid / nig, fm = gid * WGM, gsz = (nM - fm) < WGM ? (nM - fm) : WGM;
        u.pm = fm + ((wgid % nig) % gsz); u.pn = (wgid % nig) / gsz; u.e = 0; return true;
    }
};
}
using pg8::GU;

struct Args { const float* in[41]; float* out; unsigned char* ws; int ph_lo, ph_hi; };

struct GemmPlain {
    static constexpr bool PERM = true;
    const char* A; int K; unsigned lda2, ldb2; const char* Bt; pg8::TileOrder ord;
    bf16_t* C; int ldc;
    DI bool next(int i, GU& u) const { return ord.next(i, u); }
    DI unsigned a_row_off(const GU& u, int r) const { return (unsigned)(u.pm * 256 + r) * lda2; }
    DI const char* b_tile(const GU& u) const { return Bt + (size_t)u.pn * 256 * ldb2; }
    DI void epi(const f32x4 (&acc)[2][2][4][2], const GU& u, int wr, int wc, int fr, int fq) const {
        const int row0 = u.pm * 256 + wr * 64 + fr, col0 = u.pn * 256 + wc * 32 + 8 * fq;
#pragma unroll
        for (int ai = 0; ai < 2; ++ai)
#pragma unroll
            for (int m = 0; m < 4; ++m) { bf16_t* rowp = C + (size_t)(row0 + ai * 128 + m * 16) * ldc + col0;
#pragma unroll
                for (int bj = 0; bj < 2; ++bj) { const f32x4 v0 = acc[ai][bj][m][0], v1 = acc[ai][bj][m][1];
                    u32x4 w; w.x = cvt_pk_bf16(v0[0], v0[1]); w.y = cvt_pk_bf16(v0[2], v0[3]); w.z = cvt_pk_bf16(v1[0], v1[1]); w.w = cvt_pk_bf16(v1[2], v1[3]);
                    *(u32x4*)(rowp + bj * 128) = w; } }
    }
};
template <bool RES32>
struct GemmResid {
    static constexpr bool PERM = true;
    const char* A; int K; unsigned lda2, ldb2; const char* Bt; pg8::TileOrder ord;
    const float* res32; const bf16_t* res16; bf16_t* out;
    DI bool next(int i, GU& u) const { return ord.next(i, u); }
    DI unsigned a_row_off(const GU& u, int r) const { return (unsigned)(u.pm * 256 + r) * lda2; }
    DI const char* b_tile(const GU& u) const { return Bt + (size_t)u.pn * 256 * ldb2; }
    DI void epi(const f32x4 (&acc)[2][2][4][2], const GU& u, int wr, int wc, int fr, int fq) const {
        const int col0 = u.pn * 256 + wc * 32 + 8 * fq; const size_t rbase = (size_t)(u.pm * 256 + wr * 64 + fr) * D + col0;
        if constexpr (RES32) {
#pragma unroll
            for (int ai = 0; ai < 2; ++ai) {
                f32x4 r[4][2][2];
#pragma unroll
                for (int m = 0; m < 4; ++m)
#pragma unroll
                    for (int bj = 0; bj < 2; ++bj) { const float* rp = res32 + rbase + (size_t)(ai * 128 + m * 16) * D + bj * 128; r[m][bj][0] = *(const f32x4*)rp; r[m][bj][1] = *(const f32x4*)(rp + 4); }
#pragma unroll
                for (int m = 0; m < 4; ++m)
#pragma unroll
                    for (int bj = 0; bj < 2; ++bj) { const f32x4 v0 = r[m][bj][0] * DN_ALPHA + acc[ai][bj][m][0], v1 = r[m][bj][1] * DN_ALPHA + acc[ai][bj][m][1];
                        u32x4 w; w.x = cvt_pk_bf16(v0[0], v0[1]); w.y = cvt_pk_bf16(v0[2], v0[3]); w.z = cvt_pk_bf16(v1[0], v1[1]); w.w = cvt_pk_bf16(v1[2], v1[3]);
                        *(u32x4*)(out + rbase + (size_t)(ai * 128 + m * 16) * D + bj * 128) = w; }
            }
        } else {
            u32x4 r[2][4][2];
#pragma unroll
            for (int ai = 0; ai < 2; ++ai)
#pragma unroll
                for (int m = 0; m < 4; ++m)
#pragma unroll
                    for (int bj = 0; bj < 2; ++bj) r[ai][m][bj] = *(const u32x4*)(res16 + rbase + (size_t)(ai * 128 + m * 16) * D + bj * 128);
#pragma unroll
            for (int ai = 0; ai < 2; ++ai)
#pragma unroll
                for (int m = 0; m < 4; ++m)
#pragma unroll
                    for (int bj = 0; bj < 2; ++bj) { const u32x4 q = r[ai][m][bj]; const f32x4 a0 = acc[ai][bj][m][0], a1 = acc[ai][bj][m][1];
                        u32x4 w; w.x = cvt_pk_bf16(bflo(q.x) * DN_ALPHA + a0[0], bfhi(q.x) * DN_ALPHA + a0[1]); w.y = cvt_pk_bf16(bflo(q.y) * DN_ALPHA + a0[2], bfhi(q.y) * DN_ALPHA + a0[3]);
                        w.z = cvt_pk_bf16(bflo(q.z) * DN_ALPHA + a1[0], bfhi(q.z) * DN_ALPHA + a1[1]); w.w = cvt_pk_bf16(bflo(q.w) * DN_ALPHA + a1[2], bfhi(q.w) * DN_ALPHA + a1[3]);
                        *(u32x4*)(out + rbase + (size_t)(ai * 128 + m * 16) * D + bj * 128) = w; }
        }
    }
};
struct MoeTab { const LAS int* tbase; const LAS int* cnt; int ntiles; };
struct GemmMoeUp {
    static constexpr bool PERM = true;
    const char* A; int K; unsigned lda2, ldb2; const char* Bt; int G, c;
    MoeTab tab; const unsigned* list; bf16_t* H;
    DI bool next(int i, GU& u) const {
        const int L = i * G + c; if (L >= tab.ntiles * 4) return false;
        const int tile = L >> 2; u.pn = L & 3; int e = 0;
#pragma unroll 1
        while (tab.tbase[e + 1] <= tile) ++e;
        u.e = e; u.pm = tile - tab.tbase[e]; return true;
    }
    DI unsigned a_row_off(const GU& u, int r) const {
        const int li = u.pm * 256 + r; const int cn = tab.cnt[u.e];
        const unsigned slot = li < cn ? list[(size_t)u.e * T + li] : 0u;
        return (slot >> 1) * lda2;
    }
    DI const char* b_tile(const GU& u) const { return Bt + ((size_t)u.e * 1024 + (size_t)u.pn * 256) * ldb2; }
    DI void epi(const f32x4 (&acc)[2][2][4][2], const GU& u, int wr, int wc, int fr, int fq) const {
        const int hrow0 = (tab.tbase[u.e] + u.pm) * 256 + wr * 64 + fr, col0 = u.pn * 128 + wc * 32 + 8 * fq;
#pragma unroll
        for (int ai = 0; ai < 2; ++ai)
#pragma unroll
            for (int m = 0; m < 4; ++m) { bf16_t* rowp = H + (size_t)(hrow0 + ai * 128 + m * 16) * FF + col0;
                float h[8];
#pragma unroll
                for (int n = 0; n < 2; ++n)
#pragma unroll
                    for (int j = 0; j < 4; ++j) { const float g = acc[ai][0][m][n][j], uu = acc[ai][1][m][n][j]; h[n * 4 + j] = g * uu / (1.0f + __expf(-g)); }
                u32x4 w; w.x = cvt_pk_bf16(h[0], h[1]); w.y = cvt_pk_bf16(h[2], h[3]); w.z = cvt_pk_bf16(h[4], h[5]); w.w = cvt_pk_bf16(h[6], h[7]);
                *(u32x4*)rowp = w; }
    }
};
struct GemmMoeDown {
    static constexpr bool PERM = true;
    const char* A; int K; unsigned lda2, ldb2; const char* Bt; int G, c;
    MoeTab tab; bf16_t* Y;
    DI bool next(int i, GU& u) const {
        const int L = i * G + c; if (L >= tab.ntiles * 4) return false;
        const int tile = L >> 2; u.pn = L & 3; int e = 0;
#pragma unroll 1
        while (tab.tbase[e + 1] <= tile) ++e;
        u.e = e; u.pm = tile - tab.tbase[e]; return true;
    }
    DI unsigned a_row_off(const GU& u, int r) const { return (unsigned)((tab.tbase[u.e] + u.pm) * 256 + r) * lda2; }
    DI const char* b_tile(const GU& u) const { return Bt + ((size_t)u.e * 1024 + (size_t)u.pn * 256) * ldb2; }
    DI void epi(const f32x4 (&acc)[2][2][4][2], const GU& u, int wr, int wc, int fr, int fq) const {
        const int row0 = (tab.tbase[u.e] + u.pm) * 256 + wr * 64 + fr, col0 = u.pn * 256 + wc * 32 + 8 * fq;
#pragma unroll
        for (int ai = 0; ai < 2; ++ai)
#pragma unroll
            for (int m = 0; m < 4; ++m) { bf16_t* rowp = Y + (size_t)(row0 + ai * 128 + m * 16) * D + col0;
#pragma unroll
                for (int bj = 0; bj < 2; ++bj) { const f32x4 v0 = acc[ai][bj][m][0], v1 = acc[ai][bj][m][1];
                    u32x4 w; w.x = cvt_pk_bf16(v0[0], v0[1]); w.y = cvt_pk_bf16(v0[2], v0[3]); w.z = cvt_pk_bf16(v1[0], v1[1]); w.w = cvt_pk_bf16(v1[2], v1[3]);
                    *(u32x4*)(rowp + bj * 128) = w; } }
    }
};

#define XB_TMO      128
#define XB_XCNT(j)  (256  + 64 * (j))
#define XB_XSUB(j)  (1280 + 64 * (j))
#define XB_XGEN(j)  (2304 + 64 * (j))
#define XB_TOP      3328
#define XB_TOPGEN   3392
#define XCD_BAR_WORDS 3456
#define XB_SPIN_CAP (1u << 18)
__device__ __forceinline__ unsigned xb_ld(unsigned* p)              { return __hip_atomic_load(p, __ATOMIC_RELAXED, __HIP_MEMORY_SCOPE_AGENT); }
__device__ __forceinline__ unsigned xb_add(unsigned* p, unsigned v) { return __hip_atomic_fetch_add(p, v, __ATOMIC_RELAXED, __HIP_MEMORY_SCOPE_AGENT); }
__device__ __forceinline__ unsigned xb_xcc_id() { return (unsigned)__builtin_amdgcn_s_getreg((3 << 11) | 20) & 0xFu; }
#define XB_SPIN(cond, bar) do { unsigned _sp = 0; while (cond) { __builtin_amdgcn_s_sleep(1); \
    if ((++_sp & 255u) == 0u) { if (xb_ld(&(bar)[XB_TMO])) break; if (_sp > XB_SPIN_CAP) { atomicAdd(&(bar)[XB_TMO], 1u); break; } } } } while (0)
struct XcdBarrier { unsigned* bar; unsigned x; volatile LAS unsigned* st; };
__device__ __forceinline__ XcdBarrier xcd_barrier_post(unsigned* bar, volatile LAS unsigned* st) {
    XcdBarrier b; b.bar = bar; b.x = xb_xcc_id(); b.st = st;
    if (threadIdx.x == 0) (void)xb_add(&bar[XB_XCNT(b.x)], 1u);
    return b;
}
__device__ __forceinline__ void xcd_barrier_complete(unsigned* bar, unsigned x, unsigned& nloc, unsigned& nx) {
    const unsigned G = gridDim.x * gridDim.y * gridDim.z;
    unsigned sum, cnt, mine, sp = 0u;
    for (;;) {
        sum = 0u; cnt = 0u; mine = 0u;
#pragma unroll
        for (unsigned j = 0; j < 16; ++j) { const unsigned c = xb_ld(&bar[XB_XCNT(j)]); sum += c; cnt += (c > 0u) ? 1u : 0u; mine = (j == x) ? c : mine; }
        if (sum == G) break;
        __builtin_amdgcn_s_sleep(1);
        if ((++sp & 255u) == 0u) { if (xb_ld(&bar[XB_TMO])) break; if (sp > XB_SPIN_CAP) { atomicAdd(&bar[XB_TMO], 1u); break; } }
    }
    nloc = mine > 0u ? mine : 1u; nx = cnt > 0u ? cnt : 1u;
}
__device__ __forceinline__ void xcd_barrier(const XcdBarrier& b) {
    asm volatile("s_waitcnt vmcnt(0)" ::: "memory");
    __syncthreads();
    if (threadIdx.x == 0) {
        unsigned* bar = b.bar;
        __builtin_amdgcn_s_waitcnt(0);
        unsigned nloc = b.st[0], nx = b.st[1];
        if (nloc == 0u) { xcd_barrier_complete(bar, b.x, nloc, nx); b.st[0] = nloc; b.st[1] = nx; }
        const unsigned old = xb_add(&bar[XB_XSUB(b.x)], 1u);
        const unsigned gen = old / nloc;
        if (old + 1u == (gen + 1u) * nloc) {
            __builtin_amdgcn_fence(__ATOMIC_RELEASE, "agent");
            asm volatile("s_waitcnt vmcnt(0)" ::: "memory");
            const unsigned og = xb_add(&bar[XB_TOP], 1u);
            const unsigned tg = og / nx;
            if (og + 1u == (tg + 1u) * nx) xb_add(&bar[XB_TOPGEN], 1u);
            else XB_SPIN(xb_ld(&bar[XB_TOPGEN]) == tg, bar);
            __builtin_amdgcn_fence(__ATOMIC_ACQUIRE, "agent");
            xb_add(&bar[XB_XGEN(b.x)], 1u);
            asm volatile("s_waitcnt vmcnt(0)" ::: "memory");
        } else {
            XB_SPIN(xb_ld(&bar[XB_XGEN(b.x)]) == gen, bar);
            __builtin_amdgcn_fence(__ATOMIC_ACQUIRE, "agent");
            asm volatile("s_waitcnt vmcnt(0)" ::: "memory");
        }
    }
    __syncthreads();
}

struct Frame {
    LAS unsigned char* lds;
    int tid, lane, wave, vcu, G;
    const float* const* in; float* out; unsigned char* ws;
};
constexpr int LDS_RING = 131072;
constexpr int LDS_MISC = LDS_RING;
constexpr int LDS_BYTES = 147456;

template <class Map>
DI void p0_transpose_item(const float* W, int K, int N, bf16_t* WT, const Map& map, LAS float* scr, int item, int lane) {
    const int nblk = (N + 31) / 32, kb = item / nblk, nb = item % nblk, k0 = 64 * kb, n0 = 32 * nb;
    const bool nok = (n0 + (lane & 31)) < N;
#pragma unroll 8
    for (int i = 0; i < 32; ++i) { const int kk = 2 * i + (lane >> 5); scr[kk * 33 + (lane & 31)] = nok ? W[(size_t)(k0 + kk) * N + n0 + (lane & 31)] : 0.f; }
    LDS_WAIT(); asm volatile("" ::: "memory");
    const int c = lane & 7;
#pragma unroll
    for (int j = 0; j < 4; ++j) { const int n = (lane >> 3) + 8 * j; const LAS float* s = scr + (8 * c) * 33 + n;
        u32x4 o; o.x = pk2(s[0 * 33], s[1 * 33]); o.y = pk2(s[2 * 33], s[3 * 33]); o.z = pk2(s[4 * 33], s[5 * 33]); o.w = pk2(s[6 * 33], s[7 * 33]);
        if (n0 + n < N) *(u32x4*)(WT + (size_t)map(n0 + n) * K + k0 + 8 * c) = o; }
    LDS_WAIT(); asm volatile("" ::: "memory");
}
struct MapId { int off; DI int operator()(int n) const { return n + off; } };
DI int rope_perm(int d) { return (d & 15) | ((d & 16) << 1) | ((d & 32) >> 1); }
struct MapL1In { DI int operator()(int n) const {
    if (n < 1024) return (n & ~63) | rope_perm(n & 63);
    if (n < 2560) { const int j = (n - 1024) >> 8; return (j & 1) ? n : ((n & ~63) | rope_perm(n & 63)); }
    return n; } };
struct MapGU { int up; DI int operator()(int c) const { return (c >> 7) * 256 + up * 128 + (c & 127); } };

DI void p0_prep(Frame& F) {
    LAS float* scr = (LAS float*)(F.lds + F.wave * 16384);
    const int gw = F.vcu * NWAVES + F.wave, NGW = F.G * NWAVES;
    const int gt = F.vcu * NTHR + F.tid, NGT = F.G * NTHR;
    unsigned char* ws = F.ws;
    for (int i = gt; i < CTL_WORDS; i += NGT) ((unsigned*)(ws + WS_CTL))[i] = 0u;
    constexpr int I_W0IN = 16 * 80, I_W0OUT = 16 * 32, I_W1IN = 16 * 82, I_W1OUT = 16 * 32, I_WC1 = 32 * 8, I_WC2 = 4 * 2, I_MOE = 32 * 256;
    constexpr int NITEMS = I_W0IN + I_W0OUT + I_W1IN + I_W1OUT + 2 * I_WC1 + 2 * I_WC2 + 6 * I_MOE;
    for (int it = gw; it < NITEMS; it += NGW) {
        int r = it;
        if (r < I_W0IN) { p0_transpose_item(F.in[1], 1024, L0N, (bf16_t*)(ws + WS_W0IN), MapId{0}, scr, r, F.lane); continue; } r -= I_W0IN;
        if (r < I_W0OUT) { p0_transpose_item(F.in[10], 1024, 1024, (bf16_t*)(ws + WS_W0OUT), MapId{0}, scr, r, F.lane); continue; } r -= I_W0OUT;
        if (r < I_W1IN) { p0_transpose_item(F.in[22], 1024, L1N, (bf16_t*)(ws + WS_W1IN), MapL1In{}, scr, r, F.lane); continue; } r -= I_W1IN;
        if (r < I_W1OUT) { p0_transpose_item(F.in[29], 1024, 1024, (bf16_t*)(ws + WS_W1OUT), MapId{0}, scr, r, F.lane); continue; } r -= I_W1OUT;
        if (r < I_WC1) { p0_transpose_item(F.in[24], 2048, 256, (bf16_t*)(ws + WS_WC1), MapId{0}, scr, r, F.lane); continue; } r -= I_WC1;
        if (r < I_WC1) { p0_transpose_item(F.in[27], 2048, 256, (bf16_t*)(ws + WS_WC1) + 256 * 2048, MapId{0}, scr, r, F.lane); continue; } r -= I_WC1;
        if (r < I_WC2) { p0_transpose_item(F.in[25], 256, 64, (bf16_t*)(ws + WS_WC2), MapId{0}, scr, r, F.lane); continue; } r -= I_WC2;
        if (r < I_WC2) { p0_transpose_item(F.in[28], 256, 64, (bf16_t*)(ws + WS_WC2) + 256 * 256, MapId{0}, scr, r, F.lane); continue; } r -= I_WC2;
#pragma unroll 1
        for (int l = 0; l < 2; ++l) {
            const int ib = l ? 36 : 17; bf16_t* wgu = (bf16_t*)(ws + (l ? WS_WGU1 : WS_WGU0)); bf16_t* wd = (bf16_t*)(ws + (l ? WS_WD1 : WS_WD0));
            if (r < I_MOE) { const int e = r >> 8; p0_transpose_item(F.in[ib] + (size_t)e * 1024 * 512, 1024, 512, wgu + (size_t)e * 1024 * 1024, MapGU{0}, scr, r & 255, F.lane); r = -1; break; } r -= I_MOE;
            if (r < I_MOE) { const int e = r >> 8; p0_transpose_item(F.in[ib + 1] + (size_t)e * 1024 * 512, 1024, 512, wgu + (size_t)e * 1024 * 1024, MapGU{1}, scr, r & 255, F.lane); r = -1; break; } r -= I_MOE;
            if (r < I_MOE) { const int e = r >> 8; p0_transpose_item(F.in[ib + 2] + (size_t)e * 512 * 1024, 512, 1024, wd + (size_t)e * 1024 * 512, MapId{0}, scr, r & 255, F.lane); r = -1; break; } r -= I_MOE;
        }
    }
    { u32x4 z = (u32x4){0u, 0u, 0u, 0u};
      u32x4* p1 = (u32x4*)((bf16_t*)(ws + WS_W1IN) + (size_t)L1N * 1024); const int n1 = (L1NP - L1N) * 1024 / 8;
      for (int i = gt; i < n1; i += NGT) p1[i] = z;
      for (int kv = 0; kv < 2; ++kv) { u32x4* p2 = (u32x4*)((bf16_t*)(ws + WS_WC2) + (size_t)kv * 65536 + 64 * 256); const int n2 = 192 * 256 / 8; for (int i = gt; i < n2; i += NGT) p2[i] = z; } }
    { const float* x = F.in[0]; bf16_t* xb = (bf16_t*)(ws + WS_XB);
      for (int m = gw; m < T; m += NGW) { const f32x4* xr = (const f32x4*)(x + (size_t)m * D) + F.lane; u32x2* o = (u32x2*)(xb + (size_t)m * D) + F.lane;
#pragma unroll
          for (int j = 0; j < 4; ++j) { const f32x4 v = xr[64 * j]; o[64 * j] = (u32x2){pk2(v.x, v.y), pk2(v.z, v.w)}; } } }
    { float* ct = (float*)(ws + WS_COS); float* st = (float*)(ws + WS_SIN);
      for (int i = gt; i < SEQ * 32; i += NGT) { const int pos = i >> 5, k = i & 31; const float inv = (float)pow(10000.0, -(double)(2 * k) / 64.0); const float ang = (float)pos * inv;
          ct[i] = (float)cos((double)ang); st[i] = (float)sin((double)ang); } }
    { bf16_t* bt = (bf16_t*)(ws + WS_SMALL + SM_LRUBT);
      for (int i = gt; i < 2 * 8 * 4096; i += NGT) { const int g = i >> 15, h = (i >> 12) & 7, j = (i >> 6) & 63, ii = i & 63; const float* w = F.in[g ? 7 : 5];
          bt[i] = (bf16_t)f2bf(w[h * 4096 + ii * 64 + j]); } }
    { float* rw = (float*)(ws + WS_SMALL + SM_RWT);
      for (int i = gt; i < 2 * 36 * 1024; i += NGT) { const int l = i / (36 * 1024), o = (i / 1024) % 36, k = i & 1023; const float* wg = F.in[l ? 32 : 13]; const float* we = F.in[l ? 34 : 15];
          rw[i] = o < 4 ? wg[k * 4 + o] : we[k * 32 + (o - 4)]; } }
    { float* cb = (float*)(ws + WS_SMALL + SM_CBIAS);
      for (int o = gw; o < 512; o += NGW) { const int kv = o >> 8, j = o & 255; const float* pe = F.in[kv ? 26 : 23]; const float* w1 = F.in[kv ? 27 : 24];
          float s = 0.f; for (int k = F.lane; k < 2048; k += 64) s += pe[k] * w1[(size_t)k * 256 + j];
          s = wave_sum(s); if (F.lane == 0) cb[o] = s; } }
}

constexpr int XCL_STRIDE = 520;
constexpr int LDS_XC = 0, LDS_GT = 66560, LDS_HIN = 133120;
DI f32x2 lds_swap(float v) { auto rr = __builtin_amdgcn_permlane32_swap(__float_as_uint(v), __float_as_uint(v), false, false); return (f32x2){__uint_as_float(rr[0]), __uint_as_float(rr[1])}; }

template <bool FINAL>
DI void lru_tile(Frame& F, int b, int ch) {
    const unsigned char* ws = F.ws;
    const bf16_t* z = (const bf16_t*)(ws + WS_Z);
    bf16_t* ycat = (bf16_t*)(ws + WS_XB);
    f32x2* SAH = (f32x2*)(ws + WS_SCAN);
    LAS bf16_t* xcL = (LAS bf16_t*)(F.lds + LDS_XC); LAS bf16_t* gL = (LAS bf16_t*)(F.lds + LDS_GT); LAS float* hin = (LAS float*)(F.lds + LDS_HIN);
    const int tid = F.tid, lane = F.lane, wave = F.wave;
    const int t0 = ch * 64; const size_t row0 = (size_t)b * SEQ + t0;
    const int c8 = tid & 63, tg = tid >> 6;
    {
        float w[4][8], bias[8];
        const float* cw = F.in[3]; const float* cbv = F.in[4];
#pragma unroll
        for (int k = 0; k < 4; ++k)
#pragma unroll
            for (int j = 0; j < 8; ++j) w[k][j] = cw[k * 512 + c8 * 8 + j];
#pragma unroll
        for (int j = 0; j < 8; ++j) bias[j] = cbv[c8 * 8 + j];
        float xv[11][8];
#pragma unroll
        for (int i = 0; i < 11; ++i) { const int t = t0 + tg * 8 + i - 3;
            if (t >= 0) { const u32x4 v = *(const u32x4*)(z + ((size_t)b * SEQ + t) * L0N + 2048 + c8 * 8);
                xv[i][0] = bflo(v.x); xv[i][1] = bfhi(v.x); xv[i][2] = bflo(v.y); xv[i][3] = bfhi(v.y); xv[i][4] = bflo(v.z); xv[i][5] = bfhi(v.z); xv[i][6] = bflo(v.w); xv[i][7] = bfhi(v.w); }
            else {
#pragma unroll
                for (int j = 0; j < 8; ++j) xv[i][j] = 0.f; } }
#pragma unroll
        for (int i = 0; i < 8; ++i) { float o[8];
#pragma unroll
            for (int j = 0; j < 8; ++j) o[j] = bias[j] + w[0][j] * xv[i][j] + w[1][j] * xv[i + 1][j] + w[2][j] * xv[i + 2][j] + w[3][j] * xv[i + 3][j];
            u32x4 pk; pk.x = pk2(o[0], o[1]); pk.y = pk2(o[2], o[3]); pk.z = pk2(o[4], o[5]); pk.w = pk2(o[6], o[7]);
            *(LAS u32x4*)(xcL + (tg * 8 + i) * XCL_STRIDE + c8 * 8) = pk; }
    }
    if constexpr (FINAL) {
#pragma unroll
        for (int i = 0; i < 8; ++i) { const int tl = tg * 8 + i; const u32x4 v = *(const u32x4*)(z + (row0 + tl) * L0N + 1536 + c8 * 8); *(LAS u32x4*)(gL + tl * XCL_STRIDE + c8 * 8) = v; }
        float w[3][8]; const float* cw = F.in[2];
#pragma unroll
        for (int k = 0; k < 3; ++k)
#pragma unroll
            for (int j = 0; j < 8; ++j) w[k][j] = cw[k * 512 + c8 * 8 + j];
        float pv[10][8];
#pragma unroll
        for (int i = 0; i < 10; ++i) { const int t = t0 + tg * 8 + i - 2;
            if (t >= 0) { const bf16_t* zr = z + ((size_t)b * SEQ + t) * L0N + c8 * 8; const u32x4 a = *(const u32x4*)(zr + 512), c = *(const u32x4*)(zr + 1024);
                pv[i][0] = bflo(a.x) * bflo(c.x); pv[i][1] = bfhi(a.x) * bfhi(c.x); pv[i][2] = bflo(a.y) * bflo(c.y); pv[i][3] = bfhi(a.y) * bfhi(c.y);
                pv[i][4] = bflo(a.z) * bflo(c.z); pv[i][5] = bfhi(a.z) * bfhi(c.z); pv[i][6] = bflo(a.w) * bflo(c.w); pv[i][7] = bfhi(a.w) * bfhi(c.w); }
            else {
#pragma unroll
                for (int j = 0; j < 8; ++j) pv[i][j] = 0.f; } }
#pragma unroll
        for (int i = 0; i < 8; ++i) { const int tl = tg * 8 + i; const u32x4 bgv = *(const u32x4*)(z + (row0 + tl) * L0N + c8 * 8);
            const float bgf[8] = {bflo(bgv.x), bfhi(bgv.x), bflo(bgv.y), bfhi(bgv.y), bflo(bgv.z), bfhi(bgv.z), bflo(bgv.w), bfhi(bgv.w)};
            float o[8];
#pragma unroll
            for (int j = 0; j < 8; ++j) o[j] = bgf[j] * (w[0][j] * pv[i][j] + w[1][j] * pv[i + 1][j] + w[2][j] * pv[i + 2][j]);
            u32x4 pk; pk.x = pk2(o[0], o[1]); pk.y = pk2(o[2], o[3]); pk.z = pk2(o[4], o[5]); pk.w = pk2(o[6], o[7]);
            *(u32x4*)(ycat + (row0 + tl) * D + c8 * 8) = pk; }
        { float h = 0.f; const f32x4* sp4 = (const f32x4*)(SAH + ((size_t)b * 512 + tid) * 128);
#pragma unroll 8
          for (int k2 = 0; k2 < (ch >> 1); ++k2) { const f32x4 v = sp4[k2]; h = v.x * h + v.y; h = v.z * h + v.w; }
          if (ch & 1) { const f32x2 v = SAH[((size_t)b * 512 + tid) * 128 + ch - 1]; h = v.x * h + v.y; }
          hin[tid] = h; }
    }
    __syncthreads();
    {
        const int head = wave, r32 = lane & 31, hh = lane >> 5;
        const bf16_t* lbt = (const bf16_t*)(ws + WS_SMALL + SM_LRUBT);
        const float* b_a = F.in[6]; const float* b_x = F.in[8]; const float* lam = F.in[9];
#pragma unroll 1
        for (int ct = 0; ct < 2; ++ct) {
            const int c = head * 64 + ct * 32 + r32;
            f32x16 acc[2][2];
#pragma unroll
            for (int g = 0; g < 2; ++g)
#pragma unroll
                for (int rt = 0; rt < 2; ++rt)
#pragma unroll
                    for (int i = 0; i < 16; ++i) acc[g][rt][i] = 0.f;
#pragma unroll
            for (int ks = 0; ks < 4; ++ks) {
                bf16x8 af[2], bfr[2];
#pragma unroll
                for (int rt = 0; rt < 2; ++rt) af[rt] = *(const LAS bf16x8*)(xcL + (rt * 32 + r32) * XCL_STRIDE + head * 64 + ks * 16 + hh * 8);
#pragma unroll
                for (int g = 0; g < 2; ++g) bfr[g] = *(const bf16x8*)(lbt + ((size_t)(g * 8 + head) * 64 + ct * 32 + r32) * 64 + ks * 16 + hh * 8);
#pragma unroll
                for (int g = 0; g < 2; ++g)
#pragma unroll
                    for (int rt = 0; rt < 2; ++rt) acc[g][rt] = __builtin_amdgcn_mfma_f32_32x32x16_bf16(af[rt], bfr[g], acc[g][rt], 0, 0, 0);
            }
            const float ba = b_a[c], bx = b_x[c]; const float lm = lam[c];
            const float sp = (lm > 15.f) ? __expf(-lm) : log1pf(__expf(-lm));
            float carry = FINAL ? hin[c] : 0.f, atot = 1.f;
#pragma unroll
            for (int rt = 0; rt < 2; ++rt) {
#pragma unroll
                for (int g4 = 0; g4 < 4; ++g4) {
                    float av[4], uv[4]; float Ag = 1.f, Hg = 0.f;
#pragma unroll
                    for (int j = 0; j < 4; ++j) { const int reg = g4 * 4 + j; const int tl = rt * 32 + 8 * g4 + 4 * hh + j;
                        const float r = sigmoidf_(acc[0][rt][reg] + ba), ig = sigmoidf_(acc[1][rt][reg] + bx);
                        const float a = __builtin_amdgcn_exp2f(-11.541560327111707f * r * sp); const float mult = __builtin_amdgcn_sqrtf(fmaxf((1.0f - a) * (1.0f + a), 0.f));
                        const float xc = bf2f(xcL[tl * XCL_STRIDE + c]);
                        av[j] = a; uv[j] = mult * ig * xc; Ag = a * Ag; Hg = a * Hg + uv[j]; }
                    const f32x2 As = lds_swap(Ag), Hs = lds_swap(Hg);
                    const float mid = As[0] * carry + Hs[0];
                    if constexpr (FINAL) {
                        float s = hh ? mid : carry;
#pragma unroll
                        for (int j = 0; j < 4; ++j) { const int tl = rt * 32 + 8 * g4 + 4 * hh + j; s = av[j] * s + uv[j];
                            const float gv = bf2f(gL[tl * XCL_STRIDE + c]); gL[tl * XCL_STRIDE + c] = (bf16_t)f2bf(s * gelu_tanh(gv)); }
                    }
                    carry = As[1] * mid + Hs[1]; atot = atot * As[0] * As[1];
                }
            }
            if constexpr (!FINAL) { if (hh == 0) SAH[((size_t)b * 512 + c) * 128 + ch] = (f32x2){atot, carry}; }
        }
    }
    __syncthreads();
    if constexpr (FINAL) {
#pragma unroll
        for (int i = 0; i < 8; ++i) { const int tl = tg * 8 + i; const u32x4 v = *(const LAS u32x4*)(gL + tl * XCL_STRIDE + c8 * 8); *(u32x4*)(ycat + (row0 + tl) * D + 512 + c8 * 8) = v; }
        __syncthreads();
    }
}

constexpr int LDS_RI = 0;
constexpr int LDS_HIST = 4096;
DI void ln_router_phase(Frame& F, int layer, const bf16_t* src) {
    bf16_t* xb = (bf16_t*)(F.ws + WS_XB);
    const float* gam = F.in[layer ? 30 : 11]; const float* bet = F.in[layer ? 31 : 12];
    const float* rw = (const float*)(F.ws + WS_SMALL + SM_RWT) + (size_t)layer * 36 * 1024;
    const float* bg = F.in[layer ? 33 : 14]; const float* be = F.in[layer ? 35 : 16];
    unsigned* cnt = (unsigned*)(F.ws + WS_CTL) + CW_CNT + layer * 32;
    unsigned* list = (unsigned*)(F.ws + WS_LIST); float* wslot = (float*)(F.ws + WS_WSLOT); unsigned* posloc = (unsigned*)(F.ws + WS_POSLOC);
    LAS int* e0s = (LAS int*)(F.lds + LDS_RI); LAS int* e1s = e0s + 128; LAS float* w0s = (LAS float*)(e1s + 128); LAS float* w1s = w0s + 128;
    LAS int* hist = (LAS int*)(F.lds + LDS_HIST); LAS int* base = hist + 32;
    const int lane = F.lane;
    f32x4 gv[4], bv[4];
#pragma unroll
    for (int j = 0; j < 4; ++j) { gv[j] = ((const f32x4*)gam)[lane + 64 * j]; bv[j] = ((const f32x4*)bet)[lane + 64 * j]; }
    for (int chunk = F.vcu; chunk < T / 128; chunk += F.G) {
        if (F.tid < 32) hist[F.tid] = 0;
        __syncthreads();
        for (int rr = F.wave; rr < 128; rr += NWAVES) {
            const size_t row = (size_t)chunk * 128 + rr;
            const u32x2* xr = (const u32x2*)(src + row * D) + lane;
            f32x4 v[4]; float s = 0.f;
#pragma unroll
            for (int j = 0; j < 4; ++j) { const u32x2 q = xr[64 * j]; v[j] = (f32x4){bflo(q.x), bfhi(q.x), bflo(q.y), bfhi(q.y)}; s += (v[j].x + v[j].y) + (v[j].z + v[j].w); }
            const float mean = wave_sum(s) * (1.f / D); float s2 = 0.f;
#pragma unroll
            for (int j = 0; j < 4; ++j) { v[j] = v[j] - mean; s2 += (v[j].x * v[j].x + v[j].y * v[j].y) + (v[j].z * v[j].z + v[j].w * v[j].w); }
            const float rstd = 1.f / sqrtf(wave_sum(s2) * (1.f / D) + LN_EPS);
            u32x2* ob = (u32x2*)(xb + row * D) + lane;
#pragma unroll
            for (int j = 0; j < 4; ++j) { v[j] = v[j] * rstd * gv[j] + bv[j]; ob[64 * j] = (u32x2){pk2(v[j].x, v[j].y), pk2(v[j].z, v[j].w)}; }
            float gl[4];
#pragma unroll
            for (int o = 0; o < 4; ++o) { const f32x4* wr_ = (const f32x4*)(rw + o * 1024) + lane; float a = 0.f;
#pragma unroll
                for (int j = 0; j < 4; ++j) { const f32x4 w = wr_[64 * j]; a += (v[j].x * w.x + v[j].y * w.y) + (v[j].z * w.z + v[j].w * w.w); }
                gl[o] = wave_sum(a) + bg[o]; }
            float g0 = gl[0]; int gs = 0;
#pragma unroll
            for (int o = 1; o < 4; ++o) if (gl[o] > g0) { g0 = gl[o]; gs = o; }
            float gsum = 0.f;
#pragma unroll
            for (int o = 0; o < 4; ++o) gsum += __expf(gl[o] - g0);
            const float pgrp = 1.0f / gsum;
            gs = __builtin_amdgcn_readfirstlane(gs);
            float le[8];
#pragma unroll
            for (int hf = 0; hf < 2; ++hf) {
#pragma unroll
                for (int oo = 0; oo < 4; ++oo) { const int o = hf * 4 + oo; const f32x4* wr_ = (const f32x4*)(rw + (4 + gs * 8 + o) * 1024) + lane; float a = 0.f;
#pragma unroll
                    for (int j = 0; j < 4; ++j) { const f32x4 w = wr_[64 * j]; a += (v[j].x * w.x + v[j].y * w.y) + (v[j].z * w.z + v[j].w * w.w); }
                    le[o] = wave_sum(a) + be[gs * 8 + o]; }
                asm volatile("" ::: "memory"); }
            float m0 = le[0]; int i0 = 0;
#pragma unroll
            for (int o = 1; o < 8; ++o) if (le[o] > m0) { m0 = le[o]; i0 = o; }
            float m1 = -3.0e38f; int i1 = 0;
#pragma unroll
            for (int o = 0; o < 8; ++o) if (o != i0 && le[o] > m1) { m1 = le[o]; i1 = o; }
            const float e1 = __expf(m1 - m0); const float w0 = pgrp / (1.0f + e1), w1 = pgrp * e1 / (1.0f + e1);
            if (lane == 0) { e0s[rr] = gs * 8 + i0; e1s[rr] = gs * 8 + i1; w0s[rr] = w0; w1s[rr] = w1; }
        }
        __syncthreads();
        int myrank = 0, mye = 0;
        if (F.tid < 256) { const int rr = F.tid >> 1, k = F.tid & 1; mye = k ? e1s[rr] : e0s[rr]; myrank = atomicAdd((int*)&hist[mye], 1); }
        __syncthreads();
        if (F.tid < 32) { const int h = hist[F.tid]; base[F.tid] = h ? (int)atomicAdd(&cnt[F.tid], (unsigned)h) : 0; }
        __syncthreads();
        if (F.tid < 256) { const int rr = F.tid >> 1, k = F.tid & 1; const unsigned slot = (unsigned)((chunk * 128 + rr) * 2 + k);
            const int li = base[mye] + myrank; list[(size_t)mye * T + li] = slot; wslot[slot] = k ? w1s[rr] : w0s[rr]; posloc[slot] = ((unsigned)mye << 20) | (unsigned)li; }
        __syncthreads();
    }
}

DI MoeTab moe_tables(Frame& F, int layer) {
    LAS int* tb = (LAS int*)(F.lds + LDS_MISC); LAS int* cn = tb + 64; LAS int* nt = cn + 64;
    const unsigned* cnt = (const unsigned*)(F.ws + WS_CTL) + CW_CNT + layer * 32;
    if (F.tid < 32) cn[F.tid] = (int)__hip_atomic_load(cnt + F.tid, __ATOMIC_RELAXED, __HIP_MEMORY_SCOPE_AGENT);
    __syncthreads();
    if (F.tid == 0) { int acc = 0; for (int e = 0; e < 32; ++e) { tb[e] = acc; acc += (cn[e] + 255) >> 8; } tb[32] = acc; nt[0] = acc; }
    __syncthreads();
    MoeTab t; t.tbase = tb; t.cnt = cn; t.ntiles = nt[0]; return t;
}

template <bool FINAL_F32>
DI void ln2_phase(Frame& F, int layer, const MoeTab& tab, bf16_t* dst16, float* dst32) {
    const bf16_t* x1 = (const bf16_t*)(F.ws + WS_XB); const bf16_t* Y = (const bf16_t*)(F.ws + WS_Y);
    const float* wslot = (const float*)(F.ws + WS_WSLOT); const unsigned* posloc = (const unsigned*)(F.ws + WS_POSLOC);
    const float* gam = F.in[layer ? 39 : 20]; const float* bet = F.in[layer ? 40 : 21];
    const int lane = F.lane; const int gw = F.vcu * NWAVES + F.wave, NGW = F.G * NWAVES;
    f32x4 gv[4], bv[4];
#pragma unroll
    for (int j = 0; j < 4; ++j) { gv[j] = ((const f32x4*)gam)[lane + 64 * j]; bv[j] = ((const f32x4*)bet)[lane + 64 * j]; }
#pragma unroll 2
    for (int row = gw; row < T; row += NGW) {
        const unsigned pl0 = posloc[2 * row], pl1 = posloc[2 * row + 1]; const float w0 = wslot[2 * row], w1 = wslot[2 * row + 1];
        const size_t h0 = (size_t)tab.tbase[pl0 >> 20] * 256 + (pl0 & 0xfffffu), h1 = (size_t)tab.tbase[pl1 >> 20] * 256 + (pl1 & 0xfffffu);
        const u32x2* xr = (const u32x2*)(x1 + (size_t)row * D) + lane;
        const u32x2* y0 = (const u32x2*)(Y + h0 * D) + lane; const u32x2* y1 = (const u32x2*)(Y + h1 * D) + lane;
        f32x4 v[4]; float s = 0.f;
#pragma unroll
        for (int j = 0; j < 4; ++j) { const u32x2 a = y0[64 * j], c = y1[64 * j], q = xr[64 * j];
            v[j].x = bflo(q.x) * DN_ALPHA + (w0 * bflo(a.x) + w1 * bflo(c.x)); v[j].y = bfhi(q.x) * DN_ALPHA + (w0 * bfhi(a.x) + w1 * bfhi(c.x));
            v[j].z = bflo(q.y) * DN_ALPHA + (w0 * bflo(a.y) + w1 * bflo(c.y)); v[j].w = bfhi(q.y) * DN_ALPHA + (w0 * bfhi(a.y) + w1 * bfhi(c.y));
            s += (v[j].x + v[j].y) + (v[j].z + v[j].w); }
        const float mean = wave_sum(s) * (1.f / D); float s2 = 0.f;
#pragma unroll
        for (int j = 0; j < 4; ++j) { v[j] = v[j] - mean; s2 += (v[j].x * v[j].x + v[j].y * v[j].y) + (v[j].z * v[j].z + v[j].w * v[j].w); }
        const float rstd = 1.f / sqrtf(wave_sum(s2) * (1.f / D) + LN_EPS);
#pragma unroll
        for (int j = 0; j < 4; ++j) { v[j] = v[j] * rstd * gv[j] + bv[j];
            if (FINAL_F32) ((f32x4*)(dst32 + (size_t)row * D))[lane + 64 * j] = v[j];
            else ((u32x2*)(dst16 + (size_t)row * D))[lane + 64 * j] = (u32x2){pk2(v[j].x, v[j].y), pk2(v[j].z, v[j].w)}; }
    }
}

constexpr float QSCALE = 0.125f * 1.4426950408889634f;
struct GemmL1In {
    static constexpr bool PERM = false;
    const char* A; int K; unsigned lda2, ldb2; const char* Bt; pg8::TileOrder ord;
    bf16_t* Q; unsigned char* KV; float* gates; const float* cosT; const float* sinT;
    DI bool next(int i, GU& u) const { return ord.next(i, u); }
    DI unsigned a_row_off(const GU& u, int r) const { return (unsigned)(u.pm * 256 + r) * lda2; }
    DI const char* b_tile(const GU& u) const { return Bt + (size_t)u.pn * 256 * ldb2; }
    DI void epi(const f32x4 (&acc)[2][2][4][2], const GU& u, int wr, int wc, int fr, int fq) const {
        const int pn = u.pn;
#pragma unroll
        for (int ai = 0; ai < 2; ++ai)
#pragma unroll
            for (int m = 0; m < 4; ++m) {
                const int row = u.pm * 256 + ai * 128 + wr * 64 + m * 16 + fr; const int pos = row & (SEQ - 1), b = row >> 13;
                if (pn == 10) {
                    if (wc < 2) {
#pragma unroll
                        for (int n = 0; n < 2; ++n) { if (n == 1 && wc == 1) continue; const f32x4 v = acc[ai][0][m][n];
                            f32x4 o; o.x = sigmoidf_(v.x); o.y = sigmoidf_(v.y); o.z = sigmoidf_(v.z); o.w = sigmoidf_(v.w);
                            *(f32x4*)(gates + (size_t)row * 48 + 32 * wc + 16 * n + 4 * fq) = o; }
                    }
                } else if (pn < 5 || pn == 6 || pn == 8) {
                    const int a = wc & 1, i0 = 16 * a + 4 * fq;
                    const f32x4 c4 = *(const f32x4*)(cosT + pos * 32 + i0), s4 = *(const f32x4*)(sinT + pos * 32 + i0);
#pragma unroll
                    for (int bj = 0; bj < 2; ++bj) { const f32x4 x1 = acc[ai][bj][m][0], x2 = acc[ai][bj][m][1];
                        f32x4 o1 = x1 * c4 - x2 * s4, o2 = x2 * c4 + x1 * s4;
                        const int hl = bj * 2 + (wc >> 1); bf16_t* dst;
                        if (pn < 4) { o1 = o1 * QSCALE; o2 = o2 * QSCALE; dst = Q + ((size_t)row * 16 + pn * 4 + hl) * 64; }
                        else dst = (bf16_t*)(KV + (size_t)(pn - 4) * KV_STRIDE) + ((size_t)(b * 4 + hl) * SEQ + pos) * 64;
                        *(u32x2*)(dst + i0) = (u32x2){cvt_pk_bf16(o1.x, o1.y), cvt_pk_bf16(o1.z, o1.w)};
                        *(u32x2*)(dst + 32 + i0) = (u32x2){cvt_pk_bf16(o2.x, o2.y), cvt_pk_bf16(o2.z, o2.w)}; }
                } else {
#pragma unroll
                    for (int bj = 0; bj < 2; ++bj) { const int gg = bj * 2 + (wc >> 1);
                        bf16_t* dst = (bf16_t*)(KV + (size_t)(pn - 4) * KV_STRIDE) + ((size_t)(b * 4 + gg) * SEQ + pos) * 64 + 32 * (wc & 1) + 4 * fq;
#pragma unroll
                        for (int n = 0; n < 2; ++n) { const f32x4 v = acc[ai][bj][m][n]; *(u32x2*)(dst + 16 * n) = (u32x2){cvt_pk_bf16(v.x, v.y), cvt_pk_bf16(v.z, v.w)}; } }
                }
            }
    }
};
struct GemmCmp1 {
    static constexpr bool PERM = true;
    const char* A; int K; unsigned lda2, ldb2; const char* Bt; int G, c;
    const float* cbias; bf16_t* Hd;
    DI bool next(int i, GU& u) const { const int L = i * G + c; if (L >= 64) return false; u.e = L >> 5; u.pm = L & 31; u.pn = 0; return true; }
    DI unsigned a_row_off(const GU& u, int r) const { return (unsigned)u.e * (unsigned)KV_STRIDE + (unsigned)(u.pm * 256 + r) * lda2; }
    DI const char* b_tile(const GU& u) const { return Bt + (size_t)u.e * 256 * ldb2; }
    DI void epi(const f32x4 (&acc)[2][2][4][2], const GU& u, int wr, int wc, int fr, int fq) const {
        const int row0 = u.pm * 256 + wr * 64 + fr, col0 = wc * 32 + 8 * fq;
        f32x4 bv[2][2];
#pragma unroll
        for (int bj = 0; bj < 2; ++bj)
#pragma unroll
            for (int n = 0; n < 2; ++n) bv[bj][n] = *(const f32x4*)(cbias + u.e * 256 + col0 + bj * 128 + 4 * n);
#pragma unroll
        for (int ai = 0; ai < 2; ++ai)
#pragma unroll
            for (int m = 0; m < 4; ++m) { bf16_t* rowp = Hd + ((size_t)u.e * 8192 + row0 + ai * 128 + m * 16) * 256 + col0;
#pragma unroll
                for (int bj = 0; bj < 2; ++bj) { const f32x4 v0 = acc[ai][bj][m][0] + bv[bj][0], v1 = acc[ai][bj][m][1] + bv[bj][1];
                    u32x4 w; w.x = cvt_pk_bf16(gelu_tanh(v0[0]), gelu_tanh(v0[1])); w.y = cvt_pk_bf16(gelu_tanh(v0[2]), gelu_tanh(v0[3]));
                    w.z = cvt_pk_bf16(gelu_tanh(v1[0]), gelu_tanh(v1[1])); w.w = cvt_pk_bf16(gelu_tanh(v1[2]), gelu_tanh(v1[3]));
                    *(u32x4*)(rowp + bj * 128) = w; } }
    }
};
struct GemmCmp2 {
    static constexpr bool PERM = true;
    const char* A; int K; unsigned lda2, ldb2; const char* Bt; int G, c;
    bf16_t* O;
    DI bool next(int i, GU& u) const { const int L = i * G + c; if (L >= 64) return false; u.e = L >> 5; u.pm = L & 31; u.pn = 0; return true; }
    DI unsigned a_row_off(const GU& u, int r) const { return (unsigned)(u.e * 8192 + u.pm * 256 + r) * lda2; }
    DI const char* b_tile(const GU& u) const { return Bt + (size_t)u.e * 256 * ldb2; }
    DI void epi(const f32x4 (&acc)[2][2][4][2], const GU& u, int wr, int wc, int fr, int fq) const {
        if (wc >= 2) return;
        const int row0 = u.pm * 256 + wr * 64 + fr, col0 = wc * 32 + 8 * fq;
#pragma unroll
        for (int ai = 0; ai < 2; ++ai)
#pragma unroll
            for (int m = 0; m < 4; ++m) { bf16_t* rowp = O + ((size_t)u.e * 8192 + row0 + ai * 128 + m * 16) * 64 + col0;
                const f32x4 v0 = acc[ai][0][m][0], v1 = acc[ai][0][m][1];
                u32x4 w; w.x = cvt_pk_bf16(v0[0], v0[1]); w.y = cvt_pk_bf16(v0[2], v0[3]); w.z = cvt_pk_bf16(v1[0], v1[1]); w.w = cvt_pk_bf16(v1[2], v1[3]);
                *(u32x4*)rowp = w; }
    }
};

constexpr int AL_KB = 0, AL_VB = 16384, AL_FAC = 40960, AL_SELM = 41984, AL_IMPS = 43008, IMP_STRIDE = 129, AL_IMPC = AL_IMPS + 64 * IMP_STRIDE * 4, AL_OT = AL_IMPS  , OT_STRIDE = 68;
static_assert(AL_OT + 8 * 32 * OT_STRIDE * 4 <= LDS_RING, "attention LDS map");
typedef short v4i16_t __attribute__((ext_vector_type(4)));
typedef __bf16 bf16x2_t __attribute__((ext_vector_type(2)));
DI unsigned cvtpk_s(float lo, float hi) { f32x2 v = {lo, hi}; bf16x2_t b = __builtin_convertvector(v, bf16x2_t); return __builtin_bit_cast(unsigned, b); }
DI int crow(int r, int hi) { return (r & 3) + 8 * (r >> 2) + 4 * hi; }
#define NEGINF (-__builtin_inff())

struct AttnW {
    int tid, lane, wave, r32, hh;
    LAS unsigned char* lds; LAS float* fac; LAS float* ot;
};
DI void at_load(const bf16_t* slab, int tile, int tid, u32x4& r) { r = *(const u32x4*)(slab + (size_t)tile * 4096 + tid * 8); }
DI void at_store_k(LAS unsigned char* kb, int tid, const u32x4& r) { const int key = tid >> 3, ch = tid & 7; *(LAS u32x4*)(kb + key * 128 + ((ch ^ ((key >> 1) & 7)) << 4)) = r; }
DI void at_store_v(LAS unsigned char* vb, int tid, const u32x4& r) { *(LAS u32x4*)(vb + tid * 16) = r; }
DI void at_qk(const LAS unsigned char* kb, const bf16x8 (&qf)[4], float cinit, int r32, int hh, f32x16& p0, f32x16& p1) {
#pragma unroll
    for (int i = 0; i < 16; ++i) { p0[i] = cinit; p1[i] = cinit; }
    const int sw = (r32 >> 1) & 7;
#pragma unroll
    for (int d0 = 0; d0 < 4; ++d0) {
        const bf16x8 a0 = *(const LAS bf16x8*)(kb + r32 * 128 + (((2 * d0 + hh) ^ sw) << 4));
        const bf16x8 a1 = *(const LAS bf16x8*)(kb + (32 + r32) * 128 + (((2 * d0 + hh) ^ sw) << 4));
        p0 = __builtin_amdgcn_mfma_f32_32x32x16_bf16(a0, qf[d0], p0, 0, 0, 0);
        p1 = __builtin_amdgcn_mfma_f32_32x32x16_bf16(a1, qf[d0], p1, 0, 0, 0);
    }
}
DI void at_pack(const f32x16& p0, const f32x16& p1, u32x4 (&pw)[4]) {
#pragma unroll
    for (int s = 0; s < 2; ++s) {
        pw[s] = (u32x4){cvtpk_s(p0[8 * s], p0[8 * s + 1]), cvtpk_s(p0[8 * s + 2], p0[8 * s + 3]), cvtpk_s(p0[8 * s + 4], p0[8 * s + 5]), cvtpk_s(p0[8 * s + 6], p0[8 * s + 7])};
        pw[2 + s] = (u32x4){cvtpk_s(p1[8 * s], p1[8 * s + 1]), cvtpk_s(p1[8 * s + 2], p1[8 * s + 3]), cvtpk_s(p1[8 * s + 4], p1[8 * s + 5]), cvtpk_s(p1[8 * s + 6], p1[8 * s + 7])};
    }
}
DI void at_pv(const LAS unsigned char* vb, const u32x4 (&pw)[4], f32x16 (&o)[2], int lane) {
    const int hh = lane >> 5;
    const LAS unsigned char* vp = vb + (4 * hh + ((lane & 15) >> 2)) * 128 + (16 * ((lane >> 4) & 1) + 4 * (lane & 3)) * 2;
#pragma unroll
    for (int s = 0; s < 4; ++s)
#pragma unroll
        for (int d0 = 0; d0 < 2; ++d0) {
            const s16x4 lo = __builtin_bit_cast(s16x4, __builtin_amdgcn_ds_read_tr16_b64_v4i16((LAS v4i16_t*)(vp + s * 2048 + d0 * 64)));
            const s16x4 hi = __builtin_bit_cast(s16x4, __builtin_amdgcn_ds_read_tr16_b64_v4i16((LAS v4i16_t*)(vp + s * 2048 + d0 * 64 + 1024)));
            const bf16x8 vf = (bf16x8){lo[0], lo[1], lo[2], lo[3], hi[0], hi[1], hi[2], hi[3]};
            o[d0] = __builtin_amdgcn_mfma_f32_32x32x16_bf16(__builtin_bit_cast(bf16x8, pw[s]), vf, o[d0], 0, 0, 0);
        }
}
DI float at_rowmax(const f32x16& p0, const f32x16& p1) {
    float a = fmaxf(fmaxf(p0[0], p1[0]), p0[1]), c = fmaxf(fmaxf(p1[1], p0[2]), p1[2]);
#pragma unroll
    for (int r = 3; r < 15; r += 2) { a = fmaxf(fmaxf(a, p0[r]), p1[r]); c = fmaxf(fmaxf(c, p0[r + 1]), p1[r + 1]); }
    a = fmaxf(fmaxf(a, p0[15]), p1[15]); a = fmaxf(a, c);
    const f32x2 s = lds_swap(a); return fmaxf(s[0], s[1]);
}
DI void at_scale_rows(f32x16 (&o)[2], float f, const AttnW& W) {
    if (W.hh == 0) W.fac[W.r32] = f;
#pragma unroll
    for (int g4 = 0; g4 < 4; ++g4) { const f32x4 fv = *(const LAS f32x4*)(W.fac + 8 * g4 + 4 * W.hh);
#pragma unroll
        for (int j = 0; j < 4; ++j) { o[0][4 * g4 + j] *= fv[j]; o[1][4 * g4 + j] *= fv[j]; } }
}
template <bool FIRST> DI void at_axpy_rows(const f32x16 (&o)[2], float f, const AttnW& W) {
    if (W.hh == 0) W.fac[W.r32] = f;
#pragma unroll
    for (int g4 = 0; g4 < 4; ++g4) { const f32x4 fv = *(const LAS f32x4*)(W.fac + 8 * g4 + 4 * W.hh);
#pragma unroll
        for (int j = 0; j < 4; ++j) { LAS float* d = W.ot + (8 * g4 + 4 * W.hh + j) * OT_STRIDE + W.r32;
            if (FIRST) { d[0] = fv[j] * o[0][4 * g4 + j]; d[32] = fv[j] * o[1][4 * g4 + j]; }
            else { d[0] += fv[j] * o[0][4 * g4 + j]; d[32] += fv[j] * o[1][4 * g4 + j]; } } }
}
template <bool GT> DI void at_mask(f32x16& p0, f32x16& p1, int lim, int hh) {
#pragma unroll
    for (int r = 0; r < 16; ++r) { const int kv = crow(r, hh);
        if (GT) { if (kv > lim) p0[r] = NEGINF; if (kv + 32 > lim) p1[r] = NEGINF; }
        else { if (kv <= lim) p0[r] = NEGINF; if (kv + 32 <= lim) p1[r] = NEGINF; } }
}
constexpr float AT_THR = 8.0f;
struct Flash { float mu, l; bool started; f32x16 o[2]; };
DI void flash_init(Flash& s) { s.mu = 0.f; s.l = 0.f; s.started = false;
#pragma unroll
    for (int i = 0; i < 16; ++i) { s.o[0][i] = 0.f; s.o[1][i] = 0.f; } }
template <bool WITH_O> DI void flash_update(Flash& s, f32x16& p0, f32x16& p1, const AttnW& W) {
    const float mx = at_rowmax(p0, p1);
    const bool fin = mx > NEGINF;
    const bool need = s.started ? (mx > AT_THR) : (fin && fabsf(mx) > AT_THR);
    if (__any(need)) {
        const float delta = need ? mx : 0.f;
        const float f = s.started ? __builtin_amdgcn_exp2f(-delta) : 1.0f;
        s.mu += delta; s.l *= f;
        if (WITH_O) at_scale_rows(s.o, f, W);
#pragma unroll
        for (int r = 0; r < 16; ++r) { p0[r] -= delta; p1[r] -= delta; }
    }
    s.started = s.started || fin;
    float sum0 = 0.f, sum1 = 0.f;
#pragma unroll
    for (int r = 0; r < 16; ++r) { p0[r] = __builtin_amdgcn_exp2f(p0[r]); p1[r] = __builtin_amdgcn_exp2f(p1[r]); sum0 += p0[r]; sum1 += p1[r]; }
    s.l += sum0 + sum1;
}

DI void attn_unit(Frame& F, int bg, int qblk, int& it) {
    AttnW W; W.tid = F.tid; W.lane = F.lane; W.wave = F.wave; W.r32 = F.lane & 31; W.hh = F.lane >> 5; W.lds = F.lds; W.fac = (LAS float*)(F.lds + AL_FAC) + F.wave * 32; W.ot = (LAS float*)(F.lds + AL_OT) + F.wave * 32 * OT_STRIDE;
    const int tid = W.tid, lane = W.lane, wave = W.wave, r32 = W.r32, hh = W.hh;
    const int b = bg >> 2, g = bg & 3;
    unsigned char* ws = F.ws;
    bf16_t* Qb = (bf16_t*)(ws + WS_Q);
    const float* gates = (const float*)(ws + WS_GATES);
    const bf16_t* kcmp = (const bf16_t*)(ws + WS_CMPO) + (size_t)bg * 512 * 64; const bf16_t* vcmp = kcmp + (size_t)8192 * 64;
    const bf16_t* ksl = (const bf16_t*)(ws + WS_KV + 2 * KV_STRIDE) + (size_t)bg * SEQ * 64; const bf16_t* vsl = (const bf16_t*)(ws + WS_KV + 3 * KV_STRIDE) + (size_t)bg * SEQ * 64;
    const bf16_t* kwl = (const bf16_t*)(ws + WS_KV + 4 * KV_STRIDE) + (size_t)bg * SEQ * 64; const bf16_t* vwl = (const bf16_t*)(ws + WS_KV + 5 * KV_STRIDE) + (size_t)bg * SEQ * 64;
    LAS unsigned char* KB = F.lds + AL_KB; LAS unsigned char* VB = F.lds + AL_VB;
    LAS unsigned* selm = (LAS unsigned*)(F.lds + AL_SELM); LAS float* impS = (LAS float*)(F.lds + AL_IMPS); LAS float* impC = (LAS float*)(F.lds + AL_IMPC);
    const int tl = wave * 8 + (r32 >> 2), hd = r32 & 3, t = qblk * 64 + tl;
    const size_t qrow = ((size_t)(b * SEQ + t) * 16 + g * 4 + hd) * 64;
    bf16x8 qf[4];
#pragma unroll
    for (int d0 = 0; d0 < 4; ++d0) qf[d0] = *(const bf16x8*)(Qb + qrow + d0 * 16 + hh * 8);
    const float* gp = gates + (size_t)(b * SEQ + t) * 48 + (g * 4 + hd) * 3;
    const float gate_c = gp[0], gate_s = gp[1], gate_w = gp[2];
    const bool need_topk = qblk >= 16;
    f32x16 p0, p1; u32x4 kr, vr, pw[4];
    const bool rotB = wave >= 4;
    int vs = 0;
#define V_NEXT() do { vs = (vs == 2) ? 0 : vs + 1; } while (0)

    const int nct = (4 * qblk + 2) / 64 + 1;
    const int cmax = (t - 31) >> 4;
    Flash fc; flash_init(fc);
    at_load(kcmp, 0, tid, kr);
    for (int ti = 0; ti < nct; ++ti, ++it) {
        LAS unsigned char* kb = KB + (it & 1) * 8192;
        at_store_k(kb, tid, kr); __syncthreads();
        if (ti + 1 < nct) at_load(kcmp, ti + 1, tid, kr);
        at_qk(kb, qf, -fc.mu, r32, hh, p0, p1);
        at_mask<true>(p0, p1, cmax - 64 * ti, hh);
        flash_update<false>(fc, p0, p1, W);
    }
    { const f32x2 ls = lds_swap(fc.l); fc.l = ls[0] + ls[1]; }
    const float inv_lc = 1.0f / fmaxf(fc.l, 1e-30f);
    if (need_topk) { for (int i = tid; i < 64 * IMP_STRIDE; i += NTHR) { impS[i] = 0.f; impC[i] = 0.f; } }
    at_load(kcmp, 0, tid, kr); at_load(vcmp, 0, tid, vr);
    for (int ti = 0; ti < nct; ++ti, ++it) {
        LAS unsigned char* kb = KB + (it & 1) * 8192; LAS unsigned char* vb = VB + vs * 8192; V_NEXT();
        at_store_k(kb, tid, kr); at_store_v(vb, tid, vr); __syncthreads();
        if (ti + 1 < nct) { at_load(kcmp, ti + 1, tid, kr); at_load(vcmp, ti + 1, tid, vr); }
        at_qk(kb, qf, -fc.mu, r32, hh, p0, p1);
        at_mask<true>(p0, p1, cmax - 64 * ti, hh);
#pragma unroll
        for (int r = 0; r < 16; ++r) { p0[r] = __builtin_amdgcn_exp2f(p0[r]); p1[r] = __builtin_amdgcn_exp2f(p1[r]); }
        at_pack(p0, p1, pw);
        at_pv(vb, pw, fc.o, lane);
        if (need_topk) {
#pragma unroll
            for (int half = 0; half < 2; ++half)
#pragma unroll
                for (int g4 = 0; g4 < 4; ++g4) {
                    const f32x16& p = half ? p1 : p0;
                    float s4 = ((p[4 * g4] + p[4 * g4 + 1]) + (p[4 * g4 + 2] + p[4 * g4 + 3])) * inv_lc, c3 = p[4 * g4 + 3] * inv_lc;
                    s4 += __shfl_xor(s4, 1); c3 += __shfl_xor(c3, 1); s4 += __shfl_xor(s4, 2); c3 += __shfl_xor(c3, 2);
                    const int j = 16 * ti + 8 * half + 2 * g4 + hh;
                    if (hd == 0) { impS[tl * IMP_STRIDE + j] = s4; impC[tl * IMP_STRIDE + j] = c3; }
                }
        }
    }
    __syncthreads();
    if (need_topk) {
#pragma unroll 1
        for (int tt = 0; tt < 8; ++tt) {
            const int tk = wave * 8 + tt; const LAS float* S = impS + tk * IMP_STRIDE; const LAS float* C = impC + tk * IMP_STRIDE;
            const int j0 = lane, j1 = 64 + lane;
            const float v0 = S[j0] + (j0 > 0 ? C[j0 - 1] : 0.f), v1 = S[j1] + C[j1 - 1];
            const bool c0 = (j0 >= 1) && (j0 <= qblk - 2), c1 = (j1 <= qblk - 2);
            const unsigned k0 = c0 ? __float_as_uint(v0) + 1u : 0u, k1 = c1 ? __float_as_uint(v1) + 1u : 0u;
            unsigned prefix = 0u;
#pragma unroll 1
            for (int bit = 31; bit >= 0; --bit) { const unsigned trial = prefix | (1u << bit);
                const int cnt = __popcll(__ballot(k0 >= trial)) + __popcll(__ballot(k1 >= trial));
                if (cnt >= 13) prefix = trial; }
            const int G = __popcll(__ballot(k0 > prefix)) + __popcll(__ballot(k1 > prefix)); const int need = 13 - G;
            const unsigned long long e0 = __ballot(k0 == prefix), e1 = __ballot(k1 == prefix);
            const unsigned long long lt = (1ull << lane) - 1ull;
            const int rk0 = __popcll(e0 & lt), rk1 = __popcll(e0) + __popcll(e1 & lt);
            const bool s0 = (k0 > prefix) || (k0 == prefix && rk0 < need) || j0 == 0 || j0 == qblk || j0 == qblk - 1;
            const bool s1 = (k1 > prefix) || (k1 == prefix && rk1 < need) || j1 == qblk || j1 == qblk - 1;
            const unsigned long long m0 = __ballot(s0), m1 = __ballot(s1);
            if (lane == 0) { selm[tk * 4 + 0] = (unsigned)m0; selm[tk * 4 + 1] = (unsigned)(m0 >> 32); selm[tk * 4 + 2] = (unsigned)m1; selm[tk * 4 + 3] = (unsigned)(m1 >> 32); }
        }
    } else {
        if (tid < 256) selm[tid] = 0xffffffffu;
    }
    __syncthreads();
    const unsigned sm0 = selm[tl * 4 + 0], sm1 = selm[tl * 4 + 1], sm2 = selm[tl * 4 + 2], sm3 = selm[tl * 4 + 3];
    at_axpy_rows<true>(fc.o, gate_c * inv_lc, W);

    {
        Flash fs; flash_init(fs);
        at_load(ksl, 0, tid, kr); at_load(vsl, 0, tid, vr);
        const LAS unsigned char* vprev = VB; bool pend = false;
        for (int ti = 0; ti <= qblk; ++ti, ++it) {
            LAS unsigned char* kb = KB + (it & 1) * 8192; LAS unsigned char* vb = VB + vs * 8192; V_NEXT();
            at_store_k(kb, tid, kr); at_store_v(vb, tid, vr); __syncthreads();
            if (ti < qblk) { at_load(ksl, ti + 1, tid, kr); at_load(vsl, ti + 1, tid, vr); }
            if (rotB && pend) at_pv(vprev, pw, fs.o, lane);
            const unsigned wsel = ti < 32 ? sm0 : ti < 64 ? sm1 : ti < 96 ? sm2 : sm3;
            at_qk(kb, qf, ((wsel >> (ti & 31)) & 1u) ? -fs.mu : NEGINF, r32, hh, p0, p1);
            if (ti == qblk) at_mask<true>(p0, p1, tl, hh);
            flash_update<true>(fs, p0, p1, W);
            at_pack(p0, p1, pw);
            if (!rotB) at_pv(vb, pw, fs.o, lane); else { vprev = vb; pend = true; }
        }
        if (rotB && pend) at_pv(vprev, pw, fs.o, lane);
        const f32x2 ls = lds_swap(fs.l); const float l = ls[0] + ls[1];
        at_axpy_rows<false>(fs.o, gate_s / fmaxf(l, 1e-30f), W);
    }
    {
        Flash fw; flash_init(fw);
        const int tb = qblk >= 8 ? qblk - 8 : 0;
        at_load(kwl, tb, tid, kr); at_load(vwl, tb, tid, vr);
        const LAS unsigned char* vprev = VB; bool pend = false;
        for (int ti = tb; ti <= qblk; ++ti, ++it) {
            LAS unsigned char* kb = KB + (it & 1) * 8192; LAS unsigned char* vb = VB + vs * 8192; V_NEXT();
            at_store_k(kb, tid, kr); at_store_v(vb, tid, vr); __syncthreads();
            if (ti < qblk) { at_load(kwl, ti + 1, tid, kr); at_load(vwl, ti + 1, tid, vr); }
            if (rotB && pend) at_pv(vprev, pw, fw.o, lane);
            at_qk(kb, qf, -fw.mu, r32, hh, p0, p1);
            if (ti == qblk - 8) at_mask<false>(p0, p1, tl, hh);
            if (ti == qblk) at_mask<true>(p0, p1, tl, hh);
            flash_update<true>(fw, p0, p1, W);
            at_pack(p0, p1, pw);
            if (!rotB) at_pv(vb, pw, fw.o, lane); else { vprev = vb; pend = true; }
        }
        if (rotB && pend) at_pv(vprev, pw, fw.o, lane);
        const f32x2 ls = lds_swap(fw.l); const float l = ls[0] + ls[1];
        at_axpy_rows<false>(fw.o, gate_w / fmaxf(l, 1e-30f), W);
    }
#undef V_NEXT
    { const int q = lane >> 1, hf = lane & 1; const LAS float* src = W.ot + q * OT_STRIDE + hf * 32; const int tq = qblk * 64 + wave * 8 + (q >> 2);
      bf16_t* dst = Qb + ((size_t)(b * SEQ + tq) * 16 + g * 4 + (q & 3)) * 64 + hf * 32;
#pragma unroll
      for (int c = 0; c < 4; ++c) { const f32x4 a = *(const LAS f32x4*)(src + 8 * c), d = *(const LAS f32x4*)(src + 8 * c + 4);
          *(u32x4*)(dst + 8 * c) = (u32x4){pk2(a.x, a.y), pk2(a.z, a.w), pk2(d.x, d.y), pk2(d.z, d.w)}; } }
    __syncthreads();
}
DI void attn_phase(Frame& F) {
    int it = 0;
    if (F.G == 256) {
        const int bg = F.vcu >> 4, s = F.vcu & 15;
#pragma unroll 1
        for (int i = 0; i < 8; ++i) { const int base = (i >> 1) * 32; const int qblk = (i & 1) ? base + 31 - s : base + s; attn_unit(F, bg, 127 - qblk, it); }
    } else {
#pragma unroll 1
        for (int u = F.vcu; u < 2048; u += F.G) attn_unit(F, u >> 7, 127 - (u & 127), it);
    }
}

constexpr int NPHASE = 18;
__global__ void __launch_bounds__(NTHR, 2) fwd_kernel(Args args) {
    extern __shared__ __attribute__((aligned(16))) unsigned char lds_raw[];
    cg::grid_group grid = cg::this_grid();
    Frame F;
    F.lds = (LAS unsigned char*)lds_raw;
    F.tid = threadIdx.x; F.lane = F.tid & 63; F.wave = __builtin_amdgcn_readfirstlane(F.tid >> 6);
    F.G = gridDim.x; { const int bx = blockIdx.x; F.vcu = (F.G % 8 == 0) ? (bx % 8) * (F.G / 8) + bx / 8 : bx; }
    F.in = args.in; F.out = args.out; F.ws = args.ws;
    unsigned char* ws = args.ws;
    const int lo = args.ph_lo, hi = args.ph_hi;
    volatile LAS unsigned* bar_st = (volatile LAS unsigned*)(F.lds + LDS_BYTES - 64);
    if (F.tid < 16) bar_st[F.tid] = 0u;
    __syncthreads();
    XcdBarrier xbar; xbar.bar = (unsigned*)(ws + WS_CTL) + CW_BAR; xbar.x = 0; xbar.st = bar_st;
#ifndef PHMASK
#define PHMASK 0xFFFFFFFFu
#endif
#define IN(k) (((PHMASK >> (k)) & 1u) && lo <= (k) && (k) < hi)
#ifdef TPH_LO
    unsigned long long tp0 = __builtin_amdgcn_s_memrealtime(), tp1 = tp0;
#define STAMP(k) do { if ((k) == TPH_LO - 1) tp0 = __builtin_amdgcn_s_memrealtime(); if ((k) == TPH_HI) tp1 = __builtin_amdgcn_s_memrealtime(); } while (0)
#else
#define STAMP(k) do { } while (0)
#endif
#define SEAM(k) do { if (IN(k) && IN((k) + 1)) { if ((k) == 0) { grid.sync(); xbar = xcd_barrier_post((unsigned*)(ws + WS_CTL) + CW_BAR, bar_st); } else xcd_barrier(xbar); } STAMP(k); } while (0)

    if (IN(0)) { p0_prep(F); } SEAM(0);
    if (IN(1)) { GemmPlain g; g.A = (const char*)(ws + WS_XB); g.K = 1024; g.lda2 = 2048; g.ldb2 = 2048; g.Bt = (const char*)(ws + WS_W0IN); g.ord.init(T, L0N, F.G, (int)blockIdx.x);
        g.C = (bf16_t*)(ws + WS_Z); g.ldc = L0N; pg8::gemm_phase(F.lds, g); } SEAM(1);
#ifdef XSYNC_N
    for (int xs = 0; xs < XSYNC_N; ++xs) grid.sync();
#endif
#ifdef XGEMM_K
    { grid.sync(); const unsigned long long xt0 = __builtin_amdgcn_s_memrealtime();
      GemmPlain g; g.A = (const char*)(ws + WS_XB); g.K = XGEMM_K; g.lda2 = 2048; g.ldb2 = 2048; g.Bt = (const char*)(ws + WS_W0IN); g.ord.init(T, XGEMM_N, F.G, (int)blockIdx.x);
      g.C = (bf16_t*)F.out; g.ldc = XGEMM_N; pg8::gemm_phase(F.lds, g); grid.sync(); (void)xt0; }
#endif
    if (IN(2)) { for (int u = F.vcu; u < 512; u += F.G) lru_tile<false>(F, u >> 7, u & 127); } SEAM(2);
    if (IN(3)) { for (int u = F.vcu; u < 512; u += F.G) lru_tile<true>(F, u >> 7, u & 127); } SEAM(3);
    bf16_t* const OA = (bf16_t*)F.out; bf16_t* const OB = OA + (size_t)T * D;
    if (IN(4)) { GemmResid<true> g; g.A = (const char*)(ws + WS_XB); g.K = 1024; g.lda2 = 2048; g.ldb2 = 2048; g.Bt = (const char*)(ws + WS_W0OUT); g.ord.init(T, D, F.G, (int)blockIdx.x);
        g.res32 = F.in[0]; g.res16 = nullptr; g.out = OA; pg8::gemm_phase(F.lds, g); } SEAM(4);
#define MOE_LAYER(layer, pb, SRC, FIN, DST16) do { \
        if (IN(pb)) { ln_router_phase(F, layer, SRC); } SEAM(pb); \
        if (IN((pb) + 1)) { MoeTab tab = moe_tables(F, layer); \
            GemmMoeUp g; g.A = (const char*)(ws + WS_XB); g.K = 1024; g.lda2 = 2048; g.ldb2 = 2048; g.Bt = (const char*)(ws + ((layer) ? WS_WGU1 : WS_WGU0)); g.G = F.G; g.c = (int)blockIdx.x; \
            g.tab = tab; g.list = (const unsigned*)(ws + WS_LIST); g.H = (bf16_t*)(ws + WS_H); pg8::gemm_phase(F.lds, g); } SEAM((pb) + 1); \
        if (IN((pb) + 2)) { MoeTab tab = moe_tables(F, layer); \
            GemmMoeDown g; g.A = (const char*)(ws + WS_H); g.K = 512; g.lda2 = 1024; g.ldb2 = 1024; g.Bt = (const char*)(ws + ((layer) ? WS_WD1 : WS_WD0)); g.G = F.G; g.c = (int)blockIdx.x; \
            g.tab = tab; g.Y = (bf16_t*)(ws + WS_Y); pg8::gemm_phase(F.lds, g); } SEAM((pb) + 2); \
        if (IN((pb) + 3)) { MoeTab tab = moe_tables(F, layer); ln2_phase<FIN>(F, layer, tab, DST16, F.out); } } while (0)
    MOE_LAYER(0, 5, OA, false, OA); SEAM(8);
    if (IN(9)) { GemmL1In g; g.A = (const char*)OA; g.K = 1024; g.lda2 = 2048; g.ldb2 = 2048; g.Bt = (const char*)(ws + WS_W1IN); g.ord.init(T, L1NP, F.G, (int)blockIdx.x);
        g.Q = (bf16_t*)(ws + WS_Q); g.KV = ws + WS_KV; g.gates = (float*)(ws + WS_GATES); g.cosT = (const float*)(ws + WS_COS); g.sinT = (const float*)(ws + WS_SIN); pg8::gemm_phase(F.lds, g); } SEAM(9);
    if (IN(10)) { GemmCmp1 g; g.A = (const char*)(ws + WS_KV); g.K = 2048; g.lda2 = 2048; g.ldb2 = 4096; g.Bt = (const char*)(ws + WS_WC1); g.G = F.G; g.c = (int)blockIdx.x;
        g.cbias = (const float*)(ws + WS_SMALL + SM_CBIAS); g.Hd = (bf16_t*)(ws + WS_CMPH); pg8::gemm_phase(F.lds, g); } SEAM(10);
    if (IN(11)) { GemmCmp2 g; g.A = (const char*)(ws + WS_CMPH); g.K = 256; g.lda2 = 512; g.ldb2 = 512; g.Bt = (const char*)(ws + WS_WC2); g.G = F.G; g.c = (int)blockIdx.x;
        g.O = (bf16_t*)(ws + WS_CMPO); pg8::gemm_phase(F.lds, g); } SEAM(11);
    if (IN(12)) { attn_phase(F); } SEAM(12);
    if (IN(13)) { GemmResid<false> g; g.A = (const char*)(ws + WS_Q); g.K = 1024; g.lda2 = 2048; g.ldb2 = 2048; g.Bt = (const char*)(ws + WS_W1OUT); g.ord.init(T, D, F.G, (int)blockIdx.x);
        g.res32 = nullptr; g.res16 = OA; g.out = OB; pg8::gemm_phase(F.lds, g); } SEAM(13);
    MOE_LAYER(1, 14, OB, true, nullptr);
#undef MOE_LAYER
#ifdef TPH_LO
    grid.sync(); STAMP(17);
    if (blockIdx.x == 0 && threadIdx.x == 0) { const unsigned long long span = (tp1 - tp0) * TPH_MUL, ts = __builtin_amdgcn_s_memrealtime(); while (__builtin_amdgcn_s_memrealtime() - ts < span) __builtin_amdgcn_s_sleep(32); }
#endif
#undef IN
#undef SEAM
}

extern "C" void kernel_launch(void* const* d_in, const int* in_sizes, int n_in, void* d_out, int out_size, void* d_ws, size_t ws_size, hipStream_t stream) {
    static int grid = 0;
    if (grid == 0) {
        if (n_in != 41 || out_size != T * D || ws_size < WS_END) { fprintf(stderr, "kernel_launch: unexpected problem (n_in %d out %d ws %zu, need %zu)\n", n_in, out_size, ws_size, (size_t)WS_END); grid = -1; return; }
        int dev = 0, cus = 0, per_cu = 0;
        hipGetDevice(&dev); hipDeviceGetAttribute(&cus, hipDeviceAttributeMultiprocessorCount, dev);
        hipFuncSetAttribute((const void*)fwd_kernel, hipFuncAttributeMaxDynamicSharedMemorySize, LDS_BYTES);
        hipOccupancyMaxActiveBlocksPerMultiprocessor(&per_cu, (const void*)fwd_kernel, NTHR, LDS_BYTES);
        if (per_cu < 1) { fprintf(stderr, "kernel_launch: occupancy query says %d blocks/CU\n", per_cu); per_cu = 1; }
        grid = cus * per_cu; if (grid > cus) grid = cus;
        (void)hipGetLastError();
    }
    if (grid < 0) return;
    Args a{};
    for (int i = 0; i < 41; ++i) a.in[i] = (const float*)d_in[i];
    a.out = (float*)d_out; a.ws = (unsigned char*)d_ws; a.ph_lo = 0; a.ph_hi = NPHASE;
    void* kargs[] = {&a};
    hipError_t e = hipLaunchCooperativeKernel((const void*)fwd_kernel, dim3(grid), dim3(NTHR), kargs, LDS_BYTES, stream);
    if (e != hipSuccess) fprintf(stderr, "cooperative launch failed: %s (grid %d)\n", hipGetErrorString(e), grid);
}
```

```cpp
#include <hip/hip_runtime.h>
#include <hip/hip_cooperative_groups.h>
#include <cstdio>
#include <cstdint>
#include <cmath>
namespace cg = cooperative_groups;

#define LAS __attribute__((address_space(3)))
#define DI __device__ __forceinline__
typedef unsigned short bf16_t;
typedef short bf16x8 __attribute__((ext_vector_type(8)));
typedef short s16x4 __attribute__((ext_vector_type(4)));
typedef float f32x2 __attribute__((ext_vector_type(2)));
typedef float f32x4 __attribute__((ext_vector_type(4)));
typedef float f32x16 __attribute__((ext_vector_type(16)));
typedef unsigned u32x2 __attribute__((ext_vector_type(2)));
typedef unsigned u32x4 __attribute__((ext_vector_type(4)));

constexpr int NB = 4, SEQ = 8192, T = NB * SEQ, D = 1024;
constexpr int L0N = 2560;
constexpr int L1N = 2608, L1NP = 2816;
constexpr int NEXP = 32, FF = 512;
constexpr float DN_ALPHA = 1.4142135623730951f;
constexpr float LN_EPS = 1e-5f;
constexpr int NWAVES = 8, NTHR = 512;
constexpr int NCMP = 512;

constexpr size_t MiB = 1u << 20;
constexpr size_t WS_CTL = 0;
constexpr size_t WS_COS = 1 * MiB, WS_SIN = 2 * MiB;
constexpr size_t WS_SMALL = 3 * MiB;
constexpr size_t SM_LRUBT = 0;
constexpr size_t SM_CBIAS = 256 * 1024;
constexpr size_t SM_RWT = 320 * 1024;
constexpr size_t WS_W0IN = 4 * MiB, WS_W0OUT = 9 * MiB, WS_W1IN = 11 * MiB, WS_W1OUT = 17 * MiB;
constexpr size_t WS_WC1 = 19 * MiB;
constexpr size_t WS_WC2 = 21 * MiB;
constexpr size_t WS_LIST = 22 * MiB;
constexpr size_t WS_WSLOT = 26 * MiB;
constexpr size_t WS_POSLOC = WS_WSLOT + 256 * 1024;
constexpr size_t WS_SCAN = 27 * MiB;
constexpr size_t WS_WGU0 = 32 * MiB, WS_WD0 = 96 * MiB, WS_WGU1 = 128 * MiB, WS_WD1 = 192 * MiB;
constexpr size_t WS_ACT = 224 * MiB;
constexpr size_t WS_XB = WS_ACT;
constexpr size_t WS_Z = WS_ACT + 64 * MiB;
constexpr size_t WS_H = WS_ACT + 64 * MiB;
constexpr size_t WS_X8 = WS_ACT + 100 * MiB;
constexpr size_t WS_Y = WS_ACT + 136 * MiB;
constexpr size_t WS_Q = WS_ACT + 64 * MiB;
constexpr size_t WS_KV = WS_ACT + 128 * MiB;
constexpr size_t KV_STRIDE = 17 * MiB;
constexpr size_t WS_GATES = WS_ACT + 232 * MiB;
constexpr size_t WS_CMPH = WS_ACT + 240 * MiB;
constexpr size_t WS_CMPO = WS_ACT + 248 * MiB;
constexpr size_t WS_END = WS_ACT + 280 * MiB;
constexpr int CW_CNT = 64;
constexpr int CW_BAR = 1024;
constexpr int CTL_WORDS = 8192;

DI unsigned f2bf(float f) { unsigned u = __builtin_bit_cast(unsigned, f); return (u + 0x7fffu + ((u >> 16) & 1u)) >> 16; }
DI unsigned pk2(float lo, float hi) { return f2bf(lo) | (f2bf(hi) << 16); }
DI float bf2f(unsigned short b) { return __builtin_bit_cast(float, (unsigned)b << 16); }
DI float bflo(unsigned w) { return __builtin_bit_cast(float, w << 16); }
DI float bfhi(unsigned w) { return __builtin_bit_cast(float, w & 0xffff0000u); }
DI unsigned cvt_pk_bf16(float lo, float hi) { unsigned r; asm volatile("v_cvt_pk_bf16_f32 %0, %1, %2" : "=v"(r) : "v"(lo), "v"(hi)); return r; }
DI float wave_sum(float v) {
    int x = __float_as_int(v);
    x = __float_as_int(__int_as_float(x) + __int_as_float(__builtin_amdgcn_mov_dpp(x, 0xB1, 0xF, 0xF, true)));
    x = __float_as_int(__int_as_float(x) + __int_as_float(__builtin_amdgcn_mov_dpp(x, 0x4E, 0xF, 0xF, true)));
    x = __float_as_int(__int_as_float(x) + __int_as_float(__builtin_amdgcn_mov_dpp(x, 0x141, 0xF, 0xF, true)));
    x = __float_as_int(__int_as_float(x) + __int_as_float(__builtin_amdgcn_mov_dpp(x, 0x140, 0xF, 0xF, true)));
    x = __float_as_int(__int_as_float(x) + __int_as_float(__builtin_amdgcn_update_dpp(0, x, 0x142, 0xA, 0xF, false)));
    x = __float_as_int(__int_as_float(x) + __int_as_float(__builtin_amdgcn_update_dpp(0, x, 0x143, 0xC, 0xF, false)));
    return __int_as_float(__builtin_amdgcn_readlane(x, 63));
}
DI float sigmoidf_(float x) { return __builtin_amdgcn_rcpf(1.0f + __builtin_amdgcn_exp2f(-1.4426950408889634f * x)); }
DI float gelu_tanh(float x) { const float u = 0.7978845608028654f * (x + 0.044715f * x * x * x); return x * __builtin_amdgcn_rcpf(1.0f + __builtin_amdgcn_exp2f(-2.8853900817779268f * u)); }
#define LDS_WAIT() asm volatile("s_waitcnt lgkmcnt(0)" ::: "memory")

namespace pg8 {
constexpr int BM = 256, BK = 64, HALF = 128, HTB = HALF * BK * 2, STAGE_BYTES = 8 * HTB;
__host__ __device__ __forceinline__ int lds_byte(int r, int c) { const int st = (r >> 4) * 2 + (c >> 5), rr = r & 15, cc = c & 31, ob = rr * 64 + cc * 2; return st * 1024 + (ob ^ (((ob >> 9) & 1) << 5)); }
__host__ __device__ __forceinline__ void stage_rc(int b, int& R, int& C) { const int st = b / 1024, sb = b % 1024, swz = sb ^ (((sb >> 9) & 1) << 5); R = (st >> 1) * 16 + swz / 64; C = (st & 1) * 32 + (swz % 64) / 2; }
__host__ __device__ __forceinline__ int perm32(int rho) { const int n = rho >> 4, i = rho & 15; return 8 * (i >> 2) + 4 * n + (i & 3); }
struct GU { int pm, pn, e; };
typedef int v8i32 __attribute__((ext_vector_type(8))); typedef int v4i32 __attribute__((ext_vector_type(4))); typedef long v2i64 __attribute__((ext_vector_type(2)));
__device__ __forceinline__ v8i32 cat8(bf16x8 a, bf16x8 b) { const v4i32 x = __builtin_bit_cast(v4i32, a), y = __builtin_bit_cast(v4i32, b); return __builtin_shufflevector(x, y, 0, 1, 2, 3, 4, 5, 6, 7); }
template <class P>
__device__ __forceinline__ void gemm_phase(LAS unsigned char* lds, const P& p) {
    const int tid = threadIdx.x, wid = __builtin_amdgcn_readfirstlane(tid >> 6), lane = tid & 63, wr = wid >> 2, wc = wid & 3, fr = lane & 15, fq = lane >> 4;
    const int nt = p.K / BK;
    int Rr[2]; unsigned Cc2[2], voffB[2];
#pragma unroll
    for (int i = 0; i < 2; ++i) { int R, C; stage_rc(tid * 16 + i * 8192, R, C); const int Rb = P::PERM ? ((R & ~31) + perm32(R & 31)) : R;
        Rr[i] = R; Cc2[i] = (unsigned)C * 2u; voffB[i] = (unsigned)Rb * p.ldb2 + (unsigned)C * 2u; }
    const size_t kstep = (size_t)(BK * 2);
    const size_t hstepB = (size_t)HALF * p.ldb2;
    const unsigned ldsw = (unsigned)wid * 1024u;
    const int aoff = lds_byte(wr * 64 + fr, fq * 8), boff = lds_byte(wc * 32 + fr, fq * 8);
#define PG8_SA(b, h) (((b) * 2 + (h)) * HTB)
#define PG8_SB(b, h) ((4 + (b) * 2 + (h)) * HTB)
#define PG8_STAGE(bufoff, gbase, voff) do { _Pragma("unroll") for (int _i = 0; _i < 2; ++_i) \
        __builtin_amdgcn_global_load_lds((const unsigned*)((const char*)(gbase) + (voff)[_i]), (LAS unsigned*)(lds + (bufoff) + ldsw + _i * 8192), 16, 0, 0); } while (0)
#define PG8_LDA(dst, b, h) do { _Pragma("unroll") for (int m = 0; m < 4; ++m) _Pragma("unroll") for (int k = 0; k < 2; ++k) dst[m][k] = *(const LAS bf16x8*)(lds + PG8_SA(b, h) + aoff + m * 2048 + k * 1024); } while (0)
#define PG8_LDB(dst, b, h) do { _Pragma("unroll") for (int n = 0; n < 2; ++n) _Pragma("unroll") for (int k = 0; k < 2; ++k) dst[n][k] = *(const LAS bf16x8*)(lds + PG8_SB(b, h) + boff + n * 2048 + k * 1024); } while (0)
#define PG8_MMA(ai, bj, At, Bt) do { __builtin_amdgcn_s_setprio(1); _Pragma("unroll") for (int m = 0; m < 4; ++m) _Pragma("unroll") for (int n = 0; n < 2; ++n) { \
        if constexpr (P::FP8) { _Pragma("unroll") for (int k = 0; k < 2; ++k) { const v2i64 b2 = __builtin_bit_cast(v2i64, Bt[n][k]), a2 = __builtin_bit_cast(v2i64, At[m][k]); \
            acc[ai][bj][m][n] = __builtin_amdgcn_mfma_f32_16x16x32_fp8_fp8(b2[0], a2[0], acc[ai][bj][m][n], 0, 0, 0); acc[ai][bj][m][n] = __builtin_amdgcn_mfma_f32_16x16x32_fp8_fp8(b2[1], a2[1], acc[ai][bj][m][n], 0, 0, 0); } } \
        else { _Pragma("unroll") for (int k = 0; k < 2; ++k) acc[ai][bj][m][n] = __builtin_amdgcn_mfma_f32_16x16x32_bf16(Bt[n][k], At[m][k], acc[ai][bj][m][n], 0, 0, 0); } } \
        __builtin_amdgcn_s_setprio(0); } while (0)
#define PG8_WAIT_V(n) asm volatile("s_waitcnt vmcnt(" #n ")" ::: "memory")
#define PG8_WAIT_L(n) asm volatile("s_waitcnt lgkmcnt(" #n ")" ::: "memory")
#define PG8_BAR __builtin_amdgcn_s_barrier()
#define PG8_SCHED __builtin_amdgcn_sched_barrier(0)
    GU cur, nxt; int ui = 0;
    if (!p.next(0, cur)) return;
    f32x4 acc[2][2][4][2];
#pragma unroll
    for (int a = 0; a < 2; ++a)
#pragma unroll
        for (int b = 0; b < 2; ++b)
#pragma unroll
            for (int m = 0; m < 4; ++m)
#pragma unroll
                for (int n = 0; n < 2; ++n) acc[a][b][m][n] = (f32x4){0.f, 0.f, 0.f, 0.f};
    bf16x8 At[4][2], B0[2][2], B1[2][2];
    unsigned cA0[2], cA1[2], nA0[2], nA1[2];
    size_t cU = 0, nU = 0;
#pragma unroll
    for (int i = 0; i < 2; ++i) {
        if constexpr (P::AUNI) { cA0[i] = (unsigned)Rr[i] * p.lda2 + Cc2[i]; cA1[i] = (unsigned)(HALF + Rr[i]) * p.lda2 + Cc2[i]; }
        else { cA0[i] = p.a_row_off(cur, Rr[i]) + Cc2[i]; cA1[i] = p.a_row_off(cur, HALF + Rr[i]) + Cc2[i]; } }
    if constexpr (P::AUNI) cU = p.a_base(cur);
    const char* const Ab0 = p.A;
#define Ab (Ab0 + cU)
    const char* cB = p.b_tile(cur);
    PG8_STAGE(PG8_SB(0, 0), cB, voffB); PG8_STAGE(PG8_SB(0, 1), cB + hstepB, voffB); PG8_STAGE(PG8_SA(0, 0), Ab, cA0); PG8_STAGE(PG8_SA(0, 1), Ab, cA1);
    if (wr == 1) PG8_BAR;
    PG8_WAIT_V(2); PG8_BAR;
    PG8_STAGE(PG8_SB(1, 0), cB + kstep, voffB); PG8_STAGE(PG8_SA(1, 0), Ab + kstep, cA0); PG8_STAGE(PG8_SB(1, 1), cB + hstepB + kstep, voffB);
    PG8_WAIT_V(6); PG8_BAR;
    for (;;) {
        const bool has_next = p.next(ui + 1, nxt);
        const char* nB = has_next ? p.b_tile(nxt) : cB;
        if constexpr (P::AUNI) nU = has_next ? p.a_base(nxt) : cU;
        else {
#pragma unroll
            for (int i = 0; i < 2; ++i) { nA0[i] = has_next ? p.a_row_off(nxt, Rr[i]) + Cc2[i] : cA0[i]; nA1[i] = has_next ? p.a_row_off(nxt, HALF + Rr[i]) + Cc2[i] : cA1[i]; } }
        for (int t = 0; t < nt; t += 2) {
            const bool last = (t == nt - 2);
            const char* a1 = Ab + (size_t)(t + 1) * kstep;
            const char* a2 = last ? (P::AUNI ? Ab0 + nU : Ab) : Ab + (size_t)(t + 2) * kstep; const char* b2 = last ? nB : cB + (size_t)(t + 2) * kstep;
            const char* a3 = a2 + kstep; const char* b3 = b2 + kstep;
            unsigned o0[2], o1[2];
#pragma unroll
            for (int i = 0; i < 2; ++i) { if constexpr (P::AUNI) { o0[i] = cA0[i]; o1[i] = cA1[i]; } else { o0[i] = last ? nA0[i] : cA0[i]; o1[i] = last ? nA1[i] : cA1[i]; } }
            PG8_LDB(B0, 0, 0); PG8_LDB(B1, 0, 1); PG8_SCHED; PG8_LDA(At, 0, 0); PG8_STAGE(PG8_SA(1, 1), a1, cA1);
            PG8_WAIT_V(8); PG8_WAIT_L(0); PG8_BAR; PG8_MMA(0, 0, At, B0); PG8_MMA(0, 1, At, B1); PG8_BAR; PG8_SCHED;
            PG8_LDA(At, 0, 1); PG8_STAGE(PG8_SB(0, 0), b2, voffB); PG8_STAGE(PG8_SB(0, 1), b2 + hstepB, voffB); PG8_STAGE(PG8_SA(0, 0), a2, o0);
            PG8_WAIT_V(8); PG8_WAIT_L(0); PG8_BAR; PG8_MMA(1, 0, At, B0); PG8_MMA(1, 1, At, B1); PG8_BAR; PG8_SCHED;
            PG8_LDB(B0, 1, 0); PG8_LDB(B1, 1, 1); PG8_SCHED; PG8_LDA(At, 1, 0); PG8_STAGE(PG8_SA(0, 1), a2, o1);
            PG8_WAIT_V(8); PG8_WAIT_L(0); PG8_BAR; PG8_MMA(0, 0, At, B0); PG8_MMA(0, 1, At, B1); PG8_BAR; PG8_SCHED;
            PG8_LDA(At, 1, 1); PG8_STAGE(PG8_SB(1, 0), b3, voffB); PG8_STAGE(PG8_SB(1, 1), b3 + hstepB, voffB); PG8_STAGE(PG8_SA(1, 0), a3, o0);
            PG8_WAIT_V(8); PG8_WAIT_L(0); PG8_BAR; PG8_MMA(1, 0, At, B0); PG8_MMA(1, 1, At, B1); PG8_BAR; PG8_SCHED;
        }
#ifndef PG8_NOALIGN
        if (wr == 0) PG8_BAR;
#endif
        p.epi(acc, cur, wr, wc, fr, fq);
        if (!has_next) break;
#pragma unroll
        for (int a = 0; a < 2; ++a)
#pragma unroll
            for (int b = 0; b < 2; ++b)
#pragma unroll
                for (int m = 0; m < 4; ++m)
#pragma unroll
                    for (int n = 0; n < 2; ++n) acc[a][b][m][n] = (f32x4){0.f, 0.f, 0.f, 0.f};
        cur = nxt; cB = nB; ++ui;
        if constexpr (P::AUNI) cU = nU;
        else {
#pragma unroll
            for (int i = 0; i < 2; ++i) { cA0[i] = nA0[i]; cA1[i] = nA1[i]; } }
#ifndef PG8_NOALIGN
        if (wr == 1) PG8_BAR;
#endif
    }
    PG8_WAIT_V(0);
#ifdef PG8_NOALIGN
    if (wr == 0) PG8_BAR;
#endif
    PG8_BAR;
#undef Ab
#undef PG8_SA
#undef PG8_SB
#undef PG8_STAGE
#undef PG8_LDA
#undef PG8_LDB
#undef PG8_MMA
#undef PG8_WAIT_V
#undef PG8_WAIT_L
#undef PG8_BAR
#undef PG8_SCHED
}
struct TileOrder {
    int nM, nN, nwg, G, c;
    __device__ void init(int M, int N, int G_, int c_) { nM = M / BM; nN = N / BM; nwg = nM * nN; G = G_; c = c_; }
    __device__ bool next(int i, GU& u) const {
        const long L = (long)i * G + c; if (L >= nwg) return false;
        int wgid = (int)L; { const int q = nwg / 8, r = nwg % 8, xcd = wgid % 8, off = wgid / 8; wgid = (xcd < r ? xcd * (q + 1) : r * (q + 1) + (xcd - r) * q) + off; }
        const int WGM = 8; const int nig = WGM * nN, gid = wgid / nig, fm = gid * WGM, gsz = (nM - fm) < WGM ? (nM - fm) : WGM;
        u.pm = fm + ((wgid % nig) % gsz); u.pn = (wgid % nig) / gsz; u.e = 0; return true;
    }
};
}
using pg8::GU;

struct Args { const float* in[41]; float* out; unsigned char* ws; int ph_lo, ph_hi; };

struct GemmPlain {
    static constexpr bool AUNI = true;
    static constexpr bool FP8 = false;
    static constexpr bool PERM = true;
    const char* A; int K; unsigned lda2, ldb2; const char* Bt; pg8::TileOrder ord;
    bf16_t* C; int ldc;
    DI bool next(int i, GU& u) const { return ord.next(i, u); }
    DI unsigned a_row_off(const GU& u, int r) const { return (unsigned)(u.pm * 256 + r) * lda2; }
    DI size_t a_base(const GU& u) const { return (size_t)(u.pm * 256) * lda2; }
    DI const char* b_tile(const GU& u) const { return Bt + (size_t)u.pn * 256 * ldb2; }
    DI void epi(const f32x4 (&acc)[2][2][4][2], const GU& u, int wr, int wc, int fr, int fq) const {
        const int row0 = u.pm * 256 + wr * 64 + fr, col0 = u.pn * 256 + wc * 32 + 8 * fq;
#pragma unroll
        for (int ai = 0; ai < 2; ++ai)
#pragma unroll
            for (int m = 0; m < 4; ++m) { bf16_t* rowp = C + (size_t)(row0 + ai * 128 + m * 16) * ldc + col0;
#pragma unroll
                for (int bj = 0; bj < 2; ++bj) { const f32x4 v0 = acc[ai][bj][m][0], v1 = acc[ai][bj][m][1];
                    u32x4 w; w.x = cvt_pk_bf16(v0[0], v0[1]); w.y = cvt_pk_bf16(v0[2], v0[3]); w.z = cvt_pk_bf16(v1[0], v1[1]); w.w = cvt_pk_bf16(v1[2], v1[3]);
                    *(u32x4*)(rowp + bj * 128) = w; } }
    }
};
template <bool RES32>
struct GemmResid {
    static constexpr bool AUNI = true;
    static constexpr bool FP8 = false;
    static constexpr bool PERM = true;
    const char* A; int K; unsigned lda2, ldb2; const char* Bt; pg8::TileOrder ord;
    const float* res32; const bf16_t* res16; bf16_t* out;
    DI bool next(int i, GU& u) const { return ord.next(i, u); }
    DI unsigned a_row_off(const GU& u, int r) const { return (unsigned)(u.pm * 256 + r) * lda2; }
    DI size_t a_base(const GU& u) const { return (size_t)(u.pm * 256) * lda2; }
    DI const char* b_tile(const GU& u) const { return Bt + (size_t)u.pn * 256 * ldb2; }
    DI void epi(const f32x4 (&acc)[2][2][4][2], const GU& u, int wr, int wc, int fr, int fq) const {
        const int col0 = u.pn * 256 + wc * 32 + 8 * fq; const size_t rbase = (size_t)(u.pm * 256 + wr * 64 + fr) * D + col0;
        if constexpr (RES32) {
#pragma unroll
            for (int ai = 0; ai < 2; ++ai) {
                f32x4 r[4][2][2];
#pragma unroll
                for (int m = 0; m < 4; ++m)
#pragma unroll
                    for (int bj = 0; bj < 2; ++bj) { const float* rp = res32 + rbase + (size_t)(ai * 128 + m * 16) * D + bj * 128; r[m][bj][0] = *(const f32x4*)rp; r[m][bj][1] = *(const f32x4*)(rp + 4); }
#pragma unroll
                for (int m = 0; m < 4; ++m)
#pragma unroll
                    for (int bj = 0; bj < 2; ++bj) { const f32x4 v0 = r[m][bj][0] * DN_ALPHA + acc[ai][bj][m][0], v1 = r[m][bj][1] * DN_ALPHA + acc[ai][bj][m][1];
                        u32x4 w; w.x = cvt_pk_bf16(v0[0], v0[1]); w.y = cvt_pk_bf16(v0[2], v0[3]); w.z = cvt_pk_bf16(v1[0], v1[1]); w.w = cvt_pk_bf16(v1[2], v1[3]);
                        *(u32x4*)(out + rbase + (size_t)(ai * 128 + m * 16) * D + bj * 128) = w; }
            }
        } else {
            u32x4 r[2][4][2];
#pragma unroll
            for (int ai = 0; ai < 2; ++ai)
#pragma unroll
                for (int m = 0; m < 4; ++m)
#pragma unroll
                    for (int bj = 0; bj < 2; ++bj) r[ai][m][bj] = *(const u32x4*)(res16 + rbase + (size_t)(ai * 128 + m * 16) * D + bj * 128);
#pragma unroll
            for (int ai = 0; ai < 2; ++ai)
#pragma unroll
                for (int m = 0; m < 4; ++m)
#pragma unroll
                    for (int bj = 0; bj < 2; ++bj) { const u32x4 q = r[ai][m][bj]; const f32x4 a0 = acc[ai][bj][m][0], a1 = acc[ai][bj][m][1];
                        u32x4 w; w.x = cvt_pk_bf16(bflo(q.x) * DN_ALPHA + a0[0], bfhi(q.x) * DN_ALPHA + a0[1]); w.y = cvt_pk_bf16(bflo(q.y) * DN_ALPHA + a0[2], bfhi(q.y) * DN_ALPHA + a0[3]);
                        w.z = cvt_pk_bf16(bflo(q.z) * DN_ALPHA + a1[0], bfhi(q.z) * DN_ALPHA + a1[1]); w.w = cvt_pk_bf16(bflo(q.w) * DN_ALPHA + a1[2], bfhi(q.w) * DN_ALPHA + a1[3]);
                        *(u32x4*)(out + rbase + (size_t)(ai * 128 + m * 16) * D + bj * 128) = w; }
        }
    }
};
struct MoeTab { const LAS int* tbase; const LAS int* cnt; int ntiles; };
struct GemmMoeUp {
    static constexpr bool AUNI = false;
    static constexpr bool FP8 = true;
    static constexpr bool PERM = true;
    const char* A; int K; unsigned lda2, ldb2; const char* Bt; int G, c;
    MoeTab tab; const unsigned* list; bf16_t* H;
    DI bool next(int i, GU& u) const {
        const int L = i * G + c; if (L >= tab.ntiles * 4) return false;
        const int tile = L >> 2; u.pn = L & 3; int e = 0;
#pragma unroll 1
        while (tab.tbase[e + 1] <= tile) ++e;
        u.e = e; u.pm = tile - tab.tbase[e]; return true;
    }
    DI unsigned a_row_off(const GU& u, int r) const {
        const int li = u.pm * 256 + r; const int cn = tab.cnt[u.e];
        const unsigned slot = li < cn ? list[(size_t)u.e * T + li] : 0u;
        return (slot >> 1) * lda2;
    }
    DI size_t a_base(const GU&) const { return 0; }
    DI const char* b_tile(const GU& u) const { return Bt + ((size_t)u.e * 1024 + (size_t)u.pn * 256) * ldb2; }
    DI void epi(const f32x4 (&acc)[2][2][4][2], const GU& u, int wr, int wc, int fr, int fq) const {
        const int hrow0 = (tab.tbase[u.e] + u.pm) * 256 + wr * 64 + fr, col0 = u.pn * 128 + wc * 32 + 8 * fq;
#pragma unroll
        for (int ai = 0; ai < 2; ++ai)
#pragma unroll
            for (int m = 0; m < 4; ++m) { unsigned char* rowp = (unsigned char*)H + (size_t)(hrow0 + ai * 128 + m * 16) * FF + col0;
                float h[8];
#pragma unroll
                for (int n = 0; n < 2; ++n)
#pragma unroll
                    for (int j = 0; j < 4; ++j) { const float g = acc[ai][0][m][n][j] * 0.03125f, uu = acc[ai][1][m][n][j] * 0.03125f; h[n * 4 + j] = g * uu / (1.0f + __expf(-g)); }
                int w0 = 0, w1 = 0; w0 = __builtin_amdgcn_cvt_pk_fp8_f32(h[0], h[1], w0, false); w0 = __builtin_amdgcn_cvt_pk_fp8_f32(h[2], h[3], w0, true);
                w1 = __builtin_amdgcn_cvt_pk_fp8_f32(h[4], h[5], w1, false); w1 = __builtin_amdgcn_cvt_pk_fp8_f32(h[6], h[7], w1, true);
                *(u32x2*)rowp = (u32x2){(unsigned)w0, (unsigned)w1}; }
    }
};
struct GemmMoeDown {
    static constexpr bool AUNI = true;
    static constexpr bool FP8 = true;
    static constexpr bool PERM = true;
    const char* A; int K; unsigned lda2, ldb2; const char* Bt; int G, c;
    MoeTab tab; bf16_t* Y;
    DI bool next(int i, GU& u) const {
        const int L = i * G + c; if (L >= tab.ntiles * 4) return false;
        const int tile = L >> 2; u.pn = L & 3; int e = 0;
#pragma unroll 1
        while (tab.tbase[e + 1] <= tile) ++e;
        u.e = e; u.pm = tile - tab.tbase[e]; return true;
    }
    DI unsigned a_row_off(const GU& u, int r) const { return (unsigned)((tab.tbase[u.e] + u.pm) * 256 + r) * lda2; }
    DI size_t a_base(const GU& u) const { return (size_t)((tab.tbase[u.e] + u.pm) * 256) * lda2; }
    DI const char* b_tile(const GU& u) const { return Bt + ((size_t)u.e * 1024 + (size_t)u.pn * 256) * ldb2; }
    DI void epi(const f32x4 (&acc)[2][2][4][2], const GU& u, int wr, int wc, int fr, int fq) const {
        const int row0 = (tab.tbase[u.e] + u.pm) * 256 + wr * 64 + fr, col0 = u.pn * 256 + wc * 32 + 8 * fq;
#pragma unroll
        for (int ai = 0; ai < 2; ++ai)
#pragma unroll
            for (int m = 0; m < 4; ++m) { bf16_t* rowp = Y + (size_t)(row0 + ai * 128 + m * 16) * D + col0;
#pragma unroll
                for (int bj = 0; bj < 2; ++bj) { const f32x4 v0 = acc[ai][bj][m][0] * 0.03125f, v1 = acc[ai][bj][m][1] * 0.03125f;
                    u32x4 w; w.x = cvt_pk_bf16(v0[0], v0[1]); w.y = cvt_pk_bf16(v0[2], v0[3]); w.z = cvt_pk_bf16(v1[0], v1[1]); w.w = cvt_pk_bf16(v1[2], v1[3]);
                    *(u32x4*)(rowp + bj * 128) = w; } }
    }
};

#define XB_TMO      128
#define XB_XCNT(j)  (256  + 64 * (j))
#define XB_XSUB(j)  (1280 + 64 * (j))
#define XB_XGEN(j)  (2304 + 64 * (j))
#define XB_TOP      3328
#define XB_TOPGEN   3392
#define XCD_BAR_WORDS 3456
#define XB_SPIN_CAP (1u << 18)
__device__ __forceinline__ unsigned xb_ld(unsigned* p)              { return __hip_atomic_load(p, __ATOMIC_RELAXED, __HIP_MEMORY_SCOPE_AGENT); }
__device__ __forceinline__ unsigned xb_add(unsigned* p, unsigned v) { return __hip_atomic_fetch_add(p, v, __ATOMIC_RELAXED, __HIP_MEMORY_SCOPE_AGENT); }
__device__ __forceinline__ unsigned xb_xcc_id() { return (unsigned)__builtin_amdgcn_s_getreg((3 << 11) | 20) & 0xFu; }
#define XB_SPIN(cond, bar) do { unsigned _sp = 0; while (cond) { __builtin_amdgcn_s_sleep(1); \
    if ((++_sp & 255u) == 0u) { if (xb_ld(&(bar)[XB_TMO])) break; if (_sp > XB_SPIN_CAP) { atomicAdd(&(bar)[XB_TMO], 1u); break; } } } } while (0)
struct XcdBarrier { unsigned* bar; unsigned x; volatile LAS unsigned* st; };
__device__ __forceinline__ XcdBarrier xcd_barrier_post(unsigned* bar, volatile LAS unsigned* st) {
    XcdBarrier b; b.bar = bar; b.x = xb_xcc_id(); b.st = st;
    if (threadIdx.x == 0) (void)xb_add(&bar[XB_XCNT(b.x)], 1u);
    return b;
}
__device__ __forceinline__ void xcd_barrier_complete(unsigned* bar, unsigned x, unsigned& nloc, unsigned& nx) {
    const unsigned G = gridDim.x * gridDim.y * gridDim.z;
    unsigned sum, cnt, mine, sp = 0u;
    for (;;) {
        sum = 0u; cnt = 0u; mine = 0u;
#pragma unroll
        for (unsigned j = 0; j < 16; ++j) { const unsigned c = xb_ld(&bar[XB_XCNT(j)]); sum += c; cnt += (c > 0u) ? 1u : 0u; mine = (j == x) ? c : mine; }
        if (sum == G) break;
        __builtin_amdgcn_s_sleep(1);
        if ((++sp & 255u) == 0u) { if (xb_ld(&bar[XB_TMO])) break; if (sp > XB_SPIN_CAP) { atomicAdd(&bar[XB_TMO], 1u); break; } }
    }
    nloc = mine > 0u ? mine : 1u; nx = cnt > 0u ? cnt : 1u;
}
__device__ __forceinline__ void xcd_barrier(const XcdBarrier& b) {
    asm volatile("s_waitcnt vmcnt(0)" ::: "memory");
    __syncthreads();
    if (threadIdx.x == 0) {
        unsigned* bar = b.bar;
        __builtin_amdgcn_s_waitcnt(0);
        unsigned nloc = b.st[0], nx = b.st[1];
        if (nloc == 0u) { xcd_barrier_complete(bar, b.x, nloc, nx); b.st[0] = nloc; b.st[1] = nx; }
        const unsigned old = xb_add(&bar[XB_XSUB(b.x)], 1u);
        const unsigned gen = old / nloc;
        if (old + 1u == (gen + 1u) * nloc) {
            __builtin_amdgcn_fence(__ATOMIC_RELEASE, "agent");
            asm volatile("s_waitcnt vmcnt(0)" ::: "memory");
            const unsigned og = xb_add(&bar[XB_TOP], 1u);
            const unsigned tg = og / nx;
            if (og + 1u == (tg + 1u) * nx) xb_add(&bar[XB_TOPGEN], 1u);
            else XB_SPIN(xb_ld(&bar[XB_TOPGEN]) == tg, bar);
            __builtin_amdgcn_fence(__ATOMIC_ACQUIRE, "agent");
            xb_add(&bar[XB_XGEN(b.x)], 1u);
            asm volatile("s_waitcnt vmcnt(0)" ::: "memory");
        } else {
            XB_SPIN(xb_ld(&bar[XB_XGEN(b.x)]) == gen, bar);
            __builtin_amdgcn_fence(__ATOMIC_ACQUIRE, "agent");
            asm volatile("s_waitcnt vmcnt(0)" ::: "memory");
        }
    }
    __syncthreads();
}

struct Frame {
    LAS unsigned char* lds;
    int tid, lane, wave, vcu, G;
    const float* const* in; float* out; unsigned char* ws;
};
constexpr int LDS_RING = 131072;
constexpr int LDS_MISC = LDS_RING;
constexpr int LDS_BYTES = 147456;

template <class Map>
DI void p0_transpose_item(const float* W, int K, int N, bf16_t* WT, const Map& map, LAS float* scr_, int item, int lane) {
    LAS unsigned char* scr = (LAS unsigned char*)scr_;
    const int nblk = (N + 63) / 64, kb = item / nblk, nb = item % nblk, k0 = 64 * kb, n0 = 64 * nb;
    const int kk = lane >> 4, n4 = 4 * (lane & 15);
    const bool nok = (n0 + n4) < N;
    f32x4 v[16];
#pragma unroll
    for (int i = 0; i < 16; ++i) v[i] = nok ? *(const f32x4*)(W + (size_t)(k0 + 16 * kk + i) * N + n0 + n4) : (f32x4){0.f, 0.f, 0.f, 0.f};
#pragma unroll
    for (int c = 0; c < 4; ++c) {
        u32x4 lo, hi;
        lo.x = pk2(v[0][c], v[1][c]); lo.y = pk2(v[2][c], v[3][c]); lo.z = pk2(v[4][c], v[5][c]); lo.w = pk2(v[6][c], v[7][c]);
        hi.x = pk2(v[8][c], v[9][c]); hi.y = pk2(v[10][c], v[11][c]); hi.z = pk2(v[12][c], v[13][c]); hi.w = pk2(v[14][c], v[15][c]);
        *(LAS u32x4*)(scr + (n4 + c) * 144 + kk * 32) = lo; *(LAS u32x4*)(scr + (n4 + c) * 144 + kk * 32 + 16) = hi;
    }
    LDS_WAIT(); asm volatile("" ::: "memory");
#pragma unroll
    for (int j = 0; j < 8; ++j) { const int n = (lane >> 3) + 8 * j, ch = lane & 7;
        const u32x4 o = *(const LAS u32x4*)(scr + n * 144 + ch * 16);
        if (n0 + n < N) *(u32x4*)(WT + (size_t)map(n0 + n) * K + k0 + 8 * ch) = o; }
    LDS_WAIT(); asm volatile("" ::: "memory");
}
template <class Map>
DI void p0_transpose_item_f8(const float* W, int K, int N, unsigned char* WT, const Map& map, LAS float* scr_, int item, int lane) {
    LAS unsigned char* scr = (LAS unsigned char*)scr_;
    const int nblk = N / 64, kb = item / nblk, nb = item % nblk, k0 = 64 * kb, n0 = 64 * nb;
    const int kk = lane >> 4, n4 = 4 * (lane & 15);
    f32x4 v[16];
#pragma unroll
    for (int i = 0; i < 16; ++i) v[i] = *(const f32x4*)(W + (size_t)(k0 + 16 * kk + i) * N + n0 + n4) * 32.0f;
#pragma unroll
    for (int c = 0; c < 4; ++c) { int w[4];
#pragma unroll
        for (int q = 0; q < 4; ++q) { int x = 0; x = __builtin_amdgcn_cvt_pk_fp8_f32(v[4 * q][c], v[4 * q + 1][c], x, false); x = __builtin_amdgcn_cvt_pk_fp8_f32(v[4 * q + 2][c], v[4 * q + 3][c], x, true); w[q] = x; }
        *(LAS u32x4*)(scr + (n4 + c) * 80 + kk * 16) = (u32x4){(unsigned)w[0], (unsigned)w[1], (unsigned)w[2], (unsigned)w[3]}; }
    LDS_WAIT(); asm volatile("" ::: "memory");
#pragma unroll
    for (int j = 0; j < 4; ++j) { const int n = (lane >> 2) + 16 * j, ch = lane & 3;
        const u32x4 o = *(const LAS u32x4*)(scr + n * 80 + ch * 16);
        *(u32x4*)(WT + (size_t)map(n0 + n) * K + k0 + 16 * ch) = o; }
    LDS_WAIT(); asm volatile("" ::: "memory");
}
struct MapId { int off; DI int operator()(int n) const { return n + off; } };
DI int rope_perm(int d) { return (d & 15) | ((d & 16) << 1) | ((d & 32) >> 1); }
struct MapL1In { DI int operator()(int n) const {
    if (n < 1024) return (n & ~63) | rope_perm(n & 63);
    if (n < 2560) { const int j = (n - 1024) >> 8; return (j & 1) ? n : ((n & ~63) | rope_perm(n & 63)); }
    return n; } };
struct MapGU { int up; DI int operator()(int c) const { return (c >> 7) * 256 + up * 128 + (c & 127); } };

DI void p0_prep(Frame& F) {
    LAS float* scr = (LAS float*)(F.lds + F.wave * 16384);
    const int gw = F.vcu * NWAVES + F.wave, NGW = F.G * NWAVES;
    const int gt = F.vcu * NTHR + F.tid, NGT = F.G * NTHR;
    unsigned char* ws = F.ws;
    for (int i = gt; i < CTL_WORDS; i += NGT) ((unsigned*)(ws + WS_CTL))[i] = 0u;
    constexpr int I_W0IN = 16 * 40, I_W0OUT = 16 * 16, I_W1IN = 16 * 41, I_W1OUT = 16 * 16, I_WC1 = 32 * 4, I_WC2 = 4 * 1, I_MOE = 32 * 128;
    constexpr int NITEMS = I_W0IN + I_W0OUT + I_W1IN + I_W1OUT + 2 * I_WC1 + 2 * I_WC2 + 3 * I_MOE;
    for (int it = gw; it < NITEMS; it += NGW) {
        int r = it;
        if (r < I_W0IN) { p0_transpose_item(F.in[1], 1024, L0N, (bf16_t*)(ws + WS_W0IN), MapId{0}, scr, r, F.lane); continue; } r -= I_W0IN;
        if (r < I_W0OUT) { p0_transpose_item(F.in[10], 1024, 1024, (bf16_t*)(ws + WS_W0OUT), MapId{0}, scr, r, F.lane); continue; } r -= I_W0OUT;
        if (r < I_W1IN) { p0_transpose_item(F.in[22], 1024, L1N, (bf16_t*)(ws + WS_W1IN), MapL1In{}, scr, r, F.lane); continue; } r -= I_W1IN;
        if (r < I_W1OUT) { p0_transpose_item(F.in[29], 1024, 1024, (bf16_t*)(ws + WS_W1OUT), MapId{0}, scr, r, F.lane); continue; } r -= I_W1OUT;
        if (r < I_WC1) { p0_transpose_item(F.in[24], 2048, 256, (bf16_t*)(ws + WS_WC1), MapId{0}, scr, r, F.lane); continue; } r -= I_WC1;
        if (r < I_WC1) { p0_transpose_item(F.in[27], 2048, 256, (bf16_t*)(ws + WS_WC1) + 256 * 2048, MapId{0}, scr, r, F.lane); continue; } r -= I_WC1;
        if (r < I_WC2) { p0_transpose_item(F.in[25], 256, 64, (bf16_t*)(ws + WS_WC2), MapId{0}, scr, r, F.lane); continue; } r -= I_WC2;
        if (r < I_WC2) { p0_transpose_item(F.in[28], 256, 64, (bf16_t*)(ws + WS_WC2) + 256 * 256, MapId{0}, scr, r, F.lane); continue; } r -= I_WC2;
#pragma unroll 1
        for (int l = 0; l < 1; ++l) {
            const int ib = l ? 36 : 17; unsigned char* wgu = ws + (l ? WS_WGU1 : WS_WGU0); unsigned char* wd = ws + (l ? WS_WD1 : WS_WD0);
            if (r < I_MOE) { const int e = r >> 7; p0_transpose_item_f8(F.in[ib] + (size_t)e * 1024 * 512, 1024, 512, wgu + (size_t)e * 1024 * 1024, MapGU{0}, scr, r & 127, F.lane); r = -1; break; } r -= I_MOE;
            if (r < I_MOE) { const int e = r >> 7; p0_transpose_item_f8(F.in[ib + 1] + (size_t)e * 1024 * 512, 1024, 512, wgu + (size_t)e * 1024 * 1024, MapGU{1}, scr, r & 127, F.lane); r = -1; break; } r -= I_MOE;
            if (r < I_MOE) { const int e = r >> 7; p0_transpose_item_f8(F.in[ib + 2] + (size_t)e * 512 * 1024, 512, 1024, wd + (size_t)e * 1024 * 512, MapId{0}, scr, r & 127, F.lane); r = -1; break; } r -= I_MOE;
        }
    }
    { u32x4 z = (u32x4){0u, 0u, 0u, 0u};
      u32x4* p1 = (u32x4*)((bf16_t*)(ws + WS_W1IN) + (size_t)L1N * 1024); const int n1 = (L1NP - L1N) * 1024 / 8;
      for (int i = gt; i < n1; i += NGT) p1[i] = z;
      for (int kv = 0; kv < 2; ++kv) { u32x4* p2 = (u32x4*)((bf16_t*)(ws + WS_WC2) + (size_t)kv * 65536 + 64 * 256); const int n2 = 192 * 256 / 8; for (int i = gt; i < n2; i += NGT) p2[i] = z; } }
    { const float* x = F.in[0]; bf16_t* xb = (bf16_t*)(ws + WS_XB);
      for (int m = gw; m < T; m += NGW) { const f32x4* xr = (const f32x4*)(x + (size_t)m * D) + F.lane; u32x2* o = (u32x2*)(xb + (size_t)m * D) + F.lane;
#pragma unroll
          for (int j = 0; j < 4; ++j) { const f32x4 v = xr[64 * j]; o[64 * j] = (u32x2){pk2(v.x, v.y), pk2(v.z, v.w)}; } } }
    { float* ct = (float*)(ws + WS_COS); float* st = (float*)(ws + WS_SIN);
      for (int i = gt; i < SEQ * 32; i += NGT) { const int pos = i >> 5, k = i & 31; const float inv = (float)pow(10000.0, -(double)(2 * k) / 64.0); const float ang = (float)pos * inv;
          ct[i] = (float)cos((double)ang); st[i] = (float)sin((double)ang); } }
    { bf16_t* bt = (bf16_t*)(ws + WS_SMALL + SM_LRUBT);
      for (int i = gt; i < 2 * 8 * 4096; i += NGT) { const int g = i >> 15, h = (i >> 12) & 7, j = (i >> 6) & 63, ii = i & 63; const float* w = F.in[g ? 7 : 5];
          bt[i] = (bf16_t)f2bf(w[h * 4096 + ii * 64 + j]); } }
    { float* rw = (float*)(ws + WS_SMALL + SM_RWT);
      for (int i = gt; i < 2 * 36 * 1024; i += NGT) { const int l = i / (36 * 1024), o = (i / 1024) % 36, k = i & 1023; const float* wg = F.in[l ? 32 : 13]; const float* we = F.in[l ? 34 : 15];
          rw[i] = o < 4 ? wg[k * 4 + o] : we[k * 32 + (o - 4)]; } }
    { float* cb = (float*)(ws + WS_SMALL + SM_CBIAS);
      for (int o = gw; o < 512; o += NGW) { const int kv = o >> 8, j = o & 255; const float* pe = F.in[kv ? 26 : 23]; const float* w1 = F.in[kv ? 27 : 24];
          float s = 0.f; for (int k = F.lane; k < 2048; k += 64) s += pe[k] * w1[(size_t)k * 256 + j];
          s = wave_sum(s); if (F.lane == 0) cb[o] = s; } }
}

DI void p0_moe1(Frame& F, int first) {
    LAS float* scr = (LAS float*)(F.lds + F.wave * 16384);
    const int nb = F.G - first; if (nb <= 0 || (int)blockIdx.x < first) return;
    const int gw = ((int)blockIdx.x - first) * NWAVES + F.wave, NGW = nb * NWAVES;
    unsigned char* ws = F.ws; constexpr int I_MOE = 32 * 128;
    unsigned char* wgu = ws + WS_WGU1; unsigned char* wd = ws + WS_WD1;
    for (int it = gw; it < 3 * I_MOE; it += NGW) {
        int r = it;
        if (r < I_MOE) { const int e = r >> 7; p0_transpose_item_f8(F.in[36] + (size_t)e * 1024 * 512, 1024, 512, wgu + (size_t)e * 1024 * 1024, MapGU{0}, scr, r & 127, F.lane); continue; } r -= I_MOE;
        if (r < I_MOE) { const int e = r >> 7; p0_transpose_item_f8(F.in[37] + (size_t)e * 1024 * 512, 1024, 512, wgu + (size_t)e * 1024 * 1024, MapGU{1}, scr, r & 127, F.lane); continue; } r -= I_MOE;
        { const int e = r >> 7; p0_transpose_item_f8(F.in[38] + (size_t)e * 512 * 1024, 512, 1024, wd + (size_t)e * 1024 * 512, MapId{0}, scr, r & 127, F.lane); }
    }
}

constexpr int XCL_STRIDE = 520;
constexpr int LDS_XC = 0, LDS_GT = 66560, LDS_HIN = 133120;
DI f32x2 lds_swap(float v) { auto rr = __builtin_amdgcn_permlane32_swap(__float_as_uint(v), __float_as_uint(v), false, false); return (f32x2){__uint_as_float(rr[0]), __uint_as_float(rr[1])}; }

template <int CTRL> DI float quad_xor(float v) { return __int_as_float(__builtin_amdgcn_mov_dpp(__float_as_int(v), CTRL, 0xF, 0xF, true)); }

template <bool FINAL>
DI void lru_tile(Frame& F, int b, int ch) {
    const unsigned char* ws = F.ws;
    const bf16_t* z = (const bf16_t*)(ws + WS_Z);
    bf16_t* ycat = (bf16_t*)(ws + WS_XB);
    f32x2* SAH = (f32x2*)(ws + WS_SCAN);
    LAS bf16_t* xcL = (LAS bf16_t*)(F.lds + LDS_XC); LAS bf16_t* gL = (LAS bf16_t*)(F.lds + LDS_GT); LAS float* hin = (LAS float*)(F.lds + LDS_HIN);
    const int tid = F.tid, lane = F.lane, wave = F.wave;
    const int t0 = ch * 64; const size_t row0 = (size_t)b * SEQ + t0;
    const int c8 = tid & 63, tg = tid >> 6;
    {
        float w[4][8], bias[8];
        const float* cw = F.in[3]; const float* cbv = F.in[4];
#pragma unroll
        for (int k = 0; k < 4; ++k)
#pragma unroll
            for (int j = 0; j < 8; ++j) w[k][j] = cw[k * 512 + c8 * 8 + j];
#pragma unroll
        for (int j = 0; j < 8; ++j) bias[j] = cbv[c8 * 8 + j];
        float xv[11][8];
#pragma unroll
        for (int i = 0; i < 11; ++i) { const int t = t0 + tg * 8 + i - 3;
            if (t >= 0) { const u32x4 v = *(const u32x4*)(z + ((size_t)b * SEQ + t) * L0N + 2048 + c8 * 8);
                xv[i][0] = bflo(v.x); xv[i][1] = bfhi(v.x); xv[i][2] = bflo(v.y); xv[i][3] = bfhi(v.y); xv[i][4] = bflo(v.z); xv[i][5] = bfhi(v.z); xv[i][6] = bflo(v.w); xv[i][7] = bfhi(v.w); }
            else {
#pragma unroll
                for (int j = 0; j < 8; ++j) xv[i][j] = 0.f; } }
#pragma unroll
        for (int i = 0; i < 8; ++i) { float o[8];
#pragma unroll
            for (int j = 0; j < 8; ++j) o[j] = bias[j] + w[0][j] * xv[i][j] + w[1][j] * xv[i + 1][j] + w[2][j] * xv[i + 2][j] + w[3][j] * xv[i + 3][j];
            u32x4 pk; pk.x = pk2(o[0], o[1]); pk.y = pk2(o[2], o[3]); pk.z = pk2(o[4], o[5]); pk.w = pk2(o[6], o[7]);
            *(LAS u32x4*)(xcL + (tg * 8 + i) * XCL_STRIDE + c8 * 8) = pk; }
    }
    if constexpr (FINAL) {
#pragma unroll
        for (int i = 0; i < 8; ++i) { const int tl = tg * 8 + i; const u32x4 v = *(const u32x4*)(z + (row0 + tl) * L0N + 1536 + c8 * 8); *(LAS u32x4*)(gL + tl * XCL_STRIDE + c8 * 8) = v; }
        float w[3][8]; const float* cw = F.in[2];
#pragma unroll
        for (int k = 0; k < 3; ++k)
#pragma unroll
            for (int j = 0; j < 8; ++j) w[k][j] = cw[k * 512 + c8 * 8 + j];
        float pv[10][8];
#pragma unroll
        for (int i = 0; i < 10; ++i) { const int t = t0 + tg * 8 + i - 2;
            if (t >= 0) { const bf16_t* zr = z + ((size_t)b * SEQ + t) * L0N + c8 * 8; const u32x4 a = *(const u32x4*)(zr + 512), c = *(const u32x4*)(zr + 1024);
                pv[i][0] = bflo(a.x) * bflo(c.x); pv[i][1] = bfhi(a.x) * bfhi(c.x); pv[i][2] = bflo(a.y) * bflo(c.y); pv[i][3] = bfhi(a.y) * bfhi(c.y);
                pv[i][4] = bflo(a.z) * bflo(c.z); pv[i][5] = bfhi(a.z) * bfhi(c.z); pv[i][6] = bflo(a.w) * bflo(c.w); pv[i][7] = bfhi(a.w) * bfhi(c.w); }
            else {
#pragma unroll
                for (int j = 0; j < 8; ++j) pv[i][j] = 0.f; } }
#pragma unroll
        for (int i = 0; i < 8; ++i) { const int tl = tg * 8 + i; const u32x4 bgv = *(const u32x4*)(z + (row0 + tl) * L0N + c8 * 8);
            const float bgf[8] = {bflo(bgv.x), bfhi(bgv.x), bflo(bgv.y), bfhi(bgv.y), bflo(bgv.z), bfhi(bgv.z), bflo(bgv.w), bfhi(bgv.w)};
            float o[8];
#pragma unroll
            for (int j = 0; j < 8; ++j) o[j] = bgf[j] * (w[0][j] * pv[i][j] + w[1][j] * pv[i + 1][j] + w[2][j] * pv[i + 2][j]);
            u32x4 pk; pk.x = pk2(o[0], o[1]); pk.y = pk2(o[2], o[3]); pk.z = pk2(o[4], o[5]); pk.w = pk2(o[6], o[7]);
            *(u32x4*)(ycat + (row0 + tl) * D + c8 * 8) = pk; }
        { float h = 0.f; const f32x4* sp4 = (const f32x4*)(SAH + ((size_t)b * 512 + tid) * 128);
#pragma unroll 8
          for (int k2 = 0; k2 < (ch >> 1); ++k2) { const f32x4 v = sp4[k2]; h = v.x * h + v.y; h = v.z * h + v.w; }
          if (ch & 1) { const f32x2 v = SAH[((size_t)b * 512 + tid) * 128 + ch - 1]; h = v.x * h + v.y; }
          hin[tid] = h; }
    }
    __syncthreads();
    {
        const int head = wave, r32 = lane & 31, hh = lane >> 5;
        const bf16_t* lbt = (const bf16_t*)(ws + WS_SMALL + SM_LRUBT);
        const float* b_a = F.in[6]; const float* b_x = F.in[8]; const float* lam = F.in[9];
#pragma unroll 1
        for (int ct = 0; ct < 2; ++ct) {
            const int c = head * 64 + ct * 32 + r32;
            f32x16 acc[2][2];
#pragma unroll
            for (int g = 0; g < 2; ++g)
#pragma unroll
                for (int rt = 0; rt < 2; ++rt)
#pragma unroll
                    for (int i = 0; i < 16; ++i) acc[g][rt][i] = 0.f;
#pragma unroll
            for (int ks = 0; ks < 4; ++ks) {
                bf16x8 af[2], bfr[2];
#pragma unroll
                for (int rt = 0; rt < 2; ++rt) af[rt] = *(const LAS bf16x8*)(xcL + (rt * 32 + r32) * XCL_STRIDE + head * 64 + ks * 16 + hh * 8);
#pragma unroll
                for (int g = 0; g < 2; ++g) bfr[g] = *(const bf16x8*)(lbt + ((size_t)(g * 8 + head) * 64 + ct * 32 + r32) * 64 + ks * 16 + hh * 8);
#pragma unroll
                for (int g = 0; g < 2; ++g)
#pragma unroll
                    for (int rt = 0; rt < 2; ++rt) acc[g][rt] = __builtin_amdgcn_mfma_f32_32x32x16_bf16(af[rt], bfr[g], acc[g][rt], 0, 0, 0);
            }
            const float ba = b_a[c], bx = b_x[c]; const float lm = lam[c];
            const float sp = (lm > 15.f) ? __expf(-lm) : log1pf(__expf(-lm));
            float carry = FINAL ? hin[c] : 0.f, atot = 1.f;
#pragma unroll
            for (int rt = 0; rt < 2; ++rt) {
#pragma unroll
                for (int g4 = 0; g4 < 4; ++g4) {
                    float av[4], uv[4]; float Ag = 1.f, Hg = 0.f;
#pragma unroll
                    for (int j = 0; j < 4; ++j) { const int reg = g4 * 4 + j; const int tl = rt * 32 + 8 * g4 + 4 * hh + j;
                        const float r = sigmoidf_(acc[0][rt][reg] + ba), ig = sigmoidf_(acc[1][rt][reg] + bx);
                        const float a = __builtin_amdgcn_exp2f(-11.541560327111707f * r * sp); const float mult = __builtin_amdgcn_sqrtf(fmaxf((1.0f - a) * (1.0f + a), 0.f));
                        const float xc = bf2f(xcL[tl * XCL_STRIDE + c]);
                        av[j] = a; uv[j] = mult * ig * xc; Ag = a * Ag; Hg = a * Hg + uv[j]; }
                    const f32x2 As = lds_swap(Ag), Hs = lds_swap(Hg);
                    const float mid = As[0] * carry + Hs[0];
                    if constexpr (FINAL) {
                        float s = hh ? mid : carry;
#pragma unroll
                        for (int j = 0; j < 4; ++j) { const int tl = rt * 32 + 8 * g4 + 4 * hh + j; s = av[j] * s + uv[j];
                            const float gv = bf2f(gL[tl * XCL_STRIDE + c]); gL[tl * XCL_STRIDE + c] = (bf16_t)f2bf(s * gelu_tanh(gv)); }
                    }
                    carry = As[1] * mid + Hs[1]; atot = atot * As[0] * As[1];
                }
            }
            if constexpr (!FINAL) { if (hh == 0) SAH[((size_t)b * 512 + c) * 128 + ch] = (f32x2){atot, carry}; }
        }
    }
    __syncthreads();
    if constexpr (FINAL) {
#pragma unroll
        for (int i = 0; i < 8; ++i) { const int tl = tg * 8 + i; const u32x4 v = *(const LAS u32x4*)(gL + tl * XCL_STRIDE + c8 * 8); *(u32x4*)(ycat + (row0 + tl) * D + 512 + c8 * 8) = v; }
        __syncthreads();
    }
}

constexpr int LDS_RI = 0;
constexpr int LDS_HIST = 4096;
DI void ln_router_phase(Frame& F, int layer, const bf16_t* src) {
    bf16_t* xb = (bf16_t*)(F.ws + WS_XB); unsigned char* x8 = F.ws + WS_X8;
    const float* gam = F.in[layer ? 30 : 11]; const float* bet = F.in[layer ? 31 : 12];
    const float* rw = (const float*)(F.ws + WS_SMALL + SM_RWT) + (size_t)layer * 36 * 1024;
    const float* bg = F.in[layer ? 33 : 14]; const float* be = F.in[layer ? 35 : 16];
    unsigned* cnt = (unsigned*)(F.ws + WS_CTL) + CW_CNT + layer * 32;
    unsigned* list = (unsigned*)(F.ws + WS_LIST); float* wslot = (float*)(F.ws + WS_WSLOT); unsigned* posloc = (unsigned*)(F.ws + WS_POSLOC);
    LAS int* e0s = (LAS int*)(F.lds + LDS_RI); LAS int* e1s = e0s + 128; LAS float* w0s = (LAS float*)(e1s + 128); LAS float* w1s = w0s + 128;
    LAS int* hist = (LAS int*)(F.lds + LDS_HIST); LAS int* base = hist + 32;
    const int lane = F.lane;
    f32x4 gv[4], bv[4];
#pragma unroll
    for (int j = 0; j < 4; ++j) { gv[j] = ((const f32x4*)gam)[lane + 64 * j]; bv[j] = ((const f32x4*)bet)[lane + 64 * j]; }
    for (int chunk = F.vcu; chunk < T / 128; chunk += F.G) {
        if (F.tid < 32) hist[F.tid] = 0;
        __syncthreads();
        for (int rr = F.wave; rr < 128; rr += NWAVES) {
            const size_t row = (size_t)chunk * 128 + rr;
            const u32x2* xr = (const u32x2*)(src + row * D) + lane;
            f32x4 v[4]; float s = 0.f;
#pragma unroll
            for (int j = 0; j < 4; ++j) { const u32x2 q = xr[64 * j]; v[j] = (f32x4){bflo(q.x), bfhi(q.x), bflo(q.y), bfhi(q.y)}; s += (v[j].x + v[j].y) + (v[j].z + v[j].w); }
            const float mean = wave_sum(s) * (1.f / D); float s2 = 0.f;
#pragma unroll
            for (int j = 0; j < 4; ++j) { v[j] = v[j] - mean; s2 += (v[j].x * v[j].x + v[j].y * v[j].y) + (v[j].z * v[j].z + v[j].w * v[j].w); }
            const float rstd = 1.f / sqrtf(wave_sum(s2) * (1.f / D) + LN_EPS);
            u32x2* ob = (u32x2*)(xb + row * D) + lane;
#pragma unroll
            for (int j = 0; j < 4; ++j) { v[j] = v[j] * rstd * gv[j] + bv[j]; ob[64 * j] = (u32x2){pk2(v[j].x, v[j].y), pk2(v[j].z, v[j].w)};
                int w8 = 0; w8 = __builtin_amdgcn_cvt_pk_fp8_f32(v[j].x, v[j].y, w8, false); w8 = __builtin_amdgcn_cvt_pk_fp8_f32(v[j].z, v[j].w, w8, true); ((unsigned*)(x8 + row * D))[lane + 64 * j] = (unsigned)w8; }
            float gl[4];
#pragma unroll
            for (int o = 0; o < 4; ++o) { const f32x4* wr_ = (const f32x4*)(rw + o * 1024) + lane; float a = 0.f;
#pragma unroll
                for (int j = 0; j < 4; ++j) { const f32x4 w = wr_[64 * j]; a += (v[j].x * w.x + v[j].y * w.y) + (v[j].z * w.z + v[j].w * w.w); }
                gl[o] = wave_sum(a) + bg[o]; }
            float g0 = gl[0]; int gs = 0;
#pragma unroll
            for (int o = 1; o < 4; ++o) if (gl[o] > g0) { g0 = gl[o]; gs = o; }
            float gsum = 0.f;
#pragma unroll
            for (int o = 0; o < 4; ++o) gsum += __expf(gl[o] - g0);
            const float pgrp = 1.0f / gsum;
            gs = __builtin_amdgcn_readfirstlane(gs);
            float le[8];
#pragma unroll
            for (int hf = 0; hf < 2; ++hf) {
#pragma unroll
                for (int oo = 0; oo < 4; ++oo) { const int o = hf * 4 + oo; const f32x4* wr_ = (const f32x4*)(rw + (4 + gs * 8 + o) * 1024) + lane; float a = 0.f;
#pragma unroll
                    for (int j = 0; j < 4; ++j) { const f32x4 w = wr_[64 * j]; a += (v[j].x * w.x + v[j].y * w.y) + (v[j].z * w.z + v[j].w * w.w); }
                    le[o] = wave_sum(a) + be[gs * 8 + o]; }
                asm volatile("" ::: "memory"); }
            float m0 = le[0]; int i0 = 0;
#pragma unroll
            for (int o = 1; o < 8; ++o) if (le[o] > m0) { m0 = le[o]; i0 = o; }
            float m1 = -3.0e38f; int i1 = 0;
#pragma unroll
            for (int o = 0; o < 8; ++o) if (o != i0 && le[o] > m1) { m1 = le[o]; i1 = o; }
            const float e1 = __expf(m1 - m0); const float w0 = pgrp / (1.0f + e1), w1 = pgrp * e1 / (1.0f + e1);
            if (lane == 0) { e0s[rr] = gs * 8 + i0; e1s[rr] = gs * 8 + i1; w0s[rr] = w0; w1s[rr] = w1; }
        }
        __syncthreads();
        int myrank = 0, mye = 0;
        if (F.tid < 256) { const int rr = F.tid >> 1, k = F.tid & 1; mye = k ? e1s[rr] : e0s[rr]; myrank = atomicAdd((int*)&hist[mye], 1); }
        __syncthreads();
        if (F.tid < 32) { const int h = hist[F.tid]; base[F.tid] = h ? (int)atomicAdd(&cnt[F.tid], (unsigned)h) : 0; }
        __syncthreads();
        if (F.tid < 256) { const int rr = F.tid >> 1, k = F.tid & 1; const unsigned slot = (unsigned)((chunk * 128 + rr) * 2 + k);
            const int li = base[mye] + myrank; list[(size_t)mye * T + li] = slot; wslot[slot] = k ? w1s[rr] : w0s[rr]; posloc[slot] = ((unsigned)mye << 20) | (unsigned)li; }
        __syncthreads();
    }
}

DI MoeTab moe_tables(Frame& F, int layer) {
    LAS int* tb = (LAS int*)(F.lds + LDS_MISC); LAS int* cn = tb + 64; LAS int* nt = cn + 64;
    const unsigned* cnt = (const unsigned*)(F.ws + WS_CTL) + CW_CNT + layer * 32;
    if (F.tid < 32) cn[F.tid] = (int)__hip_atomic_load(cnt + F.tid, __ATOMIC_RELAXED, __HIP_MEMORY_SCOPE_AGENT);
    __syncthreads();
    if (F.tid == 0) { int acc = 0; for (int e = 0; e < 32; ++e) { tb[e] = acc; acc += (cn[e] + 255) >> 8; } tb[32] = acc; nt[0] = acc; }
    __syncthreads();
    MoeTab t; t.tbase = tb; t.cnt = cn; t.ntiles = nt[0]; return t;
}

template <bool FINAL_F32>
DI void ln2_phase(Frame& F, int layer, const MoeTab& tab, bf16_t* dst16, float* dst32) {
    const bf16_t* x1 = (const bf16_t*)(F.ws + WS_XB); const bf16_t* Y = (const bf16_t*)(F.ws + WS_Y);
    const float* wslot = (const float*)(F.ws + WS_WSLOT); const unsigned* posloc = (const unsigned*)(F.ws + WS_POSLOC);
    const float* gam = F.in[layer ? 39 : 20]; const float* bet = F.in[layer ? 40 : 21];
    const int lane = F.lane; const int gw = F.vcu * NWAVES + F.wave, NGW = F.G * NWAVES;
    f32x4 gv[4], bv[4];
#pragma unroll
    for (int j = 0; j < 4; ++j) { gv[j] = ((const f32x4*)gam)[lane + 64 * j]; bv[j] = ((const f32x4*)bet)[lane + 64 * j]; }
#pragma unroll 2
    for (int row = gw; row < T; row += NGW) {
        const unsigned pl0 = posloc[2 * row], pl1 = posloc[2 * row + 1]; const float w0 = wslot[2 * row], w1 = wslot[2 * row + 1];
        const size_t h0 = (size_t)tab.tbase[pl0 >> 20] * 256 + (pl0 & 0xfffffu), h1 = (size_t)tab.tbase[pl1 >> 20] * 256 + (pl1 & 0xfffffu);
        const u32x2* xr = (const u32x2*)(x1 + (size_t)row * D) + lane;
        const u32x2* y0 = (const u32x2*)(Y + h0 * D) + lane; const u32x2* y1 = (const u32x2*)(Y + h1 * D) + lane;
        f32x4 v[4]; float s = 0.f;
#pragma unroll
        for (int j = 0; j < 4; ++j) { const u32x2 a = y0[64 * j], c = y1[64 * j], q = xr[64 * j];
            v[j].x = bflo(q.x) * DN_ALPHA + (w0 * bflo(a.x) + w1 * bflo(c.x)); v[j].y = bfhi(q.x) * DN_ALPHA + (w0 * bfhi(a.x) + w1 * bfhi(c.x));
            v[j].z = bflo(q.y) * DN_ALPHA + (w0 * bflo(a.y) + w1 * bflo(c.y)); v[j].w = bfhi(q.y) * DN_ALPHA + (w0 * bfhi(a.y) + w1 * bfhi(c.y));
            s += (v[j].x + v[j].y) + (v[j].z + v[j].w); }
        const float mean = wave_sum(s) * (1.f / D); float s2 = 0.f;
#pragma unroll
        for (int j = 0; j < 4; ++j) { v[j] = v[j] - mean; s2 += (v[j].x * v[j].x + v[j].y * v[j].y) + (v[j].z * v[j].z + v[j].w * v[j].w); }
        const float rstd = 1.f / sqrtf(wave_sum(s2) * (1.f / D) + LN_EPS);
#pragma unroll
        for (int j = 0; j < 4; ++j) { v[j] = v[j] * rstd * gv[j] + bv[j];
            if (FINAL_F32) ((f32x4*)(dst32 + (size_t)row * D))[lane + 64 * j] = v[j];
            else ((u32x2*)(dst16 + (size_t)row * D))[lane + 64 * j] = (u32x2){pk2(v[j].x, v[j].y), pk2(v[j].z, v[j].w)}; }
    }
}

constexpr float QSCALE = 0.125f * 1.4426950408889634f;
struct GemmL1In {
    static constexpr bool AUNI = true;
    static constexpr bool FP8 = false;
    static constexpr bool PERM = false;
    const char* A; int K; unsigned lda2, ldb2; const char* Bt; pg8::TileOrder ord;
    bf16_t* Q; unsigned char* KV; float* gates; const float* cosT; const float* sinT;
    DI bool next(int i, GU& u) const { return ord.next(i, u); }
    DI unsigned a_row_off(const GU& u, int r) const { return (unsigned)(u.pm * 256 + r) * lda2; }
    DI size_t a_base(const GU& u) const { return (size_t)(u.pm * 256) * lda2; }
    DI const char* b_tile(const GU& u) const { return Bt + (size_t)u.pn * 256 * ldb2; }
    DI void epi(const f32x4 (&acc)[2][2][4][2], const GU& u, int wr, int wc, int fr, int fq) const {
        const int pn = u.pn;
#pragma unroll
        for (int ai = 0; ai < 2; ++ai)
#pragma unroll
            for (int m = 0; m < 4; ++m) {
                const int row = u.pm * 256 + ai * 128 + wr * 64 + m * 16 + fr; const int pos = row & (SEQ - 1), b = row >> 13;
                if (pn == 10) {
                    if (wc < 2) {
#pragma unroll
                        for (int n = 0; n < 2; ++n) { if (n == 1 && wc == 1) continue; const f32x4 v = acc[ai][0][m][n];
                            f32x4 o; o.x = sigmoidf_(v.x); o.y = sigmoidf_(v.y); o.z = sigmoidf_(v.z); o.w = sigmoidf_(v.w);
                            *(f32x4*)(gates + (size_t)row * 48 + 32 * wc + 16 * n + 4 * fq) = o; }
                    }
                } else if (pn < 5 || pn == 6 || pn == 8) {
                    const int a = wc & 1, i0 = 16 * a + 4 * fq;
                    const f32x4 c4 = *(const f32x4*)(cosT + pos * 32 + i0), s4 = *(const f32x4*)(sinT + pos * 32 + i0);
#pragma unroll
                    for (int bj = 0; bj < 2; ++bj) { const f32x4 x1 = acc[ai][bj][m][0], x2 = acc[ai][bj][m][1];
                        f32x4 o1 = x1 * c4 - x2 * s4, o2 = x2 * c4 + x1 * s4;
                        const int hl = bj * 2 + (wc >> 1); bf16_t* dst;
                        if (pn < 4) { o1 = o1 * QSCALE; o2 = o2 * QSCALE; dst = Q + ((size_t)row * 16 + pn * 4 + hl) * 64; }
                        else dst = (bf16_t*)(KV + (size_t)(pn - 4) * KV_STRIDE) + ((size_t)(b * 4 + hl) * SEQ + pos) * 64;
                        *(u32x2*)(dst + i0) = (u32x2){cvt_pk_bf16(o1.x, o1.y), cvt_pk_bf16(o1.z, o1.w)};
                        *(u32x2*)(dst + 32 + i0) = (u32x2){cvt_pk_bf16(o2.x, o2.y), cvt_pk_bf16(o2.z, o2.w)}; }
                } else {
#pragma unroll
                    for (int bj = 0; bj < 2; ++bj) { const int gg = bj * 2 + (wc >> 1);
                        bf16_t* dst = (bf16_t*)(KV + (size_t)(pn - 4) * KV_STRIDE) + ((size_t)(b * 4 + gg) * SEQ + pos) * 64 + 32 * (wc & 1) + 4 * fq;
#pragma unroll
                        for (int n = 0; n < 2; ++n) { const f32x4 v = acc[ai][bj][m][n]; *(u32x2*)(dst + 16 * n) = (u32x2){cvt_pk_bf16(v.x, v.y), cvt_pk_bf16(v.z, v.w)}; } }
                }
            }
    }
};
struct GemmCmp1 {
    static constexpr bool AUNI = true;
    static constexpr bool FP8 = false;
    static constexpr bool PERM = true;
    const char* A; int K; unsigned lda2, ldb2; const char* Bt; int G, c;
    const float* cbias; bf16_t* Hd;
    DI bool next(int i, GU& u) const { const int L = i * G + c; if (L >= 64) return false; u.e = L >> 5; u.pm = L & 31; u.pn = 0; return true; }
    DI unsigned a_row_off(const GU& u, int r) const { return (unsigned)u.e * (unsigned)KV_STRIDE + (unsigned)(u.pm * 256 + r) * lda2; }
    DI size_t a_base(const GU& u) const { return (size_t)u.e * KV_STRIDE + (size_t)(u.pm * 256) * lda2; }
    DI const char* b_tile(const GU& u) const { return Bt + (size_t)u.e * 256 * ldb2; }
    DI void epi(const f32x4 (&acc)[2][2][4][2], const GU& u, int wr, int wc, int fr, int fq) const {
        const int row0 = u.pm * 256 + wr * 64 + fr, col0 = wc * 32 + 8 * fq;
        f32x4 bv[2][2];
#pragma unroll
        for (int bj = 0; bj < 2; ++bj)
#pragma unroll
            for (int n = 0; n < 2; ++n) bv[bj][n] = *(const f32x4*)(cbias + u.e * 256 + col0 + bj * 128 + 4 * n);
#pragma unroll
        for (int ai = 0; ai < 2; ++ai)
#pragma unroll
            for (int m = 0; m < 4; ++m) { bf16_t* rowp = Hd + ((size_t)u.e * 8192 + row0 + ai * 128 + m * 16) * 256 + col0;
#pragma unroll
                for (int bj = 0; bj < 2; ++bj) { const f32x4 v0 = acc[ai][bj][m][0] + bv[bj][0], v1 = acc[ai][bj][m][1] + bv[bj][1];
                    u32x4 w; w.x = cvt_pk_bf16(gelu_tanh(v0[0]), gelu_tanh(v0[1])); w.y = cvt_pk_bf16(gelu_tanh(v0[2]), gelu_tanh(v0[3]));
                    w.z = cvt_pk_bf16(gelu_tanh(v1[0]), gelu_tanh(v1[1])); w.w = cvt_pk_bf16(gelu_tanh(v1[2]), gelu_tanh(v1[3]));
                    *(u32x4*)(rowp + bj * 128) = w; } }
    }
};
struct GemmCmp2 {
    static constexpr bool AUNI = true;
    static constexpr bool FP8 = false;
    static constexpr bool PERM = true;
    const char* A; int K; unsigned lda2, ldb2; const char* Bt; int G, c;
    bf16_t* O;
    DI bool next(int i, GU& u) const { const int L = i * G + c; if (L >= 64) return false; u.e = L >> 5; u.pm = L & 31; u.pn = 0; return true; }
    DI unsigned a_row_off(const GU& u, int r) const { return (unsigned)(u.e * 8192 + u.pm * 256 + r) * lda2; }
    DI size_t a_base(const GU& u) const { return (size_t)(u.e * 8192 + u.pm * 256) * lda2; }
    DI const char* b_tile(const GU& u) const { return Bt + (size_t)u.e * 256 * ldb2; }
    DI void epi(const f32x4 (&acc)[2][2][4][2], const GU& u, int wr, int wc, int fr, int fq) const {
        if (wc >= 2) return;
        const int row0 = u.pm * 256 + wr * 64 + fr, col0 = wc * 32 + 8 * fq;
#pragma unroll
        for (int ai = 0; ai < 2; ++ai)
#pragma unroll
            for (int m = 0; m < 4; ++m) { bf16_t* rowp = O + ((size_t)u.e * 8192 + row0 + ai * 128 + m * 16) * 64 + col0;
                const f32x4 v0 = acc[ai][0][m][0], v1 = acc[ai][0][m][1];
                u32x4 w; w.x = cvt_pk_bf16(v0[0], v0[1]); w.y = cvt_pk_bf16(v0[2], v0[3]); w.z = cvt_pk_bf16(v1[0], v1[1]); w.w = cvt_pk_bf16(v1[2], v1[3]);
                *(u32x4*)rowp = w; }
    }
};

constexpr int AL_KB = 0, AL_VB = 16384, AL_FAC = 40960, AL_SELM = 41984, AL_IMPS = 43008, IMP_STRIDE = 129, AL_IMPC = AL_IMPS + 64 * IMP_STRIDE * 4, AL_OT = AL_IMPS  , OT_STRIDE = 68;
static_assert(AL_OT + 8 * 32 * OT_STRIDE * 4 <= LDS_RING, "attention LDS map");
typedef short v4i16_t __attribute__((ext_vector_type(4)));
typedef __bf16 bf16x2_t __attribute__((ext_vector_type(2)));
DI unsigned cvtpk_s(float lo, float hi) { f32x2 v = {lo, hi}; bf16x2_t b = __builtin_convertvector(v, bf16x2_t); return __builtin_bit_cast(unsigned, b); }
DI int crow(int r, int hi) { return (r & 3) + 8 * (r >> 2) + 4 * hi; }
#define NEGINF (-__builtin_inff())

struct AttnW {
    int tid, lane, wave, r32, hh;
    LAS unsigned char* lds; LAS float* fac; LAS float* ot;
};
DI void at_load(const bf16_t* slab, int tile, int tid, u32x4& r) { r = *(const u32x4*)(slab + (size_t)tile * 4096 + tid * 8); }
DI void at_store_k(LAS unsigned char* kb, int tid, const u32x4& r) { const int key = tid >> 3, ch = tid & 7; *(LAS u32x4*)(kb + key * 128 + ((ch ^ ((key >> 1) & 7)) << 4)) = r; }
DI void at_store_v(LAS unsigned char* vb, int tid, const u32x4& r) { *(LAS u32x4*)(vb + tid * 16) = r; }
DI void at_qk(const LAS unsigned char* kb, const bf16x8 (&qf)[4], float cinit, int r32, int hh, f32x16& p0, f32x16& p1) {
#pragma unroll
    for (int i = 0; i < 16; ++i) { p0[i] = cinit; p1[i] = cinit; }
    const int sw = (r32 >> 1) & 7;
#pragma unroll
    for (int d0 = 0; d0 < 4; ++d0) {
        const bf16x8 a0 = *(const LAS bf16x8*)(kb + r32 * 128 + (((2 * d0 + hh) ^ sw) << 4));
        const bf16x8 a1 = *(const LAS bf16x8*)(kb + (32 + r32) * 128 + (((2 * d0 + hh) ^ sw) << 4));
        p0 = __builtin_amdgcn_mfma_f32_32x32x16_bf16(a0, qf[d0], p0, 0, 0, 0);
        p1 = __builtin_amdgcn_mfma_f32_32x32x16_bf16(a1, qf[d0], p1, 0, 0, 0);
    }
}
DI void at_pack(const f32x16& p0, const f32x16& p1, u32x4 (&pw)[4]) {
#pragma unroll
    for (int s = 0; s < 2; ++s) {
        pw[s] = (u32x4){cvtpk_s(p0[8 * s], p0[8 * s + 1]), cvtpk_s(p0[8 * s + 2], p0[8 * s + 3]), cvtpk_s(p0[8 * s + 4], p0[8 * s + 5]), cvtpk_s(p0[8 * s + 6], p0[8 * s + 7])};
        pw[2 + s] = (u32x4){cvtpk_s(p1[8 * s], p1[8 * s + 1]), cvtpk_s(p1[8 * s + 2], p1[8 * s + 3]), cvtpk_s(p1[8 * s + 4], p1[8 * s + 5]), cvtpk_s(p1[8 * s + 6], p1[8 * s + 7])};
    }
}
DI void at_pv(const LAS unsigned char* vb, const u32x4 (&pw)[4], f32x16 (&o)[2], int lane) {
    const int hh = lane >> 5;
    const LAS unsigned char* vp = vb + (4 * hh + ((lane & 15) >> 2)) * 128 + (16 * ((lane >> 4) & 1) + 4 * (lane & 3)) * 2;
#pragma unroll
    for (int s = 0; s < 4; ++s)
#pragma unroll
        for (int d0 = 0; d0 < 2; ++d0) {
            const s16x4 lo = __builtin_bit_cast(s16x4, __builtin_amdgcn_ds_read_tr16_b64_v4i16((LAS v4i16_t*)(vp + s * 2048 + d0 * 64)));
            const s16x4 hi = __builtin_bit_cast(s16x4, __builtin_amdgcn_ds_read_tr16_b64_v4i16((LAS v4i16_t*)(vp + s * 2048 + d0 * 64 + 1024)));
            const bf16x8 vf = (bf16x8){lo[0], lo[1], lo[2], lo[3], hi[0], hi[1], hi[2], hi[3]};
            o[d0] = __builtin_amdgcn_mfma_f32_32x32x16_bf16(__builtin_bit_cast(bf16x8, pw[s]), vf, o[d0], 0, 0, 0);
        }
}
DI float at_rowmax(const f32x16& p0, const f32x16& p1) {
    float a = fmaxf(fmaxf(p0[0], p1[0]), p0[1]), c = fmaxf(fmaxf(p1[1], p0[2]), p1[2]);
#pragma unroll
    for (int r = 3; r < 15; r += 2) { a = fmaxf(fmaxf(a, p0[r]), p1[r]); c = fmaxf(fmaxf(c, p0[r + 1]), p1[r + 1]); }
    a = fmaxf(fmaxf(a, p0[15]), p1[15]); a = fmaxf(a, c);
    const f32x2 s = lds_swap(a); return fmaxf(s[0], s[1]);
}
DI void at_scale_rows(f32x16 (&o)[2], float f, const AttnW& W) {
    if (W.hh == 0) W.fac[W.r32] = f;
#pragma unroll
    for (int g4 = 0; g4 < 4; ++g4) { const f32x4 fv = *(const LAS f32x4*)(W.fac + 8 * g4 + 4 * W.hh);
#pragma unroll
        for (int j = 0; j < 4; ++j) { o[0][4 * g4 + j] *= fv[j]; o[1][4 * g4 + j] *= fv[j]; } }
}
template <bool FIRST> DI void at_axpy_rows(const f32x16 (&o)[2], float f, const AttnW& W) {
    if (W.hh == 0) W.fac[W.r32] = f;
#pragma unroll
    for (int g4 = 0; g4 < 4; ++g4) { const f32x4 fv = *(const LAS f32x4*)(W.fac + 8 * g4 + 4 * W.hh);
#pragma unroll
        for (int j = 0; j < 4; ++j) { LAS float* d = W.ot + (8 * g4 + 4 * W.hh + j) * OT_STRIDE + W.r32;
            if (FIRST) { d[0] = fv[j] * o[0][4 * g4 + j]; d[32] = fv[j] * o[1][4 * g4 + j]; }
            else { d[0] += fv[j] * o[0][4 * g4 + j]; d[32] += fv[j] * o[1][4 * g4 + j]; } } }
}
template <bool GT> DI void at_mask(f32x16& p0, f32x16& p1, int lim, int hh) {
#pragma unroll
    for (int r = 0; r < 16; ++r) { const int kv = crow(r, hh);
        if (GT) { if (kv > lim) p0[r] = NEGINF; if (kv + 32 > lim) p1[r] = NEGINF; }
        else { if (kv <= lim) p0[r] = NEGINF; if (kv + 32 <= lim) p1[r] = NEGINF; } }
}
constexpr float AT_THR = 8.0f;
struct Flash { float mu, l; bool started; f32x16 o[2]; };
DI void flash_init(Flash& s) { s.mu = 0.f; s.l = 0.f; s.started = false;
#pragma unroll
    for (int i = 0; i < 16; ++i) { s.o[0][i] = 0.f; s.o[1][i] = 0.f; } }
template <bool WITH_O> DI void flash_update(Flash& s, f32x16& p0, f32x16& p1, const AttnW& W) {
    const float mx = at_rowmax(p0, p1);
    const bool fin = mx > NEGINF;
    const bool need = s.started ? (mx > AT_THR) : (fin && fabsf(mx) > AT_THR);
    if (__any(need)) {
        const float delta = need ? mx : 0.f;
        const float f = s.started ? __builtin_amdgcn_exp2f(-delta) : 1.0f;
        s.mu += delta; s.l *= f;
        if (WITH_O) at_scale_rows(s.o, f, W);
#pragma unroll
        for (int r = 0; r < 16; ++r) { p0[r] -= delta; p1[r] -= delta; }
    }
    s.started = s.started || fin;
    float sum0 = 0.f, sum1 = 0.f;
#pragma unroll
    for (int r = 0; r < 16; ++r) { p0[r] = __builtin_amdgcn_exp2f(p0[r]); p1[r] = __builtin_amdgcn_exp2f(p1[r]); sum0 += p0[r]; sum1 += p1[r]; }
    s.l += sum0 + sum1;
}

template <int VAR>
DI void attn_unit(Frame& F, int bg, int qblk, int& it, bf16_t* Ob, u32x4& kr, const bf16_t* next_kcmp) {
    AttnW W; W.tid = F.tid; W.lane = F.lane; W.wave = F.wave; W.r32 = F.lane & 31; W.hh = F.lane >> 5; W.lds = F.lds; W.fac = (LAS float*)(F.lds + AL_FAC) + F.wave * 32; W.ot = (LAS float*)(F.lds + AL_OT) + F.wave * 32 * OT_STRIDE;
    const int tid = W.tid, lane = W.lane, wave = W.wave, r32 = W.r32, hh = W.hh;
    const int b = bg >> 2, g = bg & 3;
    unsigned char* ws = F.ws;
    bf16_t* Qb = (bf16_t*)(ws + WS_Q);
    const float* gates = (const float*)(ws + WS_GATES);
    const bf16_t* kcmp = (const bf16_t*)(ws + WS_CMPO) + (size_t)bg * 512 * 64; const bf16_t* vcmp = kcmp + (size_t)8192 * 64;
    const bf16_t* ksl = (const bf16_t*)(ws + WS_KV + 2 * KV_STRIDE) + (size_t)bg * SEQ * 64; const bf16_t* vsl = (const bf16_t*)(ws + WS_KV + 3 * KV_STRIDE) + (size_t)bg * SEQ * 64;
    const bf16_t* kwl = (const bf16_t*)(ws + WS_KV + 4 * KV_STRIDE) + (size_t)bg * SEQ * 64; const bf16_t* vwl = (const bf16_t*)(ws + WS_KV + 5 * KV_STRIDE) + (size_t)bg * SEQ * 64;
    LAS unsigned char* KB = F.lds + AL_KB; LAS unsigned char* VB = F.lds + AL_VB;
    LAS unsigned* selm = (LAS unsigned*)(F.lds + AL_SELM); LAS float* impS = (LAS float*)(F.lds + AL_IMPS); LAS float* impC = (LAS float*)(F.lds + AL_IMPC);
    const int tl = wave * 8 + (r32 >> 2), hd = r32 & 3, t = qblk * 64 + tl;
    const size_t qrow = ((size_t)(b * SEQ + t) * 16 + g * 4 + hd) * 64;
    bf16x8 qf[4];
#pragma unroll
    for (int d0 = 0; d0 < 4; ++d0) qf[d0] = *(const bf16x8*)(Qb + qrow + d0 * 16 + hh * 8);
    const float* gp = gates + (size_t)(b * SEQ + t) * 48 + (g * 4 + hd) * 3;
    const bool need_topk = (qblk >= 16) && !(VAR & 128);
    f32x16 p0, p1; u32x4 vr, pw[4];
    const bool rotB = wave >= 4;
    int vs = 0;
#define V_NEXT() do { vs = (vs == 2) ? 0 : vs + 1; } while (0)

    const int nct = (4 * qblk + 2) / 64 + 1;
    const int cmax = (t - 31) >> 4;
    Flash fc; flash_init(fc);
    const int cfull = 4 * qblk - 2;
    for (int ti = 0; ti < nct; ++ti, ++it) {
        LAS unsigned char* kb = KB + (it & 1) * 8192;
        at_store_k(kb, tid, kr); if (!(VAR & 2)) __syncthreads();
        if (ti + 1 < nct) at_load(kcmp, ti + 1, tid, kr); else { at_load(kcmp, 0, tid, kr); at_load(vcmp, 0, tid, vr); }
        at_qk(kb, qf, -fc.mu, r32, hh, p0, p1);
        if (64 * ti + 63 > cfull) at_mask<true>(p0, p1, cmax - 64 * ti, hh);
        flash_update<false>(fc, p0, p1, W);
    }
    { const f32x2 ls = lds_swap(fc.l); fc.l = ls[0] + ls[1]; }
    const float inv_lc = 1.0f / fmaxf(fc.l, 1e-30f);
    if (need_topk) { for (int i = tid; i < 64 * IMP_STRIDE; i += NTHR) { impS[i] = 0.f; impC[i] = 0.f; } }
    for (int ti = 0; ti < nct; ++ti, ++it) {
        LAS unsigned char* kb = KB + (it & 1) * 8192; LAS unsigned char* vb = VB + vs * 8192; V_NEXT();
        at_store_k(kb, tid, kr); at_store_v(vb, tid, vr); if (!(VAR & 2)) __syncthreads();
        if (ti + 1 < nct) { at_load(kcmp, ti + 1, tid, kr); at_load(vcmp, ti + 1, tid, vr); } else { at_load(ksl, 0, tid, kr); at_load(vsl, 0, tid, vr); }
        at_qk(kb, qf, -fc.mu, r32, hh, p0, p1);
        if (64 * ti + 63 > cfull) at_mask<true>(p0, p1, cmax - 64 * ti, hh);
#pragma unroll
        for (int r = 0; r < 16; ++r) { p0[r] = __builtin_amdgcn_exp2f(p0[r]); p1[r] = __builtin_amdgcn_exp2f(p1[r]); }
        at_pack(p0, p1, pw);
        at_pv(vb, pw, fc.o, lane);
        if (need_topk) {
#pragma unroll
            for (int half = 0; half < 2; ++half)
#pragma unroll
                for (int g4 = 0; g4 < 4; ++g4) {
                    const f32x16& p = half ? p1 : p0;
                    float s4 = ((p[4 * g4] + p[4 * g4 + 1]) + (p[4 * g4 + 2] + p[4 * g4 + 3])) * inv_lc, c3 = p[4 * g4 + 3] * inv_lc;
                    s4 += quad_xor<0xB1>(s4); c3 += quad_xor<0xB1>(c3); s4 += quad_xor<0x4E>(s4); c3 += quad_xor<0x4E>(c3);
                    const int j = 16 * ti + 8 * half + 2 * g4 + hh;
                    if (hd == 0) { impS[tl * IMP_STRIDE + j] = s4; impC[tl * IMP_STRIDE + j] = c3; }
                }
        }
    }
    __syncthreads();
    if (need_topk) {
        #pragma unroll 1
        for (int rnd = 0; rnd < 2; ++rnd) {
        unsigned k0[4], k1[4], prefix[4];
#pragma unroll
        for (int tt = 0; tt < 4; ++tt) {
            const int tk = wave * 8 + rnd * 4 + tt; const LAS float* S = impS + tk * IMP_STRIDE; const LAS float* C = impC + tk * IMP_STRIDE;
            const int j0 = lane, j1 = 64 + lane;
            const float v0 = S[j0] + (j0 > 0 ? C[j0 - 1] : 0.f), v1 = S[j1] + C[j1 - 1];
            const bool c0 = (j0 >= 1) && (j0 <= qblk - 2), c1 = (j1 <= qblk - 2);
            k0[tt] = c0 ? ((__float_as_uint(v0) + 0x100u) & 0xffffff00u) : 0u; k1[tt] = c1 ? ((__float_as_uint(v1) + 0x100u) & 0xffffff00u) : 0u; prefix[tt] = 0u;
        }
#pragma unroll 1
        for (int bit = 30; bit >= 8; --bit) {
            unsigned long long bl0[4], bl1[4];
#pragma unroll
            for (int tt = 0; tt < 4; ++tt) { const unsigned trial = prefix[tt] | (1u << bit); bl0[tt] = __ballot(k0[tt] >= trial); bl1[tt] = __ballot(k1[tt] >= trial); }
#pragma unroll
            for (int tt = 0; tt < 4; ++tt) { asm volatile("" : "+s"(bl0[tt]), "+s"(bl1[tt])); }
#pragma unroll
            for (int tt = 0; tt < 4; ++tt) { const int cnt = __popcll(bl0[tt]) + __popcll(bl1[tt]); prefix[tt] = cnt >= 13 ? (prefix[tt] | (1u << bit)) : prefix[tt]; }
        }
#pragma unroll
        for (int tt = 0; tt < 4; ++tt) {
            const int tk = wave * 8 + rnd * 4 + tt; const int j0 = lane, j1 = 64 + lane; const unsigned pf = prefix[tt];
            const int G = __popcll(__ballot(k0[tt] > pf)) + __popcll(__ballot(k1[tt] > pf)); const int need = 13 - G;
            const unsigned long long e0 = __ballot(k0[tt] == pf), e1 = __ballot(k1[tt] == pf);
            const unsigned long long lt = (1ull << lane) - 1ull;
            const int rk0 = __popcll(e0 & lt), rk1 = __popcll(e0) + __popcll(e1 & lt);
            const bool s0 = (k0[tt] > pf) || (k0[tt] == pf && rk0 < need) || j0 == 0 || j0 == qblk || j0 == qblk - 1;
            const bool s1 = (k1[tt] > pf) || (k1[tt] == pf && rk1 < need) || j1 == qblk || j1 == qblk - 1;
            const unsigned long long m0 = __ballot(s0), m1 = __ballot(s1);
            if (lane == 0) { selm[tk * 4 + 0] = (unsigned)m0; selm[tk * 4 + 1] = (unsigned)(m0 >> 32); selm[tk * 4 + 2] = (unsigned)m1; selm[tk * 4 + 3] = (unsigned)(m1 >> 32); }
        }
        }
    } else {
        if (tid < 256) selm[tid] = 0xffffffffu;
    }
    __syncthreads();
    at_axpy_rows<true>(fc.o, gp[0] * inv_lc, W);

    {
        Flash fs; flash_init(fs);
        const int tbw = qblk >= 8 ? qblk - 8 : 0;
        const LAS unsigned char* vprev = VB; bool first = true;
#define SEL_HEAD() \
            LAS unsigned char* kb = KB + (it & 1) * 8192; LAS unsigned char* vb = VB + vs * 8192; V_NEXT(); \
            at_store_k(kb, tid, kr); at_store_v(vb, tid, vr); if (!(VAR & 2)) __syncthreads(); \
            if (ti < qblk) { if (!(VAR & 1)) { at_load(ksl, ti + 1, tid, kr); at_load(vsl, ti + 1, tid, vr); } } else { at_load(kwl, tbw, tid, kr); at_load(vwl, tbw, tid, vr); } \
            const unsigned wsel = selm[tl * 4 + (ti >> 5)]; \
            const bool selb = ((wsel >> (ti & 31)) & 1u) != 0u;
        if (!rotB) {
            for (int ti = (VAR & 32) ? qblk : 0; ti <= qblk; ++ti, ++it) {
                SEL_HEAD()
                at_qk(kb, qf, selb ? -fs.mu : NEGINF, r32, hh, p0, p1);
                if (ti == qblk) at_mask<true>(p0, p1, tl, hh);
                flash_update<true>(fs, p0, p1, W); at_pack(p0, p1, pw);
                at_pv(vb, pw, fs.o, lane);
            }
        } else {
            for (int ti = (VAR & 32) ? qblk : 0; ti <= qblk; ++ti, ++it) {
                SEL_HEAD()
                if (!first) at_pv(vprev, pw, fs.o, lane);
                at_qk(kb, qf, selb ? -fs.mu : NEGINF, r32, hh, p0, p1);
                if (ti == qblk) at_mask<true>(p0, p1, tl, hh);
                flash_update<true>(fs, p0, p1, W); at_pack(p0, p1, pw);
                vprev = vb; first = false;
            }
            at_pv(vprev, pw, fs.o, lane);
        }
#undef SEL_HEAD
        const f32x2 ls = lds_swap(fs.l); const float l = ls[0] + ls[1];
        at_axpy_rows<false>(fs.o, gp[1] / fmaxf(l, 1e-30f), W);
    }
    {
        Flash fw; flash_init(fw);
        const int tb = qblk >= 8 ? qblk - 8 : 0;
        const LAS unsigned char* vprev = VB; bool first = true;
#define WIN_HEAD() \
            LAS unsigned char* kb = KB + (it & 1) * 8192; LAS unsigned char* vb = VB + vs * 8192; V_NEXT(); \
            at_store_k(kb, tid, kr); at_store_v(vb, tid, vr); if (!(VAR & 2)) __syncthreads(); \
            if (ti < qblk) { if (!(VAR & 1)) { at_load(kwl, ti + 1, tid, kr); at_load(vwl, ti + 1, tid, vr); } } else if (next_kcmp) at_load(next_kcmp, 0, tid, kr);
        if (!rotB) {
            for (int ti = (VAR & 64) ? qblk : tb; ti <= qblk; ++ti, ++it) {
                WIN_HEAD()
                at_qk(kb, qf, -fw.mu, r32, hh, p0, p1);
                if (ti == qblk - 8) at_mask<false>(p0, p1, tl, hh);
                if (ti == qblk) at_mask<true>(p0, p1, tl, hh);
                flash_update<true>(fw, p0, p1, W); at_pack(p0, p1, pw);
                at_pv(vb, pw, fw.o, lane);
            }
        } else {
            for (int ti = (VAR & 64) ? qblk : tb; ti <= qblk; ++ti, ++it) {
                WIN_HEAD()
                if (!first) at_pv(vprev, pw, fw.o, lane);
                at_qk(kb, qf, -fw.mu, r32, hh, p0, p1);
                if (ti == qblk - 8) at_mask<false>(p0, p1, tl, hh);
                if (ti == qblk) at_mask<true>(p0, p1, tl, hh);
                flash_update<true>(fw, p0, p1, W); at_pack(p0, p1, pw);
                vprev = vb; first = false;
            }
            at_pv(vprev, pw, fw.o, lane);
        }
#undef WIN_HEAD
        const f32x2 ls = lds_swap(fw.l); const float l = ls[0] + ls[1];
        at_axpy_rows<false>(fw.o, gp[2] / fmaxf(l, 1e-30f), W);
    }
#undef V_NEXT
    { const int q = lane >> 1, hf = lane & 1; const LAS float* src = W.ot + q * OT_STRIDE + hf * 32; const int tq = qblk * 64 + wave * 8 + (q >> 2);
      bf16_t* dst = Ob + ((size_t)(b * SEQ + tq) * 16 + g * 4 + (q & 3)) * 64 + hf * 32;
#pragma unroll
      for (int c = 0; c < 4; ++c) { const f32x4 a = *(const LAS f32x4*)(src + 8 * c), d = *(const LAS f32x4*)(src + 8 * c + 4);
          *(u32x4*)(dst + 8 * c) = (u32x4){pk2(a.x, a.y), pk2(a.z, a.w), pk2(d.x, d.y), pk2(d.z, d.w)}; } }
    __syncthreads();
}
template <int VAR>
DI void attn_phase(Frame& F, bf16_t* Ob) {
    int it = 0;
    const bf16_t* kcmp_all = (const bf16_t*)(F.ws + WS_CMPO);
    const bool bal = (F.G == 256);
    const int bg0 = F.vcu >> 4, sft = F.vcu & 15;
    const int nun = bal ? 8 : (2048 - F.vcu + F.G - 1) / F.G;
    auto unit_of = [&](int i, int& bg, int& qblk) {
        if (bal) { const int base = (i >> 1) * 32; bg = bg0; qblk = 127 - ((i & 1) ? base + 31 - sft : base + sft); }
        else { const int u = F.vcu + i * F.G; bg = u >> 7; qblk = 127 - (u & 127); } };
    u32x4 kr;
    if (nun > 0) { int bg, qb; unit_of(0, bg, qb); at_load(kcmp_all + (size_t)bg * 512 * 64, 0, F.tid, kr); }
#pragma unroll 1
    for (int i = 0; i < nun; ++i) {
        int bg, qb, nbg = 0, nqb = 0; unit_of(i, bg, qb);
        const bf16_t* nk = nullptr; if (i + 1 < nun) { unit_of(i + 1, nbg, nqb); nk = kcmp_all + (size_t)nbg * 512 * 64; }
        attn_unit<VAR>(F, bg, qb, it, Ob, kr, nk);
    }
}

constexpr int NPHASE = 18;
__global__ void __launch_bounds__(NTHR, 2) fwd_kernel(Args args) {
    extern __shared__ __attribute__((aligned(16))) unsigned char lds_raw[];
    cg::grid_group grid = cg::this_grid();
    Frame F;
    F.lds = (LAS unsigned char*)lds_raw;
    F.tid = threadIdx.x; F.lane = F.tid & 63; F.wave = __builtin_amdgcn_readfirstlane(F.tid >> 6);
    F.G = gridDim.x; { const int bx = blockIdx.x; F.vcu = (F.G % 8 == 0) ? (bx % 8) * (F.G / 8) + bx / 8 : bx; }
    F.in = args.in; F.out = args.out; F.ws = args.ws;
    unsigned char* ws = args.ws;
    const int lo = args.ph_lo, hi = args.ph_hi;
    volatile LAS unsigned* bar_st = (volatile LAS unsigned*)(F.lds + LDS_BYTES - 64);
    if (F.tid < 16) bar_st[F.tid] = 0u;
    __syncthreads();
    XcdBarrier xbar; xbar.bar = (unsigned*)(ws + WS_CTL) + CW_BAR; xbar.x = 0; xbar.st = bar_st;
#ifndef PHMASK
#define PHMASK 0xFFFFFFFFu
#endif
#define IN(k) (((PHMASK >> (k)) & 1u) && lo <= (k) && (k) < hi)
#ifdef TPH_LO
    unsigned long long tp0 = __builtin_amdgcn_s_memrealtime(), tp1 = tp0;
#define STAMP(k) do { if ((k) == TPH_LO - 1) tp0 = __builtin_amdgcn_s_memrealtime(); if ((k) == TPH_HI) tp1 = __builtin_amdgcn_s_memrealtime(); } while (0)
#else
#define STAMP(k) do { } while (0)
#endif
#define SEAM(k) do { if (IN(k) && IN((k) + 1)) { if ((k) == 0) { grid.sync(); xbar = xcd_barrier_post((unsigned*)(ws + WS_CTL) + CW_BAR, bar_st); } else xcd_barrier(xbar); } STAMP(k); } while (0)

    if (IN(0)) { p0_prep(F); } SEAM(0);
    if (IN(1)) { GemmPlain g; g.A = (const char*)(ws + WS_XB); g.K = 1024; g.lda2 = 2048; g.ldb2 = 2048; g.Bt = (const char*)(ws + WS_W0IN); g.ord.init(T, L0N, F.G, (int)blockIdx.x);
        g.C = (bf16_t*)(ws + WS_Z); g.ldc = L0N; pg8::gemm_phase(F.lds, g); } SEAM(1);
#ifdef XSYNC_N
    for (int xs = 0; xs < XSYNC_N; ++xs) grid.sync();
#endif
#ifdef XGEMM_K
    { grid.sync(); const unsigned long long xt0 = __builtin_amdgcn_s_memrealtime();
      GemmPlain g; g.A = (const char*)(ws + WS_XB); g.K = XGEMM_K; g.lda2 = 2048; g.ldb2 = 2048; g.Bt = (const char*)(ws + WS_W0IN); g.ord.init(T, XGEMM_N, F.G, (int)blockIdx.x);
      g.C = (bf16_t*)F.out; g.ldc = XGEMM_N; pg8::gemm_phase(F.lds, g); grid.sync(); (void)xt0; }
#endif
    if (IN(2)) { for (int u = F.vcu; u < 512; u += F.G) lru_tile<false>(F, u >> 7, u & 127); } SEAM(2);
    if (IN(3)) { for (int u = F.vcu; u < 512; u += F.G) lru_tile<true>(F, u >> 7, u & 127); } SEAM(3);
    bf16_t* const OA = (bf16_t*)F.out; bf16_t* const OB = OA + (size_t)T * D;
    if (IN(4)) { GemmResid<true> g; g.A = (const char*)(ws + WS_XB); g.K = 1024; g.lda2 = 2048; g.ldb2 = 2048; g.Bt = (const char*)(ws + WS_W0OUT); g.ord.init(T, D, F.G, (int)blockIdx.x);
        g.res32 = F.in[0]; g.res16 = nullptr; g.out = OA; pg8::gemm_phase(F.lds, g); } SEAM(4);
#define MOE_LAYER(layer, pb, SRC, FIN, DST16) do { \
        if (IN(pb)) { ln_router_phase(F, layer, SRC); } SEAM(pb); \
        if (IN((pb) + 1)) { MoeTab tab = moe_tables(F, layer); \
            GemmMoeUp g; g.A = (const char*)(ws + WS_X8); g.K = 512; g.lda2 = 1024; g.ldb2 = 1024; g.Bt = (const char*)(ws + ((layer) ? WS_WGU1 : WS_WGU0)); g.G = F.G; g.c = (int)blockIdx.x; \
            g.tab = tab; g.list = (const unsigned*)(ws + WS_LIST); g.H = (bf16_t*)(ws + WS_H); pg8::gemm_phase(F.lds, g); } SEAM((pb) + 1); \
        if (IN((pb) + 2)) { MoeTab tab = moe_tables(F, layer); \
            GemmMoeDown g; g.A = (const char*)(ws + WS_H); g.K = 256; g.lda2 = 512; g.ldb2 = 512; g.Bt = (const char*)(ws + ((layer) ? WS_WD1 : WS_WD0)); g.G = F.G; g.c = (int)blockIdx.x; \
            g.tab = tab; g.Y = (bf16_t*)(ws + WS_Y); pg8::gemm_phase(F.lds, g); } SEAM((pb) + 2); \
        if (IN((pb) + 3)) { MoeTab tab = moe_tables(F, layer); ln2_phase<FIN>(F, layer, tab, DST16, F.out); } } while (0)
    MOE_LAYER(0, 5, OA, false, OA); SEAM(8);
    if (IN(9)) { GemmL1In g; g.A = (const char*)OA; g.K = 1024; g.lda2 = 2048; g.ldb2 = 2048; g.Bt = (const char*)(ws + WS_W1IN); g.ord.init(T, L1NP, F.G, (int)blockIdx.x);
        g.Q = (bf16_t*)(ws + WS_Q); g.KV = ws + WS_KV; g.gates = (float*)(ws + WS_GATES); g.cosT = (const float*)(ws + WS_COS); g.sinT = (const float*)(ws + WS_SIN); pg8::gemm_phase(F.lds, g); } SEAM(9);
    if (IN(10)) { GemmCmp1 g; g.A = (const char*)(ws + WS_KV); g.K = 2048; g.lda2 = 2048; g.ldb2 = 4096; g.Bt = (const char*)(ws + WS_WC1); g.G = F.G; g.c = (int)blockIdx.x;
        g.cbias = (const float*)(ws + WS_SMALL + SM_CBIAS); g.Hd = (bf16_t*)(ws + WS_CMPH); pg8::gemm_phase(F.lds, g); p0_moe1(F, F.G >= 128 ? 64 : 0); } SEAM(10);
    if (IN(11)) { GemmCmp2 g; g.A = (const char*)(ws + WS_CMPH); g.K = 256; g.lda2 = 512; g.ldb2 = 512; g.Bt = (const char*)(ws + WS_WC2); g.G = F.G; g.c = (int)blockIdx.x;
        g.O = (bf16_t*)(ws + WS_CMPO); pg8::gemm_phase(F.lds, g); } SEAM(11);
#ifdef XATT_VAR
    { xcd_barrier(xbar); attn_phase<XATT_VAR>(F, (bf16_t*)(ws + WS_XB)); xcd_barrier(xbar); }
#endif
    if (IN(12)) { attn_phase<0>(F, (bf16_t*)(ws + WS_Q)); } SEAM(12);
    if (IN(13)) { GemmResid<false> g; g.A = (const char*)(ws + WS_Q); g.K = 1024; g.lda2 = 2048; g.ldb2 = 2048; g.Bt = (const char*)(ws + WS_W1OUT); g.ord.init(T, D, F.G, (int)blockIdx.x);
        g.res32 = nullptr; g.res16 = OA; g.out = OB; pg8::gemm_phase(F.lds, g); } SEAM(13);
    MOE_LAYER(1, 14, OB, true, nullptr);
#undef MOE_LAYER
#ifdef TPH_LO
    grid.sync(); STAMP(17);
    if (blockIdx.x == 0 && threadIdx.x == 0) { const unsigned long long span = (tp1 - tp0) * TPH_MUL, ts = __builtin_amdgcn_s_memrealtime(); while (__builtin_amdgcn_s_memrealtime() - ts < span) __builtin_amdgcn_s_sleep(32); }
#endif
#undef IN
#undef SEAM
}

extern "C" void kernel_launch(void* const* d_in, const int* in_sizes, int n_in, void* d_out, int out_size, void* d_ws, size_t ws_size, hipStream_t stream) {
    static int grid = 0;
    if (grid == 0) {
        if (n_in != 41 || out_size != T * D || ws_size < WS_END) { fprintf(stderr, "kernel_launch: unexpected problem (n_in %d out %d ws %zu, need %zu)\n", n_in, out_size, ws_size, (size_t)WS_END); grid = -1; return; }
        int dev = 0, cus = 0, per_cu = 0;
        hipGetDevice(&dev); hipDeviceGetAttribute(&cus, hipDeviceAttributeMultiprocessorCount, dev);
        hipFuncSetAttribute((const void*)fwd_kernel, hipFuncAttributeMaxDynamicSharedMemorySize, LDS_BYTES);
        hipOccupancyMaxActiveBlocksPerMultiprocessor(&per_cu, (const void*)fwd_kernel, NTHR, LDS_BYTES);
        if (per_cu < 1) { fprintf(stderr, "kernel_launch: occupancy query says %d blocks/CU\n", per_cu); per_cu = 1; }
        grid = cus * per_cu; if (grid > cus) grid = cus;
        (void)hipGetLastError();
    }
    if (grid < 0) return;
    Args a{};
    for (int i = 0; i < 41; ++i) a.in[i] = (const float*)d_in[i];
    a.out = (float*)d_out; a.ws = (unsigned char*)d_ws; a.ph_lo = 0; a.ph_hi = NPHASE;
    void* kargs[] = {&a};
    hipError_t e = hipLaunchCooperativeKernel((const void*)fwd_kernel, dim3(grid), dim3(NTHR), kargs, LDS_BYTES, stream);
    if (e != hipSuccess) fprintf(stderr, "cooperative launch failed: %s (grid %d)\n", hipGetErrorString(e), grid);
}
```

```cpp
#include <hip/hip_runtime.h>
#include <hip/hip_cooperative_groups.h>
#include <cstdio>
#include <cstdint>
#include <cmath>
namespace cg = cooperative_groups;

#define LAS __attribute__((address_space(3)))
#define DI __device__ __forceinline__
typedef unsigned short bf16_t;
typedef short bf16x8 __attribute__((ext_vector_type(8)));
typedef short s16x4 __attribute__((ext_vector_type(4)));
typedef float f32x2 __attribute__((ext_vector_type(2)));
typedef float f32x4 __attribute__((ext_vector_type(4)));
typedef float f32x16 __attribute__((ext_vector_type(16)));
typedef unsigned u32x2 __attribute__((ext_vector_type(2)));
typedef unsigned u32x4 __attribute__((ext_vector_type(4)));

constexpr int NB = 4, SEQ = 8192, T = NB * SEQ, D = 1024;
constexpr int L0N = 2560;
constexpr int L1N = 2608, L1NP = 2816;
constexpr int NEXP = 32, FF = 512;
constexpr float DN_ALPHA = 1.4142135623730951f;
constexpr float LN_EPS = 1e-5f;
constexpr int NWAVES = 8, NTHR = 512;
constexpr int NCMP = 512;

constexpr size_t MiB = 1u << 20;
constexpr size_t WS_CTL = 0;
constexpr size_t WS_COS = 1 * MiB, WS_SIN = 2 * MiB;
constexpr size_t WS_SMALL = 3 * MiB;
constexpr size_t SM_LRUBT = 0;
constexpr size_t SM_CBIAS = 256 * 1024;
constexpr size_t SM_RWT = 320 * 1024;
constexpr size_t WS_W0IN = 4 * MiB, WS_W0OUT = 9 * MiB, WS_W1IN = 11 * MiB, WS_W1OUT = 17 * MiB;
constexpr size_t WS_WC1 = 19 * MiB;
constexpr size_t WS_WC2 = 21 * MiB;
constexpr size_t WS_LIST = 22 * MiB;
constexpr size_t WS_WSLOT = 26 * MiB;
constexpr size_t WS_POSLOC = WS_WSLOT + 256 * 1024;
constexpr size_t WS_SCAN = 27 * MiB;
constexpr size_t WS_WGU0 = 32 * MiB, WS_WD0 = 96 * MiB, WS_WGU1 = 128 * MiB, WS_WD1 = 192 * MiB;
constexpr size_t WS_ACT = 224 * MiB;
constexpr size_t WS_XB = WS_ACT;
constexpr size_t WS_Z = WS_ACT + 64 * MiB;
constexpr size_t WS_H = WS_ACT + 64 * MiB;
constexpr size_t WS_X8 = WS_ACT + 100 * MiB;
constexpr size_t WS_Y = WS_ACT + 136 * MiB;
constexpr size_t WS_Q = WS_ACT + 64 * MiB;
constexpr size_t WS_KV = WS_ACT + 128 * MiB;
constexpr size_t KV_STRIDE = 17 * MiB;
constexpr size_t WS_GATES = WS_ACT + 232 * MiB;
constexpr size_t WS_CMPH = WS_ACT + 240 * MiB;
constexpr size_t WS_CMPO = WS_ACT + 248 * MiB;
constexpr size_t WS_END = WS_ACT + 280 * MiB;
constexpr int CW_CNT = 64;
constexpr int CW_BAR = 1024;
constexpr int CTL_WORDS = 8192;

DI unsigned f2bf(float f) { unsigned u = __builtin_bit_cast(unsigned, f); return (u + 0x7fffu + ((u >> 16) & 1u)) >> 16; }
DI unsigned pk2(float lo, float hi) { return f2bf(lo) | (f2bf(hi) << 16); }
DI float bf2f(unsigned short b) { return __builtin_bit_cast(float, (unsigned)b << 16); }
DI float bflo(unsigned w) { return __builtin_bit_cast(float, w << 16); }
DI float bfhi(unsigned w) { return __builtin_bit_cast(float, w & 0xffff0000u); }
DI unsigned cvt_pk_bf16(float lo, float hi) { unsigned r; asm volatile("v_cvt_pk_bf16_f32 %0, %1, %2" : "=v"(r) : "v"(lo), "v"(hi)); return r; }
DI float wave_sum(float v) {
    int x = __float_as_int(v);
    x = __float_as_int(__int_as_float(x) + __int_as_float(__builtin_amdgcn_mov_dpp(x, 0xB1, 0xF, 0xF, true)));
    x = __float_as_int(__int_as_float(x) + __int_as_float(__builtin_amdgcn_mov_dpp(x, 0x4E, 0xF, 0xF, true)));
    x = __float_as_int(__int_as_float(x) + __int_as_float(__builtin_amdgcn_mov_dpp(x, 0x141, 0xF, 0xF, true)));
    x = __float_as_int(__int_as_float(x) + __int_as_float(__builtin_amdgcn_mov_dpp(x, 0x140, 0xF, 0xF, true)));
    x = __float_as_int(__int_as_float(x) + __int_as_float(__builtin_amdgcn_update_dpp(0, x, 0x142, 0xA, 0xF, false)));
    x = __float_as_int(__int_as_float(x) + __int_as_float(__builtin_amdgcn_update_dpp(0, x, 0x143, 0xC, 0xF, false)));
    return __int_as_float(__builtin_amdgcn_readlane(x, 63));
}
DI float sigmoidf_(float x) { return __builtin_amdgcn_rcpf(1.0f + __builtin_amdgcn_exp2f(-1.4426950408889634f * x)); }
DI float gelu_tanh(float x) { const float u = 0.7978845608028654f * (x + 0.044715f * x * x * x); return x * __builtin_amdgcn_rcpf(1.0f + __builtin_amdgcn_exp2f(-2.8853900817779268f * u)); }
#define LDS_WAIT() asm volatile("s_waitcnt lgkmcnt(0)" ::: "memory")

namespace pg8 {
constexpr int BM = 256, BK = 64, HALF = 128, HTB = HALF * BK * 2, STAGE_BYTES = 8 * HTB;
__host__ __device__ __forceinline__ int lds_byte(int r, int c) { const int st = (r >> 4) * 2 + (c >> 5), rr = r & 15, cc = c & 31, ob = rr * 64 + cc * 2; return st * 1024 + (ob ^ (((ob >> 9) & 1) << 5)); }
__host__ __device__ __forceinline__ void stage_rc(int b, int& R, int& C) { const int st = b / 1024, sb = b % 1024, swz = sb ^ (((sb >> 9) & 1) << 5); R = (st >> 1) * 16 + swz / 64; C = (st & 1) * 32 + (swz % 64) / 2; }
__host__ __device__ __forceinline__ int perm32(int rho) { const int n = rho >> 4, i = rho & 15; return 8 * (i >> 2) + 4 * n + (i & 3); }
struct GU { int pm, pn, e; };
typedef int v8i32 __attribute__((ext_vector_type(8))); typedef int v4i32 __attribute__((ext_vector_type(4))); typedef long v2i64 __attribute__((ext_vector_type(2)));
__device__ __forceinline__ v8i32 cat8(bf16x8 a, bf16x8 b) { const v4i32 x = __builtin_bit_cast(v4i32, a), y = __builtin_bit_cast(v4i32, b); return __builtin_shufflevector(x, y, 0, 1, 2, 3, 4, 5, 6, 7); }
template <class P>
__device__ __forceinline__ void gemm_phase(LAS unsigned char* lds, const P& p) {
    const int tid = threadIdx.x, wid = __builtin_amdgcn_readfirstlane(tid >> 6), lane = tid & 63, wr = wid >> 2, wc = wid & 3, fr = lane & 15, fq = lane >> 4;
    const int nt = p.K / BK;
    int Rr[2]; unsigned Cc2[2], voffB[2];
#pragma unroll
    for (int i = 0; i < 2; ++i) { int R, C; stage_rc(tid * 16 + i * 8192, R, C); const int Rb = P::PERM ? ((R & ~31) + perm32(R & 31)) : R;
        Rr[i] = R; Cc2[i] = (unsigned)C * 2u; voffB[i] = (unsigned)Rb * p.ldb2 + (unsigned)C * 2u; }
    const size_t kstep = (size_t)(BK * 2);
    const size_t hstepB = (size_t)HALF * p.ldb2;
    const unsigned ldsw = (unsigned)wid * 1024u;
    const int aoff = lds_byte(wr * 64 + fr, fq * 8), boff = lds_byte(wc * 32 + fr, fq * 8);
#define PG8_SA(b, h) (((b) * 2 + (h)) * HTB)
#define PG8_SB(b, h) ((4 + (b) * 2 + (h)) * HTB)
#define PG8_STAGE(bufoff, gbase, voff) do { _Pragma("unroll") for (int _i = 0; _i < 2; ++_i) \
        __builtin_amdgcn_global_load_lds((const unsigned*)((const char*)(gbase) + (voff)[_i]), (LAS unsigned*)(lds + (bufoff) + ldsw + _i * 8192), 16, 0, 0); } while (0)
#define PG8_LDA(dst, b, h) do { _Pragma("unroll") for (int m = 0; m < 4; ++m) _Pragma("unroll") for (int k = 0; k < 2; ++k) dst[m][k] = *(const LAS bf16x8*)(lds + PG8_SA(b, h) + aoff + m * 2048 + k * 1024); } while (0)
#define PG8_LDB(dst, b, h) do { _Pragma("unroll") for (int n = 0; n < 2; ++n) _Pragma("unroll") for (int k = 0; k < 2; ++k) dst[n][k] = *(const LAS bf16x8*)(lds + PG8_SB(b, h) + boff + n * 2048 + k * 1024); } while (0)
#define PG8_MMA(ai, bj, At, Bt) do { __builtin_amdgcn_s_setprio(1); _Pragma("unroll") for (int m = 0; m < 4; ++m) _Pragma("unroll") for (int n = 0; n < 2; ++n) { \
        if constexpr (P::FP8) { _Pragma("unroll") for (int k = 0; k < 2; ++k) { const v2i64 b2 = __builtin_bit_cast(v2i64, Bt[n][k]), a2 = __builtin_bit_cast(v2i64, At[m][k]); \
            acc[ai][bj][m][n] = __builtin_amdgcn_mfma_f32_16x16x32_fp8_fp8(b2[0], a2[0], acc[ai][bj][m][n], 0, 0, 0); acc[ai][bj][m][n] = __builtin_amdgcn_mfma_f32_16x16x32_fp8_fp8(b2[1], a2[1], acc[ai][bj][m][n], 0, 0, 0); } } \
        else { _Pragma("unroll") for (int k = 0; k < 2; ++k) acc[ai][bj][m][n] = __builtin_amdgcn_mfma_f32_16x16x32_bf16(Bt[n][k], At[m][k], acc[ai][bj][m][n], 0, 0, 0); } } \
        __builtin_amdgcn_s_setprio(0); } while (0)
#define PG8_WAIT_V(n) asm volatile("s_waitcnt vmcnt(" #n ")" ::: "memory")
#define PG8_WAIT_L(n) asm volatile("s_waitcnt lgkmcnt(" #n ")" ::: "memory")
#define PG8_BAR __builtin_amdgcn_s_barrier()
#define PG8_SCHED __builtin_amdgcn_sched_barrier(0)
    GU cur, nxt; int ui = 0;
    if (!p.next(0, cur)) return;
    f32x4 acc[2][2][4][2];
#pragma unroll
    for (int a = 0; a < 2; ++a)
#pragma unroll
        for (int b = 0; b < 2; ++b)
#pragma unroll
            for (int m = 0; m < 4; ++m)
#pragma unroll
                for (int n = 0; n < 2; ++n) acc[a][b][m][n] = (f32x4){0.f, 0.f, 0.f, 0.f};
    bf16x8 At[4][2], B0[2][2], B1[2][2];
    unsigned cA0[2], cA1[2], nA0[2], nA1[2];
    size_t cU = 0, nU = 0;
#pragma unroll
    for (int i = 0; i < 2; ++i) {
        if constexpr (P::AUNI) { cA0[i] = (unsigned)Rr[i] * p.lda2 + Cc2[i]; cA1[i] = (unsigned)(HALF + Rr[i]) * p.lda2 + Cc2[i]; }
        else { cA0[i] = p.a_row_off(cur, Rr[i]) + Cc2[i]; cA1[i] = p.a_row_off(cur, HALF + Rr[i]) + Cc2[i]; } }
    if constexpr (P::AUNI) cU = p.a_base(cur);
    const char* const Ab0 = p.A;
#define Ab (Ab0 + cU)
    const char* cB = p.b_tile(cur);
    PG8_STAGE(PG8_SB(0, 0), cB, voffB); PG8_STAGE(PG8_SB(0, 1), cB + hstepB, voffB); PG8_STAGE(PG8_SA(0, 0), Ab, cA0); PG8_STAGE(PG8_SA(0, 1), Ab, cA1);
    if (wr == 1) PG8_BAR;
    PG8_WAIT_V(2); PG8_BAR;
    PG8_STAGE(PG8_SB(1, 0), cB + kstep, voffB); PG8_STAGE(PG8_SA(1, 0), Ab + kstep, cA0); PG8_STAGE(PG8_SB(1, 1), cB + hstepB + kstep, voffB);
    PG8_WAIT_V(6); PG8_BAR;
    for (;;) {
        const bool has_next = p.next(ui + 1, nxt);
        const char* nB = has_next ? p.b_tile(nxt) : cB;
        if constexpr (P::AUNI) nU = has_next ? p.a_base(nxt) : cU;
        else {
#pragma unroll
            for (int i = 0; i < 2; ++i) { nA0[i] = has_next ? p.a_row_off(nxt, Rr[i]) + Cc2[i] : cA0[i]; nA1[i] = has_next ? p.a_row_off(nxt, HALF + Rr[i]) + Cc2[i] : cA1[i]; } }
        for (int t = 0; t < nt; t += 2) {
            const bool last = (t == nt - 2);
            const char* a1 = Ab + (size_t)(t + 1) * kstep;
            const char* a2 = last ? (P::AUNI ? Ab0 + nU : Ab) : Ab + (size_t)(t + 2) * kstep; const char* b2 = last ? nB : cB + (size_t)(t + 2) * kstep;
            const char* a3 = a2 + kstep; const char* b3 = b2 + kstep;
            unsigned o0[2], o1[2];
#pragma unroll
            for (int i = 0; i < 2; ++i) { if constexpr (P::AUNI) { o0[i] = cA0[i]; o1[i] = cA1[i]; } else { o0[i] = last ? nA0[i] : cA0[i]; o1[i] = last ? nA1[i] : cA1[i]; } }
            PG8_LDB(B0, 0, 0); PG8_LDB(B1, 0, 1); PG8_SCHED; PG8_LDA(At, 0, 0); PG8_STAGE(PG8_SA(1, 1), a1, cA1);
            PG8_WAIT_V(8); PG8_WAIT_L(0); PG8_BAR; PG8_MMA(0, 0, At, B0); PG8_MMA(0, 1, At, B1); PG8_BAR; PG8_SCHED;
            PG8_LDA(At, 0, 1); PG8_STAGE(PG8_SB(0, 0), b2, voffB); PG8_STAGE(PG8_SB(0, 1), b2 + hstepB, voffB); PG8_STAGE(PG8_SA(0, 0), a2, o0);
            PG8_WAIT_V(8); PG8_WAIT_L(0); PG8_BAR; PG8_MMA(1, 0, At, B0); PG8_MMA(1, 1, At, B1); PG8_BAR; PG8_SCHED;
            PG8_LDB(B0, 1, 0); PG8_LDB(B1, 1, 1); PG8_SCHED; PG8_LDA(At, 1, 0); PG8_STAGE(PG8_SA(0, 1), a2, o1);
            PG8_WAIT_V(8); PG8_WAIT_L(0); PG8_BAR; PG8_MMA(0, 0, At, B0); PG8_MMA(0, 1, At, B1); PG8_BAR; PG8_SCHED;
            PG8_LDA(At, 1, 1); PG8_STAGE(PG8_SB(1, 0), b3, voffB); PG8_STAGE(PG8_SB(1, 1), b3 + hstepB, voffB); PG8_STAGE(PG8_SA(1, 0), a3, o0);
            PG8_WAIT_V(8); PG8_WAIT_L(0); PG8_BAR; PG8_MMA(1, 0, At, B0); PG8_MMA(1, 1, At, B1); PG8_BAR; PG8_SCHED;
        }
#ifndef PG8_NOALIGN
        if (wr == 0) PG8_BAR;
#endif
        p.epi(acc, cur, wr, wc, fr, fq);
        if (!has_next) break;
#pragma unroll
        for (int a = 0; a < 2; ++a)
#pragma unroll
            for (int b = 0; b < 2; ++b)
#pragma unroll
                for (int m = 0; m < 4; ++m)
#pragma unroll
                    for (int n = 0; n < 2; ++n) acc[a][b][m][n] = (f32x4){0.f, 0.f, 0.f, 0.f};
        cur = nxt; cB = nB; ++ui;
        if constexpr (P::AUNI) cU = nU;
        else {
#pragma unroll
            for (int i = 0; i < 2; ++i) { cA0[i] = nA0[i]; cA1[i] = nA1[i]; } }
#ifndef PG8_NOALIGN
        if (wr == 1) PG8_BAR;
#endif
    }
    PG8_WAIT_V(0);
#ifdef PG8_NOALIGN
    if (wr == 0) PG8_BAR;
#endif
    PG8_BAR;
#undef Ab
#undef PG8_SA
#undef PG8_SB
#undef PG8_STAGE
#undef PG8_LDA
#undef PG8_LDB
#undef PG8_MMA
#undef PG8_WAIT_V
#undef PG8_WAIT_L
#undef PG8_BAR
#undef PG8_SCHED
}
struct TileOrder {
    int nM, nN, nwg, G, c;
    __device__ void init(int M, int N, int G_, int c_) { nM = M / BM; nN = N / BM; nwg = nM * nN; G = G_; c = c_; }
    __device__ bool next(int i, GU& u) const {
        const long L = (long)i * G + c; if (L >= nwg) return false;
        int wgid = (int)L; { const int q = nwg / 8, r = nwg % 8, xcd = wgid % 8, off = wgid / 8; wgid = (xcd < r ? xcd * (q + 1) : r * (q + 1) + (xcd - r) * q) + off; }
        const int WGM = 8; const int nig = WGM * nN, gid = wgid / nig, fm = gid * WGM, gsz = (nM - fm) < WGM ? (nM - fm) : WGM;
        u.pm = fm + ((wgid % nig) % gsz); u.pn = (wgid % nig) / gsz; u.e = 0; return true;
    }
};
}
using pg8::GU;

struct Args { const float* in[41]; float* out; unsigned char* ws; int ph_lo, ph_hi; };

struct GemmPlain {
    static constexpr bool AUNI = true;
    static constexpr bool FP8 = false;
    static constexpr bool PERM = true;
    const char* A; int K; unsigned lda2, ldb2; const char* Bt; pg8::TileOrder ord;
    bf16_t* C; int ldc;
    DI bool next(int i, GU& u) const { return ord.next(i, u); }
    DI unsigned a_row_off(const GU& u, int r) const { return (unsigned)(u.pm * 256 + r) * lda2; }
    DI size_t a_base(const GU& u) const { return (size_t)(u.pm * 256) * lda2; }
    DI const char* b_tile(const GU& u) const { return Bt + (size_t)u.pn * 256 * ldb2; }
    DI void epi(const f32x4 (&acc)[2][2][4][2], const GU& u, int wr, int wc, int fr, int fq) const {
        const int row0 = u.pm * 256 + wr * 64 + fr, col0 = u.pn * 256 + wc * 32 + 8 * fq;
#pragma unroll
        for (int ai = 0; ai < 2; ++ai)
#pragma unroll
            for (int m = 0; m < 4; ++m) { bf16_t* rowp = C + (size_t)(row0 + ai * 128 + m * 16) * ldc + col0;
#pragma unroll
                for (int bj = 0; bj < 2; ++bj) { const f32x4 v0 = acc[ai][bj][m][0], v1 = acc[ai][bj][m][1];
                    u32x4 w; w.x = cvt_pk_bf16(v0[0], v0[1]); w.y = cvt_pk_bf16(v0[2], v0[3]); w.z = cvt_pk_bf16(v1[0], v1[1]); w.w = cvt_pk_bf16(v1[2], v1[3]);
                    *(u32x4*)(rowp + bj * 128) = w; } }
    }
};
template <bool RES32, bool FP8_>
struct GemmResid {
    static constexpr bool AUNI = true;
    static constexpr bool FP8 = FP8_;
    static constexpr bool PERM = true;
    const char* A; int K; unsigned lda2, ldb2; const char* Bt; pg8::TileOrder ord;
    const float* res32; const bf16_t* res16; bf16_t* out;
    DI bool next(int i, GU& u) const { return ord.next(i, u); }
    DI unsigned a_row_off(const GU& u, int r) const { return (unsigned)(u.pm * 256 + r) * lda2; }
    DI size_t a_base(const GU& u) const { return (size_t)(u.pm * 256) * lda2; }
    DI const char* b_tile(const GU& u) const { return Bt + (size_t)u.pn * 256 * ldb2; }
    DI void epi(const f32x4 (&acc)[2][2][4][2], const GU& u, int wr, int wc, int fr, int fq) const {
        const int col0 = u.pn * 256 + wc * 32 + 8 * fq; const size_t rbase = (size_t)(u.pm * 256 + wr * 64 + fr) * D + col0;
        if constexpr (RES32) {
#pragma unroll
            for (int ai = 0; ai < 2; ++ai) {
                f32x4 r[4][2][2];
#pragma unroll
                for (int m = 0; m < 4; ++m)
#pragma unroll
                    for (int bj = 0; bj < 2; ++bj) { const float* rp = res32 + rbase + (size_t)(ai * 128 + m * 16) * D + bj * 128; r[m][bj][0] = *(const f32x4*)rp; r[m][bj][1] = *(const f32x4*)(rp + 4); }
#pragma unroll
                for (int m = 0; m < 4; ++m)
#pragma unroll
                    for (int bj = 0; bj < 2; ++bj) { const f32x4 v0 = r[m][bj][0] * DN_ALPHA + acc[ai][bj][m][0], v1 = r[m][bj][1] * DN_ALPHA + acc[ai][bj][m][1];
                        u32x4 w; w.x = cvt_pk_bf16(v0[0], v0[1]); w.y = cvt_pk_bf16(v0[2], v0[3]); w.z = cvt_pk_bf16(v1[0], v1[1]); w.w = cvt_pk_bf16(v1[2], v1[3]);
                        *(u32x4*)(out + rbase + (size_t)(ai * 128 + m * 16) * D + bj * 128) = w; }
            }
        } else {
            u32x4 r[2][4][2];
#pragma unroll
            for (int ai = 0; ai < 2; ++ai)
#pragma unroll
                for (int m = 0; m < 4; ++m)
#pragma unroll
                    for (int bj = 0; bj < 2; ++bj) r[ai][m][bj] = *(const u32x4*)(res16 + rbase + (size_t)(ai * 128 + m * 16) * D + bj * 128);
#pragma unroll
            for (int ai = 0; ai < 2; ++ai)
#pragma unroll
                for (int m = 0; m < 4; ++m)
#pragma unroll
                    for (int bj = 0; bj < 2; ++bj) { const u32x4 q = r[ai][m][bj]; const float sc = FP8_ ? 0.03125f : 1.0f; const f32x4 a0 = acc[ai][bj][m][0] * sc, a1 = acc[ai][bj][m][1] * sc;
                        u32x4 w; w.x = cvt_pk_bf16(bflo(q.x) * DN_ALPHA + a0[0], bfhi(q.x) * DN_ALPHA + a0[1]); w.y = cvt_pk_bf16(bflo(q.y) * DN_ALPHA + a0[2], bfhi(q.y) * DN_ALPHA + a0[3]);
                        w.z = cvt_pk_bf16(bflo(q.z) * DN_ALPHA + a1[0], bfhi(q.z) * DN_ALPHA + a1[1]); w.w = cvt_pk_bf16(bflo(q.w) * DN_ALPHA + a1[2], bfhi(q.w) * DN_ALPHA + a1[3]);
                        *(u32x4*)(out + rbase + (size_t)(ai * 128 + m * 16) * D + bj * 128) = w; }
        }
    }
};
struct MoeTab { const LAS int* tbase; const LAS int* cnt; int ntiles; };
struct GemmMoeUp {
    static constexpr bool AUNI = false;
    static constexpr bool FP8 = true;
    static constexpr bool PERM = true;
    const char* A; int K; unsigned lda2, ldb2; const char* Bt; int G, c;
    MoeTab tab; const unsigned* list; bf16_t* H;
    DI bool next(int i, GU& u) const {
        const int L = i * G + c; if (L >= tab.ntiles * 4) return false;
        const int tile = L >> 2; u.pn = L & 3; int e = 0;
#pragma unroll 1
        while (tab.tbase[e + 1] <= tile) ++e;
        u.e = e; u.pm = tile - tab.tbase[e]; return true;
    }
    DI unsigned a_row_off(const GU& u, int r) const {
        const int li = u.pm * 256 + r; const int cn = tab.cnt[u.e];
        const unsigned slot = li < cn ? list[(size_t)u.e * T + li] : 0u;
        return (slot >> 1) * lda2;
    }
    DI size_t a_base(const GU&) const { return 0; }
    DI const char* b_tile(const GU& u) const { return Bt + ((size_t)u.e * 1024 + (size_t)u.pn * 256) * ldb2; }
    DI void epi(const f32x4 (&acc)[2][2][4][2], const GU& u, int wr, int wc, int fr, int fq) const {
        const int hrow0 = (tab.tbase[u.e] + u.pm) * 256 + wr * 64 + fr, col0 = u.pn * 128 + wc * 32 + 8 * fq;
#pragma unroll
        for (int ai = 0; ai < 2; ++ai)
#pragma unroll
            for (int m = 0; m < 4; ++m) { unsigned char* rowp = (unsigned char*)H + (size_t)(hrow0 + ai * 128 + m * 16) * FF + col0;
                float h[8];
#pragma unroll
                for (int n = 0; n < 2; ++n)
#pragma unroll
                    for (int j = 0; j < 4; ++j) { const float g = acc[ai][0][m][n][j] * 0.03125f, uu = acc[ai][1][m][n][j] * 0.03125f; h[n * 4 + j] = g * uu / (1.0f + __expf(-g)); }
                int w0 = 0, w1 = 0; w0 = __builtin_amdgcn_cvt_pk_fp8_f32(h[0], h[1], w0, false); w0 = __builtin_amdgcn_cvt_pk_fp8_f32(h[2], h[3], w0, true);
                w1 = __builtin_amdgcn_cvt_pk_fp8_f32(h[4], h[5], w1, false); w1 = __builtin_amdgcn_cvt_pk_fp8_f32(h[6], h[7], w1, true);
                *(u32x2*)rowp = (u32x2){(unsigned)w0, (unsigned)w1}; }
    }
};
struct GemmMoeDown {
    static constexpr bool AUNI = true;
    static constexpr bool FP8 = true;
    static constexpr bool PERM = true;
    const char* A; int K; unsigned lda2, ldb2; const char* Bt; int G, c;
    MoeTab tab; bf16_t* Y;
    DI bool next(int i, GU& u) const {
        const int L = i * G + c; if (L >= tab.ntiles * 4) return false;
        const int tile = L >> 2; u.pn = L & 3; int e = 0;
#pragma unroll 1
        while (tab.tbase[e + 1] <= tile) ++e;
        u.e = e; u.pm = tile - tab.tbase[e]; return true;
    }
    DI unsigned a_row_off(const GU& u, int r) const { return (unsigned)((tab.tbase[u.e] + u.pm) * 256 + r) * lda2; }
    DI size_t a_base(const GU& u) const { return (size_t)((tab.tbase[u.e] + u.pm) * 256) * lda2; }
    DI const char* b_tile(const GU& u) const { return Bt + ((size_t)u.e * 1024 + (size_t)u.pn * 256) * ldb2; }
    DI void epi(const f32x4 (&acc)[2][2][4][2], const GU& u, int wr, int wc, int fr, int fq) const {
        const int row0 = (tab.tbase[u.e] + u.pm) * 256 + wr * 64 + fr, col0 = u.pn * 256 + wc * 32 + 8 * fq;
#pragma unroll
        for (int ai = 0; ai < 2; ++ai)
#pragma unroll
            for (int m = 0; m < 4; ++m) { bf16_t* rowp = Y + (size_t)(row0 + ai * 128 + m * 16) * D + col0;
#pragma unroll
                for (int bj = 0; bj < 2; ++bj) { const f32x4 v0 = acc[ai][bj][m][0] * 0.03125f, v1 = acc[ai][bj][m][1] * 0.03125f;
                    u32x4 w; w.x = cvt_pk_bf16(v0[0], v0[1]); w.y = cvt_pk_bf16(v0[2], v0[3]); w.z = cvt_pk_bf16(v1[0], v1[1]); w.w = cvt_pk_bf16(v1[2], v1[3]);
                    *(u32x4*)(rowp + bj * 128) = w; } }
    }
};

#define XB_TMO      128
#define XB_XCNT(j)  (256  + 64 * (j))
#define XB_XSUB(j)  (1280 + 64 * (j))
#define XB_XGEN(j)  (2304 + 64 * (j))
#define XB_TOP      3328
#define XB_TOPGEN   3392
#define XCD_BAR_WORDS 3456
#define XB_SPIN_CAP (1u << 18)
__device__ __forceinline__ unsigned xb_ld(unsigned* p)              { return __hip_atomic_load(p, __ATOMIC_RELAXED, __HIP_MEMORY_SCOPE_AGENT); }
__device__ __forceinline__ unsigned xb_add(unsigned* p, unsigned v) { return __hip_atomic_fetch_add(p, v, __ATOMIC_RELAXED, __HIP_MEMORY_SCOPE_AGENT); }
__device__ __forceinline__ unsigned xb_xcc_id() { return (unsigned)__builtin_amdgcn_s_getreg((3 << 11) | 20) & 0xFu; }
#define XB_SPIN(cond, bar) do { unsigned _sp = 0; while (cond) { __builtin_amdgcn_s_sleep(1); \
    if ((++_sp & 255u) == 0u) { if (xb_ld(&(bar)[XB_TMO])) break; if (_sp > XB_SPIN_CAP) { atomicAdd(&(bar)[XB_TMO], 1u); break; } } } } while (0)
struct XcdBarrier { unsigned* bar; unsigned x; volatile LAS unsigned* st; };
__device__ __forceinline__ XcdBarrier xcd_barrier_post(unsigned* bar, volatile LAS unsigned* st) {
    XcdBarrier b; b.bar = bar; b.x = xb_xcc_id(); b.st = st;
    if (threadIdx.x == 0) (void)xb_add(&bar[XB_XCNT(b.x)], 1u);
    return b;
}
__device__ __forceinline__ void xcd_barrier_complete(unsigned* bar, unsigned x, unsigned& nloc, unsigned& nx) {
    const unsigned G = gridDim.x * gridDim.y * gridDim.z;
    unsigned sum, cnt, mine, sp = 0u;
    for (;;) {
        sum = 0u; cnt = 0u; mine = 0u;
#pragma unroll
        for (unsigned j = 0; j < 16; ++j) { const unsigned c = xb_ld(&bar[XB_XCNT(j)]); sum += c; cnt += (c > 0u) ? 1u : 0u; mine = (j == x) ? c : mine; }
        if (sum == G) break;
        __builtin_amdgcn_s_sleep(1);
        if ((++sp & 255u) == 0u) { if (xb_ld(&bar[XB_TMO])) break; if (sp > XB_SPIN_CAP) { atomicAdd(&bar[XB_TMO], 1u); break; } }
    }
    nloc = mine > 0u ? mine : 1u; nx = cnt > 0u ? cnt : 1u;
}
__device__ __forceinline__ void xcd_barrier(const XcdBarrier& b) {
    asm volatile("s_waitcnt vmcnt(0)" ::: "memory");
    __syncthreads();
    if (threadIdx.x == 0) {
        unsigned* bar = b.bar;
        __builtin_amdgcn_s_waitcnt(0);
        unsigned nloc = b.st[0], nx = b.st[1];
        if (nloc == 0u) { xcd_barrier_complete(bar, b.x, nloc, nx); b.st[0] = nloc; b.st[1] = nx; }
        const unsigned old = xb_add(&bar[XB_XSUB(b.x)], 1u);
        const unsigned gen = old / nloc;
        if (old + 1u == (gen + 1u) * nloc) {
            __builtin_amdgcn_fence(__ATOMIC_RELEASE, "agent");
            asm volatile("s_waitcnt vmcnt(0)" ::: "memory");
            const unsigned og = xb_add(&bar[XB_TOP], 1u);
            const unsigned tg = og / nx;
            if (og + 1u == (tg + 1u) * nx) xb_add(&bar[XB_TOPGEN], 1u);
            else XB_SPIN(xb_ld(&bar[XB_TOPGEN]) == tg, bar);
            __builtin_amdgcn_fence(__ATOMIC_ACQUIRE, "agent");
            xb_add(&bar[XB_XGEN(b.x)], 1u);
            asm volatile("s_waitcnt vmcnt(0)" ::: "memory");
        } else {
            XB_SPIN(xb_ld(&bar[XB_XGEN(b.x)]) == gen, bar);
            __builtin_amdgcn_fence(__ATOMIC_ACQUIRE, "agent");
            asm volatile("s_waitcnt vmcnt(0)" ::: "memory");
        }
    }
    __syncthreads();
}

struct Frame {
    LAS unsigned char* lds;
    int tid, lane, wave, vcu, G;
    const float* const* in; float* out; unsigned char* ws;
};
constexpr int LDS_RING = 131072;
constexpr int LDS_MISC = LDS_RING;
constexpr int LDS_BYTES = 147456;

template <class Map>
DI void p0_transpose_item(const float* W, int K, int N, bf16_t* WT, const Map& map, LAS float* scr_, int item, int lane) {
    LAS unsigned char* scr = (LAS unsigned char*)scr_;
    const int nblk = (N + 63) / 64, kb = item / nblk, nb = item % nblk, k0 = 64 * kb, n0 = 64 * nb;
    const int kk = lane >> 4, n4 = 4 * (lane & 15);
    const bool nok = (n0 + n4) < N;
    f32x4 v[16];
#pragma unroll
    for (int i = 0; i < 16; ++i) v[i] = nok ? *(const f32x4*)(W + (size_t)(k0 + 16 * kk + i) * N + n0 + n4) : (f32x4){0.f, 0.f, 0.f, 0.f};
#pragma unroll
    for (int c = 0; c < 4; ++c) {
        u32x4 lo, hi;
        lo.x = pk2(v[0][c], v[1][c]); lo.y = pk2(v[2][c], v[3][c]); lo.z = pk2(v[4][c], v[5][c]); lo.w = pk2(v[6][c], v[7][c]);
        hi.x = pk2(v[8][c], v[9][c]); hi.y = pk2(v[10][c], v[11][c]); hi.z = pk2(v[12][c], v[13][c]); hi.w = pk2(v[14][c], v[15][c]);
        *(LAS u32x4*)(scr + (n4 + c) * 144 + kk * 32) = lo; *(LAS u32x4*)(scr + (n4 + c) * 144 + kk * 32 + 16) = hi;
    }
    LDS_WAIT(); asm volatile("" ::: "memory");
#pragma unroll
    for (int j = 0; j < 8; ++j) { const int n = (lane >> 3) + 8 * j, ch = lane & 7;
        const u32x4 o = *(const LAS u32x4*)(scr + n * 144 + ch * 16);
        if (n0 + n < N) *(u32x4*)(WT + (size_t)map(n0 + n) * K + k0 + 8 * ch) = o; }
    LDS_WAIT(); asm volatile("" ::: "memory");
}
template <class Map>
DI void p0_transpose_item_f8(const float* W, int K, int N, unsigned char* WT, const Map& map, LAS float* scr_, int item, int lane) {
    LAS unsigned char* scr = (LAS unsigned char*)scr_;
    const int nblk = (N + 63) / 64, kb = item / nblk, nb = item % nblk, k0 = 64 * kb, n0 = 64 * nb;
    const int kk = lane >> 4, n4 = 4 * (lane & 15);
    const bool nok = (n0 + n4) < N;
    f32x4 v[16];
#pragma unroll
    for (int i = 0; i < 16; ++i) v[i] = nok ? *(const f32x4*)(W + (size_t)(k0 + 16 * kk + i) * N + n0 + n4) * 32.0f : (f32x4){0.f, 0.f, 0.f, 0.f};
#pragma unroll
    for (int c = 0; c < 4; ++c) { int w[4];
#pragma unroll
        for (int q = 0; q < 4; ++q) { int x = 0; x = __builtin_amdgcn_cvt_pk_fp8_f32(v[4 * q][c], v[4 * q + 1][c], x, false); x = __builtin_amdgcn_cvt_pk_fp8_f32(v[4 * q + 2][c], v[4 * q + 3][c], x, true); w[q] = x; }
        *(LAS u32x4*)(scr + (n4 + c) * 80 + kk * 16) = (u32x4){(unsigned)w[0], (unsigned)w[1], (unsigned)w[2], (unsigned)w[3]}; }
    LDS_WAIT(); asm volatile("" ::: "memory");
#pragma unroll
    for (int j = 0; j < 4; ++j) { const int n = (lane >> 2) + 16 * j, ch = lane & 3;
        const u32x4 o = *(const LAS u32x4*)(scr + n * 80 + ch * 16);
        if (n0 + n < N) *(u32x4*)(WT + (size_t)map(n0 + n) * K + k0 + 16 * ch) = o; }
    LDS_WAIT(); asm volatile("" ::: "memory");
}
struct MapId { int off; DI int operator()(int n) const { return n + off; } };
DI int rope_perm(int d) { return (d & 15) | ((d & 16) << 1) | ((d & 32) >> 1); }
struct MapL1In { DI int operator()(int n) const {
    if (n < 1024) return (n & ~63) | rope_perm(n & 63);
    if (n < 2560) { const int j = (n - 1024) >> 8; return (j & 1) ? n : ((n & ~63) | rope_perm(n & 63)); }
    return n; } };
struct MapGU { int up; DI int operator()(int c) const { return (c >> 7) * 256 + up * 128 + (c & 127); } };

DI void p0_prep(Frame& F) {
    LAS float* scr = (LAS float*)(F.lds + F.wave * 16384);
    const int gw = F.vcu * NWAVES + F.wave, NGW = F.G * NWAVES;
    const int gt = F.vcu * NTHR + F.tid, NGT = F.G * NTHR;
    unsigned char* ws = F.ws;
    for (int i = gt; i < CTL_WORDS; i += NGT) ((unsigned*)(ws + WS_CTL))[i] = 0u;
    constexpr int I_W0IN = 16 * 40, I_W0OUT = 16 * 16, I_W1IN = 16 * 41, I_W1OUT = 16 * 16, I_WC1 = 32 * 4, I_WC2 = 4 * 1, I_MOE = 32 * 128;
    constexpr int NITEMS = I_W0IN + I_W0OUT + I_W1IN + I_W1OUT + 2 * I_WC1 + 2 * I_WC2 + 3 * I_MOE;
    for (int it = gw; it < NITEMS; it += NGW) {
        int r = it;
        if (r < I_W0IN) { p0_transpose_item(F.in[1], 1024, L0N, (bf16_t*)(ws + WS_W0IN), MapId{0}, scr, r, F.lane); continue; } r -= I_W0IN;
        if (r < I_W0OUT) { p0_transpose_item(F.in[10], 1024, 1024, (bf16_t*)(ws + WS_W0OUT), MapId{0}, scr, r, F.lane); continue; } r -= I_W0OUT;
        if (r < I_W1IN) { p0_transpose_item_f8(F.in[22], 1024, L1N, ws + WS_W1IN, MapL1In{}, scr, r, F.lane); continue; } r -= I_W1IN;
        if (r < I_W1OUT) { p0_transpose_item_f8(F.in[29], 1024, 1024, ws + WS_W1OUT, MapId{0}, scr, r, F.lane); continue; } r -= I_W1OUT;
        if (r < I_WC1) { p0_transpose_item(F.in[24], 2048, 256, (bf16_t*)(ws + WS_WC1), MapId{0}, scr, r, F.lane); continue; } r -= I_WC1;
        if (r < I_WC1) { p0_transpose_item(F.in[27], 2048, 256, (bf16_t*)(ws + WS_WC1) + 256 * 2048, MapId{0}, scr, r, F.lane); continue; } r -= I_WC1;
        if (r < I_WC2) { p0_transpose_item(F.in[25], 256, 64, (bf16_t*)(ws + WS_WC2), MapId{0}, scr, r, F.lane); continue; } r -= I_WC2;
        if (r < I_WC2) { p0_transpose_item(F.in[28], 256, 64, (bf16_t*)(ws + WS_WC2) + 256 * 256, MapId{0}, scr, r, F.lane); continue; } r -= I_WC2;
#pragma unroll 1
        for (int l = 0; l < 1; ++l) {
            const int ib = l ? 36 : 17; unsigned char* wgu = ws + (l ? WS_WGU1 : WS_WGU0); unsigned char* wd = ws + (l ? WS_WD1 : WS_WD0);
            if (r < I_MOE) { const int e = r >> 7; p0_transpose_item_f8(F.in[ib] + (size_t)e * 1024 * 512, 1024, 512, wgu + (size_t)e * 1024 * 1024, MapGU{0}, scr, r & 127, F.lane); r = -1; break; } r -= I_MOE;
            if (r < I_MOE) { const int e = r >> 7; p0_transpose_item_f8(F.in[ib + 1] + (size_t)e * 1024 * 512, 1024, 512, wgu + (size_t)e * 1024 * 1024, MapGU{1}, scr, r & 127, F.lane); r = -1; break; } r -= I_MOE;
            if (r < I_MOE) { const int e = r >> 7; p0_transpose_item_f8(F.in[ib + 2] + (size_t)e * 512 * 1024, 512, 1024, wd + (size_t)e * 1024 * 512, MapId{0}, scr, r & 127, F.lane); r = -1; break; } r -= I_MOE;
        }
    }
    { u32x4 z = (u32x4){0u, 0u, 0u, 0u};
      u32x4* p1 = (u32x4*)(ws + WS_W1IN + (size_t)L1N * 1024); const int n1 = (L1NP - L1N) * 1024 / 16;
      for (int i = gt; i < n1; i += NGT) p1[i] = z;
      for (int kv = 0; kv < 2; ++kv) { u32x4* p2 = (u32x4*)((bf16_t*)(ws + WS_WC2) + (size_t)kv * 65536 + 64 * 256); const int n2 = 192 * 256 / 8; for (int i = gt; i < n2; i += NGT) p2[i] = z; } }
    { const float* x = F.in[0]; bf16_t* xb = (bf16_t*)(ws + WS_XB);
      for (int m = gw; m < T; m += NGW) { const f32x4* xr = (const f32x4*)(x + (size_t)m * D) + F.lane; u32x2* o = (u32x2*)(xb + (size_t)m * D) + F.lane;
#pragma unroll
          for (int j = 0; j < 4; ++j) { const f32x4 v = xr[64 * j]; o[64 * j] = (u32x2){pk2(v.x, v.y), pk2(v.z, v.w)}; } } }
    { float* ct = (float*)(ws + WS_COS); float* st = (float*)(ws + WS_SIN);
      for (int i = gt; i < SEQ * 32; i += NGT) { const int pos = i >> 5, k = i & 31; const float inv = (float)pow(10000.0, -(double)(2 * k) / 64.0); const float ang = (float)pos * inv;
          ct[i] = (float)cos((double)ang); st[i] = (float)sin((double)ang); } }
    { bf16_t* bt = (bf16_t*)(ws + WS_SMALL + SM_LRUBT);
      for (int i = gt; i < 2 * 8 * 4096; i += NGT) { const int g = i >> 15, h = (i >> 12) & 7, j = (i >> 6) & 63, ii = i & 63; const float* w = F.in[g ? 7 : 5];
          bt[i] = (bf16_t)f2bf(w[h * 4096 + ii * 64 + j]); } }
    { float* rw = (float*)(ws + WS_SMALL + SM_RWT);
      for (int i = gt; i < 2 * 36 * 1024; i += NGT) { const int l = i / (36 * 1024), o = (i / 1024) % 36, k = i & 1023; const float* wg = F.in[l ? 32 : 13]; const float* we = F.in[l ? 34 : 15];
          rw[i] = o < 4 ? wg[k * 4 + o] : we[k * 32 + (o - 4)]; } }
    { float* cb = (float*)(ws + WS_SMALL + SM_CBIAS);
      for (int o = gw; o < 512; o += NGW) { const int kv = o >> 8, j = o & 255; const float* pe = F.in[kv ? 26 : 23]; const float* w1 = F.in[kv ? 27 : 24];
          float s = 0.f; for (int k = F.lane; k < 2048; k += 64) s += pe[k] * w1[(size_t)k * 256 + j];
          s = wave_sum(s); if (F.lane == 0) cb[o] = s; } }
}

DI void p0_moe1(Frame& F, int first) {
    LAS float* scr = (LAS float*)(F.lds + F.wave * 16384);
    const int nb = F.G - first; if (nb <= 0 || (int)blockIdx.x < first) return;
    const int gw = ((int)blockIdx.x - first) * NWAVES + F.wave, NGW = nb * NWAVES;
    unsigned char* ws = F.ws; constexpr int I_MOE = 32 * 128;
    unsigned char* wgu = ws + WS_WGU1; unsigned char* wd = ws + WS_WD1;
    for (int it = gw; it < 3 * I_MOE; it += NGW) {
        int r = it;
        if (r < I_MOE) { const int e = r >> 7; p0_transpose_item_f8(F.in[36] + (size_t)e * 1024 * 512, 1024, 512, wgu + (size_t)e * 1024 * 1024, MapGU{0}, scr, r & 127, F.lane); continue; } r -= I_MOE;
        if (r < I_MOE) { const int e = r >> 7; p0_transpose_item_f8(F.in[37] + (size_t)e * 1024 * 512, 1024, 512, wgu + (size_t)e * 1024 * 1024, MapGU{1}, scr, r & 127, F.lane); continue; } r -= I_MOE;
        { const int e = r >> 7; p0_transpose_item_f8(F.in[38] + (size_t)e * 512 * 1024, 512, 1024, wd + (size_t)e * 1024 * 512, MapId{0}, scr, r & 127, F.lane); }
    }
}

constexpr int XCL_STRIDE = 520;
constexpr int LDS_XC = 0, LDS_GT = 66560, LDS_HIN = 133120;
DI f32x2 lds_swap(float v) { auto rr = __builtin_amdgcn_permlane32_swap(__float_as_uint(v), __float_as_uint(v), false, false); return (f32x2){__uint_as_float(rr[0]), __uint_as_float(rr[1])}; }

template <int CTRL> DI float quad_xor(float v) { return __int_as_float(__builtin_amdgcn_mov_dpp(__float_as_int(v), CTRL, 0xF, 0xF, true)); }

template <bool FINAL>
DI void lru_tile(Frame& F, int b, int ch) {
    const unsigned char* ws = F.ws;
    const bf16_t* z = (const bf16_t*)(ws + WS_Z);
    bf16_t* ycat = (bf16_t*)(ws + WS_XB);
    f32x2* SAH = (f32x2*)(ws + WS_SCAN);
    LAS bf16_t* xcL = (LAS bf16_t*)(F.lds + LDS_XC); LAS bf16_t* gL = (LAS bf16_t*)(F.lds + LDS_GT); LAS float* hin = (LAS float*)(F.lds + LDS_HIN);
    const int tid = F.tid, lane = F.lane, wave = F.wave;
    const int t0 = ch * 64; const size_t row0 = (size_t)b * SEQ + t0;
    const int c8 = tid & 63, tg = tid >> 6;
    {
        float w[4][8], bias[8];
        const float* cw = F.in[3]; const float* cbv = F.in[4];
#pragma unroll
        for (int k = 0; k < 4; ++k)
#pragma unroll
            for (int j = 0; j < 8; ++j) w[k][j] = cw[k * 512 + c8 * 8 + j];
#pragma unroll
        for (int j = 0; j < 8; ++j) bias[j] = cbv[c8 * 8 + j];
        float xv[11][8];
#pragma unroll
        for (int i = 0; i < 11; ++i) { const int t = t0 + tg * 8 + i - 3;
            if (t >= 0) { const u32x4 v = *(const u32x4*)(z + ((size_t)b * SEQ + t) * L0N + 2048 + c8 * 8);
                xv[i][0] = bflo(v.x); xv[i][1] = bfhi(v.x); xv[i][2] = bflo(v.y); xv[i][3] = bfhi(v.y); xv[i][4] = bflo(v.z); xv[i][5] = bfhi(v.z); xv[i][6] = bflo(v.w); xv[i][7] = bfhi(v.w); }
            else {
#pragma unroll
                for (int j = 0; j < 8; ++j) xv[i][j] = 0.f; } }
#pragma unroll
        for (int i = 0; i < 8; ++i) { float o[8];
#pragma unroll
            for (int j = 0; j < 8; ++j) o[j] = bias[j] + w[0][j] * xv[i][j] + w[1][j] * xv[i + 1][j] + w[2][j] * xv[i + 2][j] + w[3][j] * xv[i + 3][j];
            u32x4 pk; pk.x = pk2(o[0], o[1]); pk.y = pk2(o[2], o[3]); pk.z = pk2(o[4], o[5]); pk.w = pk2(o[6], o[7]);
            *(LAS u32x4*)(xcL + (tg * 8 + i) * XCL_STRIDE + c8 * 8) = pk; }
    }
    if constexpr (FINAL) {
#pragma unroll
        for (int i = 0; i < 8; ++i) { const int tl = tg * 8 + i; const u32x4 v = *(const u32x4*)(z + (row0 + tl) * L0N + 1536 + c8 * 8); *(LAS u32x4*)(gL + tl * XCL_STRIDE + c8 * 8) = v; }
        float w[3][8]; const float* cw = F.in[2];
#pragma unroll
        for (int k = 0; k < 3; ++k)
#pragma unroll
            for (int j = 0; j < 8; ++j) w[k][j] = cw[k * 512 + c8 * 8 + j];
        float pv[10][8];
#pragma unroll
        for (int i = 0; i < 10; ++i) { const int t = t0 + tg * 8 + i - 2;
            if (t >= 0) { const bf16_t* zr = z + ((size_t)b * SEQ + t) * L0N + c8 * 8; const u32x4 a = *(const u32x4*)(zr + 512), c = *(const u32x4*)(zr + 1024);
                pv[i][0] = bflo(a.x) * bflo(c.x); pv[i][1] = bfhi(a.x) * bfhi(c.x); pv[i][2] = bflo(a.y) * bflo(c.y); pv[i][3] = bfhi(a.y) * bfhi(c.y);
                pv[i][4] = bflo(a.z) * bflo(c.z); pv[i][5] = bfhi(a.z) * bfhi(c.z); pv[i][6] = bflo(a.w) * bflo(c.w); pv[i][7] = bfhi(a.w) * bfhi(c.w); }
            else {
#pragma unroll
                for (int j = 0; j < 8; ++j) pv[i][j] = 0.f; } }
#pragma unroll
        for (int i = 0; i < 8; ++i) { const int tl = tg * 8 + i; const u32x4 bgv = *(const u32x4*)(z + (row0 + tl) * L0N + c8 * 8);
            const float bgf[8] = {bflo(bgv.x), bfhi(bgv.x), bflo(bgv.y), bfhi(bgv.y), bflo(bgv.z), bfhi(bgv.z), bflo(bgv.w), bfhi(bgv.w)};
            float o[8];
#pragma unroll
            for (int j = 0; j < 8; ++j) o[j] = bgf[j] * (w[0][j] * pv[i][j] + w[1][j] * pv[i + 1][j] + w[2][j] * pv[i + 2][j]);
            u32x4 pk; pk.x = pk2(o[0], o[1]); pk.y = pk2(o[2], o[3]); pk.z = pk2(o[4], o[5]); pk.w = pk2(o[6], o[7]);
            *(u32x4*)(ycat + (row0 + tl) * D + c8 * 8) = pk; }
        { float h = 0.f; const f32x4* sp4 = (const f32x4*)(SAH + ((size_t)b * 512 + tid) * 128);
#pragma unroll 8
          for (int k2 = 0; k2 < (ch >> 1); ++k2) { const f32x4 v = sp4[k2]; h = v.x * h + v.y; h = v.z * h + v.w; }
          if (ch & 1) { const f32x2 v = SAH[((size_t)b * 512 + tid) * 128 + ch - 1]; h = v.x * h + v.y; }
          hin[tid] = h; }
    }
    __syncthreads();
    {
        const int head = wave, r32 = lane & 31, hh = lane >> 5;
        const bf16_t* lbt = (const bf16_t*)(ws + WS_SMALL + SM_LRUBT);
        const float* b_a = F.in[6]; const float* b_x = F.in[8]; const float* lam = F.in[9];
#pragma unroll 1
        for (int ct = 0; ct < 2; ++ct) {
            const int c = head * 64 + ct * 32 + r32;
            f32x16 acc[2][2];
#pragma unroll
            for (int g = 0; g < 2; ++g)
#pragma unroll
                for (int rt = 0; rt < 2; ++rt)
#pragma unroll
                    for (int i = 0; i < 16; ++i) acc[g][rt][i] = 0.f;
#pragma unroll
            for (int ks = 0; ks < 4; ++ks) {
                bf16x8 af[2], bfr[2];
#pragma unroll
                for (int rt = 0; rt < 2; ++rt) af[rt] = *(const LAS bf16x8*)(xcL + (rt * 32 + r32) * XCL_STRIDE + head * 64 + ks * 16 + hh * 8);
#pragma unroll
                for (int g = 0; g < 2; ++g) bfr[g] = *(const bf16x8*)(lbt + ((size_t)(g * 8 + head) * 64 + ct * 32 + r32) * 64 + ks * 16 + hh * 8);
#pragma unroll
                for (int g = 0; g < 2; ++g)
#pragma unroll
                    for (int rt = 0; rt < 2; ++rt) acc[g][rt] = __builtin_amdgcn_mfma_f32_32x32x16_bf16(af[rt], bfr[g], acc[g][rt], 0, 0, 0);
            }
            const float ba = b_a[c], bx = b_x[c]; const float lm = lam[c];
            const float sp = (lm > 15.f) ? __expf(-lm) : log1pf(__expf(-lm));
            float carry = FINAL ? hin[c] : 0.f, atot = 1.f;
#pragma unroll
            for (int rt = 0; rt < 2; ++rt) {
#pragma unroll
                for (int g4 = 0; g4 < 4; ++g4) {
                    float av[4], uv[4]; float Ag = 1.f, Hg = 0.f;
#pragma unroll
                    for (int j = 0; j < 4; ++j) { const int reg = g4 * 4 + j; const int tl = rt * 32 + 8 * g4 + 4 * hh + j;
                        const float r = sigmoidf_(acc[0][rt][reg] + ba), ig = sigmoidf_(acc[1][rt][reg] + bx);
                        const float a = __builtin_amdgcn_exp2f(-11.541560327111707f * r * sp); const float mult = __builtin_amdgcn_sqrtf(fmaxf((1.0f - a) * (1.0f + a), 0.f));
                        const float xc = bf2f(xcL[tl * XCL_STRIDE + c]);
                        av[j] = a; uv[j] = mult * ig * xc; Ag = a * Ag; Hg = a * Hg + uv[j]; }
                    const f32x2 As = lds_swap(Ag), Hs = lds_swap(Hg);
                    const float mid = As[0] * carry + Hs[0];
                    if constexpr (FINAL) {
                        float s = hh ? mid : carry;
#pragma unroll
                        for (int j = 0; j < 4; ++j) { const int tl = rt * 32 + 8 * g4 + 4 * hh + j; s = av[j] * s + uv[j];
                            const float gv = bf2f(gL[tl * XCL_STRIDE + c]); gL[tl * XCL_STRIDE + c] = (bf16_t)f2bf(s * gelu_tanh(gv)); }
                    }
                    carry = As[1] * mid + Hs[1]; atot = atot * As[0] * As[1];
                }
            }
            if constexpr (!FINAL) { if (hh == 0) SAH[((size_t)b * 512 + c) * 128 + ch] = (f32x2){atot, carry}; }
        }
    }
    __syncthreads();
    if constexpr (FINAL) {
#pragma unroll
        for (int i = 0; i < 8; ++i) { const int tl = tg * 8 + i; const u32x4 v = *(const LAS u32x4*)(gL + tl * XCL_STRIDE + c8 * 8); *(u32x4*)(ycat + (row0 + tl) * D + 512 + c8 * 8) = v; }
        __syncthreads();
    }
}

constexpr int LDS_RI = 0;
constexpr int LDS_HIST = 4096;
DI void ln_router_phase(Frame& F, int layer, const bf16_t* src) {
    bf16_t* xb = (bf16_t*)(F.ws + WS_XB); unsigned char* x8 = F.ws + WS_X8;
    const float* gam = F.in[layer ? 30 : 11]; const float* bet = F.in[layer ? 31 : 12];
    const float* rw = (const float*)(F.ws + WS_SMALL + SM_RWT) + (size_t)layer * 36 * 1024;
    const float* bg = F.in[layer ? 33 : 14]; const float* be = F.in[layer ? 35 : 16];
    unsigned* cnt = (unsigned*)(F.ws + WS_CTL) + CW_CNT + layer * 32;
    unsigned* list = (unsigned*)(F.ws + WS_LIST); float* wslot = (float*)(F.ws + WS_WSLOT); unsigned* posloc = (unsigned*)(F.ws + WS_POSLOC);
    LAS int* e0s = (LAS int*)(F.lds + LDS_RI); LAS int* e1s = e0s + 128; LAS float* w0s = (LAS float*)(e1s + 128); LAS float* w1s = w0s + 128;
    LAS int* hist = (LAS int*)(F.lds + LDS_HIST); LAS int* base = hist + 32;
    const int lane = F.lane;
    f32x4 gv[4], bv[4];
#pragma unroll
    for (int j = 0; j < 4; ++j) { gv[j] = ((const f32x4*)gam)[lane + 64 * j]; bv[j] = ((const f32x4*)bet)[lane + 64 * j]; }
    for (int chunk = F.vcu; chunk < T / 128; chunk += F.G) {
        if (F.tid < 32) hist[F.tid] = 0;
        __syncthreads();
        for (int rr = F.wave; rr < 128; rr += NWAVES) {
            const size_t row = (size_t)chunk * 128 + rr;
            const u32x2* xr = (const u32x2*)(src + row * D) + lane;
            f32x4 v[4]; float s = 0.f;
#pragma unroll
            for (int j = 0; j < 4; ++j) { const u32x2 q = xr[64 * j]; v[j] = (f32x4){bflo(q.x), bfhi(q.x), bflo(q.y), bfhi(q.y)}; s += (v[j].x + v[j].y) + (v[j].z + v[j].w); }
            const float mean = wave_sum(s) * (1.f / D); float s2 = 0.f;
#pragma unroll
            for (int j = 0; j < 4; ++j) { v[j] = v[j] - mean; s2 += (v[j].x * v[j].x + v[j].y * v[j].y) + (v[j].z * v[j].z + v[j].w * v[j].w); }
            const float rstd = 1.f / sqrtf(wave_sum(s2) * (1.f / D) + LN_EPS);
            u32x2* ob = (u32x2*)(xb + row * D) + lane;
#pragma unroll
            for (int j = 0; j < 4; ++j) { v[j] = v[j] * rstd * gv[j] + bv[j]; ob[64 * j] = (u32x2){pk2(v[j].x, v[j].y), pk2(v[j].z, v[j].w)};
                int w8 = 0; w8 = __builtin_amdgcn_cvt_pk_fp8_f32(v[j].x, v[j].y, w8, false); w8 = __builtin_amdgcn_cvt_pk_fp8_f32(v[j].z, v[j].w, w8, true); ((unsigned*)(x8 + row * D))[lane + 64 * j] = (unsigned)w8; }
            float gl[4];
#pragma unroll
            for (int o = 0; o < 4; ++o) { const f32x4* wr_ = (const f32x4*)(rw + o * 1024) + lane; float a = 0.f;
#pragma unroll
                for (int j = 0; j < 4; ++j) { const f32x4 w = wr_[64 * j]; a += (v[j].x * w.x + v[j].y * w.y) + (v[j].z * w.z + v[j].w * w.w); }
                gl[o] = wave_sum(a) + bg[o]; }
            float g0 = gl[0]; int gs = 0;
#pragma unroll
            for (int o = 1; o < 4; ++o) if (gl[o] > g0) { g0 = gl[o]; gs = o; }
            float gsum = 0.f;
#pragma unroll
            for (int o = 0; o < 4; ++o) gsum += __expf(gl[o] - g0);
            const float pgrp = 1.0f / gsum;
            gs = __builtin_amdgcn_readfirstlane(gs);
            float le[8];
#pragma unroll
            for (int hf = 0; hf < 2; ++hf) {
#pragma unroll
                for (int oo = 0; oo < 4; ++oo) { const int o = hf * 4 + oo; const f32x4* wr_ = (const f32x4*)(rw + (4 + gs * 8 + o) * 1024) + lane; float a = 0.f;
#pragma unroll
                    for (int j = 0; j < 4; ++j) { const f32x4 w = wr_[64 * j]; a += (v[j].x * w.x + v[j].y * w.y) + (v[j].z * w.z + v[j].w * w.w); }
                    le[o] = wave_sum(a) + be[gs * 8 + o]; }
                asm volatile("" ::: "memory"); }
            float m0 = le[0]; int i0 = 0;
#pragma unroll
            for (int o = 1; o < 8; ++o) if (le[o] > m0) { m0 = le[o]; i0 = o; }
            float m1 = -3.0e38f; int i1 = 0;
#pragma unroll
            for (int o = 0; o < 8; ++o) if (o != i0 && le[o] > m1) { m1 = le[o]; i1 = o; }
            const float e1 = __expf(m1 - m0); const float w0 = pgrp / (1.0f + e1), w1 = pgrp * e1 / (1.0f + e1);
            if (lane == 0) { e0s[rr] = gs * 8 + i0; e1s[rr] = gs * 8 + i1; w0s[rr] = w0; w1s[rr] = w1; }
        }
        __syncthreads();
        int myrank = 0, mye = 0;
        if (F.tid < 256) { const int rr = F.tid >> 1, k = F.tid & 1; mye = k ? e1s[rr] : e0s[rr]; myrank = atomicAdd((int*)&hist[mye], 1); }
        __syncthreads();
        if (F.tid < 32) { const int h = hist[F.tid]; base[F.tid] = h ? (int)atomicAdd(&cnt[F.tid], (unsigned)h) : 0; }
        __syncthreads();
        if (F.tid < 256) { const int rr = F.tid >> 1, k = F.tid & 1; const unsigned slot = (unsigned)((chunk * 128 + rr) * 2 + k);
            const int li = base[mye] + myrank; list[(size_t)mye * T + li] = slot; wslot[slot] = k ? w1s[rr] : w0s[rr]; posloc[slot] = ((unsigned)mye << 20) | (unsigned)li; }
        __syncthreads();
    }
}

DI MoeTab moe_tables(Frame& F, int layer) {
    LAS int* tb = (LAS int*)(F.lds + LDS_MISC); LAS int* cn = tb + 64; LAS int* nt = cn + 64;
    const unsigned* cnt = (const unsigned*)(F.ws + WS_CTL) + CW_CNT + layer * 32;
    if (F.tid < 32) cn[F.tid] = (int)__hip_atomic_load(cnt + F.tid, __ATOMIC_RELAXED, __HIP_MEMORY_SCOPE_AGENT);
    __syncthreads();
    if (F.tid == 0) { int acc = 0; for (int e = 0; e < 32; ++e) { tb[e] = acc; acc += (cn[e] + 255) >> 8; } tb[32] = acc; nt[0] = acc; }
    __syncthreads();
    MoeTab t; t.tbase = tb; t.cnt = cn; t.ntiles = nt[0]; return t;
}

template <bool FINAL_F32>
DI void ln2_phase(Frame& F, int layer, const MoeTab& tab, bf16_t* dst16, float* dst32, unsigned char* dst8) {
    const bf16_t* x1 = (const bf16_t*)(F.ws + WS_XB); const bf16_t* Y = (const bf16_t*)(F.ws + WS_Y);
    const float* wslot = (const float*)(F.ws + WS_WSLOT); const unsigned* posloc = (const unsigned*)(F.ws + WS_POSLOC);
    const float* gam = F.in[layer ? 39 : 20]; const float* bet = F.in[layer ? 40 : 21];
    const int lane = F.lane; const int gw = F.vcu * NWAVES + F.wave, NGW = F.G * NWAVES;
    f32x4 gv[4], bv[4];
#pragma unroll
    for (int j = 0; j < 4; ++j) { gv[j] = ((const f32x4*)gam)[lane + 64 * j]; bv[j] = ((const f32x4*)bet)[lane + 64 * j]; }
#pragma unroll 2
    for (int row = gw; row < T; row += NGW) {
        const unsigned pl0 = posloc[2 * row], pl1 = posloc[2 * row + 1]; const float w0 = wslot[2 * row], w1 = wslot[2 * row + 1];
        const size_t h0 = (size_t)tab.tbase[pl0 >> 20] * 256 + (pl0 & 0xfffffu), h1 = (size_t)tab.tbase[pl1 >> 20] * 256 + (pl1 & 0xfffffu);
        const u32x2* xr = (const u32x2*)(x1 + (size_t)row * D) + lane;
        const u32x2* y0 = (const u32x2*)(Y + h0 * D) + lane; const u32x2* y1 = (const u32x2*)(Y + h1 * D) + lane;
        f32x4 v[4]; float s = 0.f;
#pragma unroll
        for (int j = 0; j < 4; ++j) { const u32x2 a = y0[64 * j], c = y1[64 * j], q = xr[64 * j];
            v[j].x = bflo(q.x) * DN_ALPHA + (w0 * bflo(a.x) + w1 * bflo(c.x)); v[j].y = bfhi(q.x) * DN_ALPHA + (w0 * bfhi(a.x) + w1 * bfhi(c.x));
            v[j].z = bflo(q.y) * DN_ALPHA + (w0 * bflo(a.y) + w1 * bflo(c.y)); v[j].w = bfhi(q.y) * DN_ALPHA + (w0 * bfhi(a.y) + w1 * bfhi(c.y));
            s += (v[j].x + v[j].y) + (v[j].z + v[j].w); }
        const float mean = wave_sum(s) * (1.f / D); float s2 = 0.f;
#pragma unroll
        for (int j = 0; j < 4; ++j) { v[j] = v[j] - mean; s2 += (v[j].x * v[j].x + v[j].y * v[j].y) + (v[j].z * v[j].z + v[j].w * v[j].w); }
        const float rstd = 1.f / sqrtf(wave_sum(s2) * (1.f / D) + LN_EPS);
#pragma unroll
        for (int j = 0; j < 4; ++j) { v[j] = v[j] * rstd * gv[j] + bv[j];
            if (FINAL_F32) ((f32x4*)(dst32 + (size_t)row * D))[lane + 64 * j] = v[j];
            else { ((u32x2*)(dst16 + (size_t)row * D))[lane + 64 * j] = (u32x2){pk2(v[j].x, v[j].y), pk2(v[j].z, v[j].w)};
                int w8 = 0; w8 = __builtin_amdgcn_cvt_pk_fp8_f32(v[j].x, v[j].y, w8, false); w8 = __builtin_amdgcn_cvt_pk_fp8_f32(v[j].z, v[j].w, w8, true); ((unsigned*)(dst8 + (size_t)row * D))[lane + 64 * j] = (unsigned)w8; } }
    }
}

constexpr float QSCALE = 0.125f * 1.4426950408889634f;
struct GemmL1In {
    static constexpr bool AUNI = true;
    static constexpr bool FP8 = true;
    static constexpr bool PERM = false;
    const char* A; int K; unsigned lda2, ldb2; const char* Bt; pg8::TileOrder ord;
    bf16_t* Q; unsigned char* KV; float* gates; const float* cosT; const float* sinT;
    DI bool next(int i, GU& u) const { return ord.next(i, u); }
    DI unsigned a_row_off(const GU& u, int r) const { return (unsigned)(u.pm * 256 + r) * lda2; }
    DI size_t a_base(const GU& u) const { return (size_t)(u.pm * 256) * lda2; }
    DI const char* b_tile(const GU& u) const { return Bt + (size_t)u.pn * 256 * ldb2; }
    DI void epi(const f32x4 (&acc)[2][2][4][2], const GU& u, int wr, int wc, int fr, int fq) const {
        const int pn = u.pn;
#pragma unroll
        for (int ai = 0; ai < 2; ++ai)
#pragma unroll
            for (int m = 0; m < 4; ++m) {
                const int row = u.pm * 256 + ai * 128 + wr * 64 + m * 16 + fr; const int pos = row & (SEQ - 1), b = row >> 13;
                if (pn == 10) {
                    if (wc < 2) {
#pragma unroll
                        for (int n = 0; n < 2; ++n) { if (n == 1 && wc == 1) continue; const f32x4 v = acc[ai][0][m][n] * 0.03125f;
                            f32x4 o; o.x = sigmoidf_(v.x); o.y = sigmoidf_(v.y); o.z = sigmoidf_(v.z); o.w = sigmoidf_(v.w);
                            *(f32x4*)(gates + (size_t)row * 48 + 32 * wc + 16 * n + 4 * fq) = o; }
                    }
                } else if (pn < 5 || pn == 6 || pn == 8) {
                    const int a = wc & 1, i0 = 16 * a + 4 * fq;
                    const f32x4 c4 = *(const f32x4*)(cosT + pos * 32 + i0), s4 = *(const f32x4*)(sinT + pos * 32 + i0);
#pragma unroll
                    for (int bj = 0; bj < 2; ++bj) { const f32x4 x1 = acc[ai][bj][m][0] * 0.03125f, x2 = acc[ai][bj][m][1] * 0.03125f;
                        f32x4 o1 = x1 * c4 - x2 * s4, o2 = x2 * c4 + x1 * s4;
                        const int hl = bj * 2 + (wc >> 1); bf16_t* dst;
                        if (pn < 4) { o1 = o1 * QSCALE; o2 = o2 * QSCALE; dst = Q + ((size_t)row * 16 + pn * 4 + hl) * 64; }
                        else dst = (bf16_t*)(KV + (size_t)(pn - 4) * KV_STRIDE) + ((size_t)(b * 4 + hl) * SEQ + pos) * 64;
                        *(u32x2*)(dst + i0) = (u32x2){cvt_pk_bf16(o1.x, o1.y), cvt_pk_bf16(o1.z, o1.w)};
                        *(u32x2*)(dst + 32 + i0) = (u32x2){cvt_pk_bf16(o2.x, o2.y), cvt_pk_bf16(o2.z, o2.w)}; }
                } else {
#pragma unroll
                    for (int bj = 0; bj < 2; ++bj) { const int gg = bj * 2 + (wc >> 1);
                        bf16_t* dst = (bf16_t*)(KV + (size_t)(pn - 4) * KV_STRIDE) + ((size_t)(b * 4 + gg) * SEQ + pos) * 64 + 32 * (wc & 1) + 4 * fq;
#pragma unroll
                        for (int n = 0; n < 2; ++n) { const f32x4 v = acc[ai][bj][m][n] * 0.03125f; *(u32x2*)(dst + 16 * n) = (u32x2){cvt_pk_bf16(v.x, v.y), cvt_pk_bf16(v.z, v.w)}; } }
                }
            }
    }
};
struct GemmCmp1 {
    static constexpr bool AUNI = true;
    static constexpr bool FP8 = false;
    static constexpr bool PERM = true;
    const char* A; int K; unsigned lda2, ldb2; const char* Bt; int G, c;
    const float* cbias; bf16_t* Hd;
    DI bool next(int i, GU& u) const { const int L = i * G + c; if (L >= 64) return false; u.e = L >> 5; u.pm = L & 31; u.pn = 0; return true; }
    DI unsigned a_row_off(const GU& u, int r) const { return (unsigned)u.e * (unsigned)KV_STRIDE + (unsigned)(u.pm * 256 + r) * lda2; }
    DI size_t a_base(const GU& u) const { return (size_t)u.e * KV_STRIDE + (size_t)(u.pm * 256) * lda2; }
    DI const char* b_tile(const GU& u) const { return Bt + (size_t)u.e * 256 * ldb2; }
    DI void epi(const f32x4 (&acc)[2][2][4][2], const GU& u, int wr, int wc, int fr, int fq) const {
        const int row0 = u.pm * 256 + wr * 64 + fr, col0 = wc * 32 + 8 * fq;
        f32x4 bv[2][2];
#pragma unroll
        for (int bj = 0; bj < 2; ++bj)
#pragma unroll
            for (int n = 0; n < 2; ++n) bv[bj][n] = *(const f32x4*)(cbias + u.e * 256 + col0 + bj * 128 + 4 * n);
#pragma unroll
        for (int ai = 0; ai < 2; ++ai)
#pragma unroll
            for (int m = 0; m < 4; ++m) { bf16_t* rowp = Hd + ((size_t)u.e * 8192 + row0 + ai * 128 + m * 16) * 256 + col0;
#pragma unroll
                for (int bj = 0; bj < 2; ++bj) { const f32x4 v0 = acc[ai][bj][m][0] + bv[bj][0], v1 = acc[ai][bj][m][1] + bv[bj][1];
                    u32x4 w; w.x = cvt_pk_bf16(gelu_tanh(v0[0]), gelu_tanh(v0[1])); w.y = cvt_pk_bf16(gelu_tanh(v0[2]), gelu_tanh(v0[3]));
                    w.z = cvt_pk_bf16(gelu_tanh(v1[0]), gelu_tanh(v1[1])); w.w = cvt_pk_bf16(gelu_tanh(v1[2]), gelu_tanh(v1[3]));
                    *(u32x4*)(rowp + bj * 128) = w; } }
    }
};
struct GemmCmp2 {
    static constexpr bool AUNI = true;
    static constexpr bool FP8 = false;
    static constexpr bool PERM = true;
    const char* A; int K; unsigned lda2, ldb2; const char* Bt; int G, c;
    bf16_t* O;
    DI bool next(int i, GU& u) const { const int L = i * G + c; if (L >= 64) return false; u.e = L >> 5; u.pm = L & 31; u.pn = 0; return true; }
    DI unsigned a_row_off(const GU& u, int r) const { return (unsigned)(u.e * 8192 + u.pm * 256 + r) * lda2; }
    DI size_t a_base(const GU& u) const { return (size_t)(u.e * 8192 + u.pm * 256) * lda2; }
    DI const char* b_tile(const GU& u) const { return Bt + (size_t)u.e * 256 * ldb2; }
    DI void epi(const f32x4 (&acc)[2][2][4][2], const GU& u, int wr, int wc, int fr, int fq) const {
        if (wc >= 2) return;
        const int row0 = u.pm * 256 + wr * 64 + fr, col0 = wc * 32 + 8 * fq;
#pragma unroll
        for (int ai = 0; ai < 2; ++ai)
#pragma unroll
            for (int m = 0; m < 4; ++m) { bf16_t* rowp = O + ((size_t)u.e * 8192 + row0 + ai * 128 + m * 16) * 64 + col0;
                const f32x4 v0 = acc[ai][0][m][0], v1 = acc[ai][0][m][1];
                u32x4 w; w.x = cvt_pk_bf16(v0[0], v0[1]); w.y = cvt_pk_bf16(v0[2], v0[3]); w.z = cvt_pk_bf16(v1[0], v1[1]); w.w = cvt_pk_bf16(v1[2], v1[3]);
                *(u32x4*)rowp = w; }
    }
};

constexpr int AL_KB = 0, AL_VB = 16384, AL_FAC = 40960, AL_SELM = 41984, AL_IMPS = 43008, IMP_STRIDE = 129, AL_IMPC = AL_IMPS + 64 * IMP_STRIDE * 4, AL_OT = AL_IMPS  , OT_STRIDE = 68;
static_assert(AL_OT + 8 * 32 * OT_STRIDE * 4 <= LDS_RING, "attention LDS map");
typedef short v4i16_t __attribute__((ext_vector_type(4)));
typedef __bf16 bf16x2_t __attribute__((ext_vector_type(2)));
DI unsigned cvtpk_s(float lo, float hi) { f32x2 v = {lo, hi}; bf16x2_t b = __builtin_convertvector(v, bf16x2_t); return __builtin_bit_cast(unsigned, b); }
DI int crow(int r, int hi) { return (r & 3) + 8 * (r >> 2) + 4 * hi; }
#define NEGINF (-__builtin_inff())

struct AttnW {
    int tid, lane, wave, r32, hh;
    LAS unsigned char* lds; LAS float* fac; LAS float* ot;
};
DI void at_load(const bf16_t* slab, int tile, int tid, u32x4& r) { r = *(const u32x4*)(slab + (size_t)tile * 4096 + tid * 8); }
DI void at_store_k(LAS unsigned char* kb, int tid, const u32x4& r) { const int key = tid >> 3, ch = tid & 7; *(LAS u32x4*)(kb + key * 128 + ((ch ^ ((key >> 1) & 7)) << 4)) = r; }
DI void at_store_v(LAS unsigned char* vb, int tid, const u32x4& r) { *(LAS u32x4*)(vb + tid * 16) = r; }
DI void at_qk(const LAS unsigned char* kb, const bf16x8 (&qf)[4], float cinit, int r32, int hh, f32x16& p0, f32x16& p1) {
#pragma unroll
    for (int i = 0; i < 16; ++i) { p0[i] = cinit; p1[i] = cinit; }
    const int sw = (r32 >> 1) & 7;
#pragma unroll
    for (int d0 = 0; d0 < 4; ++d0) {
        const bf16x8 a0 = *(const LAS bf16x8*)(kb + r32 * 128 + (((2 * d0 + hh) ^ sw) << 4));
        const bf16x8 a1 = *(const LAS bf16x8*)(kb + (32 + r32) * 128 + (((2 * d0 + hh) ^ sw) << 4));
        p0 = __builtin_amdgcn_mfma_f32_32x32x16_bf16(a0, qf[d0], p0, 0, 0, 0);
        p1 = __builtin_amdgcn_mfma_f32_32x32x16_bf16(a1, qf[d0], p1, 0, 0, 0);
    }
}
DI void at_pack(const f32x16& p0, const f32x16& p1, u32x4 (&pw)[4]) {
#pragma unroll
    for (int s = 0; s < 2; ++s) {
        pw[s] = (u32x4){cvtpk_s(p0[8 * s], p0[8 * s + 1]), cvtpk_s(p0[8 * s + 2], p0[8 * s + 3]), cvtpk_s(p0[8 * s + 4], p0[8 * s + 5]), cvtpk_s(p0[8 * s + 6], p0[8 * s + 7])};
        pw[2 + s] = (u32x4){cvtpk_s(p1[8 * s], p1[8 * s + 1]), cvtpk_s(p1[8 * s + 2], p1[8 * s + 3]), cvtpk_s(p1[8 * s + 4], p1[8 * s + 5]), cvtpk_s(p1[8 * s + 6], p1[8 * s + 7])};
    }
}
DI void at_pv(const LAS unsigned char* vb, const u32x4 (&pw)[4], f32x16 (&o)[2], int lane) {
    const int hh = lane >> 5;
    const LAS unsigned char* vp = vb + (4 * hh + ((lane & 15) >> 2)) * 128 + (16 * ((lane >> 4) & 1) + 4 * (lane & 3)) * 2;
#pragma unroll
    for (int s = 0; s < 4; ++s)
#pragma unroll
        for (int d0 = 0; d0 < 2; ++d0) {
            const s16x4 lo = __builtin_bit_cast(s16x4, __builtin_amdgcn_ds_read_tr16_b64_v4i16((LAS v4i16_t*)(vp + s * 2048 + d0 * 64)));
            const s16x4 hi = __builtin_bit_cast(s16x4, __builtin_amdgcn_ds_read_tr16_b64_v4i16((LAS v4i16_t*)(vp + s * 2048 + d0 * 64 + 1024)));
            const bf16x8 vf = (bf16x8){lo[0], lo[1], lo[2], lo[3], hi[0], hi[1], hi[2], hi[3]};
            o[d0] = __builtin_amdgcn_mfma_f32_32x32x16_bf16(__builtin_bit_cast(bf16x8, pw[s]), vf, o[d0], 0, 0, 0);
        }
}
DI float at_rowmax(const f32x16& p0, const f32x16& p1) {
    float a = fmaxf(fmaxf(p0[0], p1[0]), p0[1]), c = fmaxf(fmaxf(p1[1], p0[2]), p1[2]);
#pragma unroll
    for (int r = 3; r < 15; r += 2) { a = fmaxf(fmaxf(a, p0[r]), p1[r]); c = fmaxf(fmaxf(c, p0[r + 1]), p1[r + 1]); }
    a = fmaxf(fmaxf(a, p0[15]), p1[15]); a = fmaxf(a, c);
    const f32x2 s = lds_swap(a); return fmaxf(s[0], s[1]);
}
DI void at_scale_rows(f32x16 (&o)[2], float f, const AttnW& W) {
    if (W.hh == 0) W.fac[W.r32] = f;
#pragma unroll
    for (int g4 = 0; g4 < 4; ++g4) { const f32x4 fv = *(const LAS f32x4*)(W.fac + 8 * g4 + 4 * W.hh);
#pragma unroll
        for (int j = 0; j < 4; ++j) { o[0][4 * g4 + j] *= fv[j]; o[1][4 * g4 + j] *= fv[j]; } }
}
template <bool FIRST> DI void at_axpy_rows(const f32x16 (&o)[2], float f, const AttnW& W) {
    if (W.hh == 0) W.fac[W.r32] = f;
#pragma unroll
    for (int g4 = 0; g4 < 4; ++g4) { const f32x4 fv = *(const LAS f32x4*)(W.fac + 8 * g4 + 4 * W.hh);
#pragma unroll
        for (int j = 0; j < 4; ++j) { LAS float* d = W.ot + (8 * g4 + 4 * W.hh + j) * OT_STRIDE + W.r32;
            if (FIRST) { d[0] = fv[j] * o[0][4 * g4 + j]; d[32] = fv[j] * o[1][4 * g4 + j]; }
            else { d[0] += fv[j] * o[0][4 * g4 + j]; d[32] += fv[j] * o[1][4 * g4 + j]; } } }
}
template <bool GT> DI void at_mask(f32x16& p0, f32x16& p1, int lim, int hh) {
#pragma unroll
    for (int r = 0; r < 16; ++r) { const int kv = crow(r, hh);
        if (GT) { if (kv > lim) p0[r] = NEGINF; if (kv + 32 > lim) p1[r] = NEGINF; }
        else { if (kv <= lim) p0[r] = NEGINF; if (kv + 32 <= lim) p1[r] = NEGINF; } }
}
constexpr float AT_THR = 8.0f;
struct Flash { float mu, l; bool started; f32x16 o[2]; };
DI void flash_init(Flash& s) { s.mu = 0.f; s.l = 0.f; s.started = false;
#pragma unroll
    for (int i = 0; i < 16; ++i) { s.o[0][i] = 0.f; s.o[1][i] = 0.f; } }
template <bool WITH_O> DI void flash_update(Flash& s, f32x16& p0, f32x16& p1, const AttnW& W) {
    const float mx = at_rowmax(p0, p1);
    const bool fin = mx > NEGINF;
    const bool need = s.started ? (mx > AT_THR) : (fin && fabsf(mx) > AT_THR);
    if (__any(need)) {
        const float delta = need ? mx : 0.f;
        const float f = s.started ? __builtin_amdgcn_exp2f(-delta) : 1.0f;
        s.mu += delta; s.l *= f;
        if (WITH_O) at_scale_rows(s.o, f, W);
#pragma unroll
        for (int r = 0; r < 16; ++r) { p0[r] -= delta; p1[r] -= delta; }
    }
    s.started = s.started || fin;
    float sum0 = 0.f, sum1 = 0.f;
#pragma unroll
    for (int r = 0; r < 16; ++r) { p0[r] = __builtin_amdgcn_exp2f(p0[r]); p1[r] = __builtin_amdgcn_exp2f(p1[r]); sum0 += p0[r]; sum1 += p1[r]; }
    s.l += sum0 + sum1;
}

template <int VAR>
DI void attn_unit(Frame& F, int bg, int qblk, int& it, bf16_t* Ob, u32x4& kr, const bf16_t* next_kcmp) {
    AttnW W; W.tid = F.tid; W.lane = F.lane; W.wave = F.wave; W.r32 = F.lane & 31; W.hh = F.lane >> 5; W.lds = F.lds; W.fac = (LAS float*)(F.lds + AL_FAC) + F.wave * 32; W.ot = (LAS float*)(F.lds + AL_OT) + F.wave * 32 * OT_STRIDE;
    const int tid = W.tid, lane = W.lane, wave = W.wave, r32 = W.r32, hh = W.hh;
    const int b = bg >> 2, g = bg & 3;
    unsigned char* ws = F.ws;
    bf16_t* Qb = (bf16_t*)(ws + WS_Q);
    const float* gates = (const float*)(ws + WS_GATES);
    const bf16_t* kcmp = (const bf16_t*)(ws + WS_CMPO) + (size_t)bg * 512 * 64; const bf16_t* vcmp = kcmp + (size_t)8192 * 64;
    const bf16_t* ksl = (const bf16_t*)(ws + WS_KV + 2 * KV_STRIDE) + (size_t)bg * SEQ * 64; const bf16_t* vsl = (const bf16_t*)(ws + WS_KV + 3 * KV_STRIDE) + (size_t)bg * SEQ * 64;
    const bf16_t* kwl = (const bf16_t*)(ws + WS_KV + 4 * KV_STRIDE) + (size_t)bg * SEQ * 64; const bf16_t* vwl = (const bf16_t*)(ws + WS_KV + 5 * KV_STRIDE) + (size_t)bg * SEQ * 64;
    LAS unsigned char* KB = F.lds + AL_KB; LAS unsigned char* VB = F.lds + AL_VB;
    LAS unsigned* selm = (LAS unsigned*)(F.lds + AL_SELM); LAS float* impS = (LAS float*)(F.lds + AL_IMPS); LAS float* impC = (LAS float*)(F.lds + AL_IMPC);
    const int tl = wave * 8 + (r32 >> 2), hd = r32 & 3, t = qblk * 64 + tl;
    const size_t qrow = ((size_t)(b * SEQ + t) * 16 + g * 4 + hd) * 64;
    bf16x8 qf[4];
#pragma unroll
    for (int d0 = 0; d0 < 4; ++d0) qf[d0] = *(const bf16x8*)(Qb + qrow + d0 * 16 + hh * 8);
    const float* gp = gates + (size_t)(b * SEQ + t) * 48 + (g * 4 + hd) * 3;
    const bool need_topk = (qblk >= 16) && !(VAR & 128);
    f32x16 p0, p1; u32x4 vr, pw[4];
    const bool rotB = wave >= 4;
    int vs = 0;
#define V_NEXT() do { vs = (vs == 2) ? 0 : vs + 1; } while (0)

    const int nct = (4 * qblk + 2) / 64 + 1;
    const int cmax = (t - 31) >> 4;
    Flash fc; flash_init(fc);
    const int cfull = 4 * qblk - 2;
    for (int ti = 0; ti < nct; ++ti, ++it) {
        LAS unsigned char* kb = KB + (it & 1) * 8192;
        at_store_k(kb, tid, kr); if (!(VAR & 2)) __syncthreads();
        if (ti + 1 < nct) at_load(kcmp, ti + 1, tid, kr); else { at_load(kcmp, 0, tid, kr); at_load(vcmp, 0, tid, vr); }
        at_qk(kb, qf, -fc.mu, r32, hh, p0, p1);
        if (64 * ti + 63 > cfull) at_mask<true>(p0, p1, cmax - 64 * ti, hh);
        flash_update<false>(fc, p0, p1, W);
    }
    { const f32x2 ls = lds_swap(fc.l); fc.l = ls[0] + ls[1]; }
    const float inv_lc = 1.0f / fmaxf(fc.l, 1e-30f);
    if (need_topk) { for (int i = tid; i < 64 * IMP_STRIDE; i += NTHR) { impS[i] = 0.f; impC[i] = 0.f; } }
    for (int ti = 0; ti < nct; ++ti, ++it) {
        LAS unsigned char* kb = KB + (it & 1) * 8192; LAS unsigned char* vb = VB + vs * 8192; V_NEXT();
        at_store_k(kb, tid, kr); at_store_v(vb, tid, vr); if (!(VAR & 2)) __syncthreads();
        if (ti + 1 < nct) { at_load(kcmp, ti + 1, tid, kr); at_load(vcmp, ti + 1, tid, vr); } else { at_load(ksl, 0, tid, kr); at_load(vsl, 0, tid, vr); }
        at_qk(kb, qf, -fc.mu, r32, hh, p0, p1);
        if (64 * ti + 63 > cfull) at_mask<true>(p0, p1, cmax - 64 * ti, hh);
#pragma unroll
        for (int r = 0; r < 16; ++r) { p0[r] = __builtin_amdgcn_exp2f(p0[r]); p1[r] = __builtin_amdgcn_exp2f(p1[r]); }
        at_pack(p0, p1, pw);
        at_pv(vb, pw, fc.o, lane);
        if (need_topk) {
#pragma unroll
            for (int half = 0; half < 2; ++half)
#pragma unroll
                for (int g4 = 0; g4 < 4; ++g4) {
                    const f32x16& p = half ? p1 : p0;
                    float s4 = ((p[4 * g4] + p[4 * g4 + 1]) + (p[4 * g4 + 2] + p[4 * g4 + 3])) * inv_lc, c3 = p[4 * g4 + 3] * inv_lc;
                    s4 += quad_xor<0xB1>(s4); c3 += quad_xor<0xB1>(c3); s4 += quad_xor<0x4E>(s4); c3 += quad_xor<0x4E>(c3);
                    const int j = 16 * ti + 8 * half + 2 * g4 + hh;
                    if (hd == 0) { impS[tl * IMP_STRIDE + j] = s4; impC[tl * IMP_STRIDE + j] = c3; }
                }
        }
    }
    __syncthreads();
    if (need_topk) {
        #pragma unroll 1
        for (int rnd = 0; rnd < 2; ++rnd) {
        unsigned k0[4], k1[4], prefix[4];
#pragma unroll
        for (int tt = 0; tt < 4; ++tt) {
            const int tk = wave * 8 + rnd * 4 + tt; const LAS float* S = impS + tk * IMP_STRIDE; const LAS float* C = impC + tk * IMP_STRIDE;
            const int j0 = lane, j1 = 64 + lane;
            const float v0 = S[j0] + (j0 > 0 ? C[j0 - 1] : 0.f), v1 = S[j1] + C[j1 - 1];
            const bool c0 = (j0 >= 1) && (j0 <= qblk - 2), c1 = (j1 <= qblk - 2);
            k0[tt] = c0 ? ((__float_as_uint(v0) + 0x100u) & 0xffffff00u) : 0u; k1[tt] = c1 ? ((__float_as_uint(v1) + 0x100u) & 0xffffff00u) : 0u; prefix[tt] = 0u;
        }
#pragma unroll 1
        for (int bit = 30; bit >= 8; --bit) {
            unsigned long long bl0[4], bl1[4];
#pragma unroll
            for (int tt = 0; tt < 4; ++tt) { const unsigned trial = prefix[tt] | (1u << bit); bl0[tt] = __ballot(k0[tt] >= trial); bl1[tt] = __ballot(k1[tt] >= trial); }
#pragma unroll
            for (int tt = 0; tt < 4; ++tt) { asm volatile("" : "+s"(bl0[tt]), "+s"(bl1[tt])); }
#pragma unroll
            for (int tt = 0; tt < 4; ++tt) { const int cnt = __popcll(bl0[tt]) + __popcll(bl1[tt]); prefix[tt] = cnt >= 13 ? (prefix[tt] | (1u << bit)) : prefix[tt]; }
        }
#pragma unroll
        for (int tt = 0; tt < 4; ++tt) {
            const int tk = wave * 8 + rnd * 4 + tt; const int j0 = lane, j1 = 64 + lane; const unsigned pf = prefix[tt];
            const int G = __popcll(__ballot(k0[tt] > pf)) + __popcll(__ballot(k1[tt] > pf)); const int need = 13 - G;
            const unsigned long long e0 = __ballot(k0[tt] == pf), e1 = __ballot(k1[tt] == pf);
            const unsigned long long lt = (1ull << lane) - 1ull;
            const int rk0 = __popcll(e0 & lt), rk1 = __popcll(e0) + __popcll(e1 & lt);
            const bool s0 = (k0[tt] > pf) || (k0[tt] == pf && rk0 < need) || j0 == 0 || j0 == qblk || j0 == qblk - 1;
            const bool s1 = (k1[tt] > pf) || (k1[tt] == pf && rk1 < need) || j1 == qblk || j1 == qblk - 1;
            const unsigned long long m0 = __ballot(s0), m1 = __ballot(s1);
            if (lane == 0) { selm[tk * 4 + 0] = (unsigned)m0; selm[tk * 4 + 1] = (unsigned)(m0 >> 32); selm[tk * 4 + 2] = (unsigned)m1; selm[tk * 4 + 3] = (unsigned)(m1 >> 32); }
        }
        }
    } else {
        if (tid < 256) selm[tid] = 0xffffffffu;
    }
    __syncthreads();
    at_axpy_rows<true>(fc.o, gp[0] * inv_lc, W);

    {
        Flash fs; flash_init(fs);
        const int tbw = qblk >= 8 ? qblk - 8 : 0;
        const LAS unsigned char* vprev = VB; bool first = true;
#define SEL_HEAD() \
            LAS unsigned char* kb = KB + (it & 1) * 8192; LAS unsigned char* vb = VB + vs * 8192; V_NEXT(); \
            at_store_k(kb, tid, kr); at_store_v(vb, tid, vr); if (!(VAR & 2)) __syncthreads(); \
            if (ti < qblk) { if (!(VAR & 1)) { at_load(ksl, ti + 1, tid, kr); at_load(vsl, ti + 1, tid, vr); } } else { at_load(kwl, tbw, tid, kr); at_load(vwl, tbw, tid, vr); } \
            const unsigned wsel = selm[tl * 4 + (ti >> 5)]; \
            const bool selb = ((wsel >> (ti & 31)) & 1u) != 0u;
        if (!rotB) {
            for (int ti = (VAR & 32) ? qblk : 0; ti <= qblk; ++ti, ++it) {
                SEL_HEAD()
                at_qk(kb, qf, selb ? -fs.mu : NEGINF, r32, hh, p0, p1);
                if (ti == qblk) at_mask<true>(p0, p1, tl, hh);
                flash_update<true>(fs, p0, p1, W); at_pack(p0, p1, pw);
                at_pv(vb, pw, fs.o, lane);
            }
        } else {
            for (int ti = (VAR & 32) ? qblk : 0; ti <= qblk; ++ti, ++it) {
                SEL_HEAD()
                if (!first) at_pv(vprev, pw, fs.o, lane);
                at_qk(kb, qf, selb ? -fs.mu : NEGINF, r32, hh, p0, p1);
                if (ti == qblk) at_mask<true>(p0, p1, tl, hh);
                flash_update<true>(fs, p0, p1, W); at_pack(p0, p1, pw);
                vprev = vb; first = false;
            }
            at_pv(vprev, pw, fs.o, lane);
        }
#undef SEL_HEAD
        const f32x2 ls = lds_swap(fs.l); const float l = ls[0] + ls[1];
        at_axpy_rows<false>(fs.o, gp[1] / fmaxf(l, 1e-30f), W);
    }
    {
        Flash fw; flash_init(fw);
        const int tb = qblk >= 8 ? qblk - 8 : 0;
        const LAS unsigned char* vprev = VB; bool first = true;
#define WIN_HEAD() \
            LAS unsigned char* kb = KB + (it & 1) * 8192; LAS unsigned char* vb = VB + vs * 8192; V_NEXT(); \
            at_store_k(kb, tid, kr); at_store_v(vb, tid, vr); if (!(VAR & 2)) __syncthreads(); \
            if (ti < qblk) { if (!(VAR & 1)) { at_load(kwl, ti + 1, tid, kr); at_load(vwl, ti + 1, tid, vr); } } else if (next_kcmp) at_load(next_kcmp, 0, tid, kr);
        if (!rotB) {
            for (int ti = (VAR & 64) ? qblk : tb; ti <= qblk; ++ti, ++it) {
                WIN_HEAD()
                at_qk(kb, qf, -fw.mu, r32, hh, p0, p1);
                if (ti == qblk - 8) at_mask<false>(p0, p1, tl, hh);
                if (ti == qblk) at_mask<true>(p0, p1, tl, hh);
                flash_update<true>(fw, p0, p1, W); at_pack(p0, p1, pw);
                at_pv(vb, pw, fw.o, lane);
            }
        } else {
            for (int ti = (VAR & 64) ? qblk : tb; ti <= qblk; ++ti, ++it) {
                WIN_HEAD()
                if (!first) at_pv(vprev, pw, fw.o, lane);
                at_qk(kb, qf, -fw.mu, r32, hh, p0, p1);
                if (ti == qblk - 8) at_mask<false>(p0, p1, tl, hh);
                if (ti == qblk) at_mask<true>(p0, p1, tl, hh);
                flash_update<true>(fw, p0, p1, W); at_pack(p0, p1, pw);
                vprev = vb; first = false;
            }
            at_pv(vprev, pw, fw.o, lane);
        }
#undef WIN_HEAD
        const f32x2 ls = lds_swap(fw.l); const float l = ls[0] + ls[1];
        at_axpy_rows<false>(fw.o, gp[2] / fmaxf(l, 1e-30f), W);
    }
#undef V_NEXT
    { const int q = lane >> 1, hf = lane & 1; const LAS float* src = W.ot + q * OT_STRIDE + hf * 32; const int tq = qblk * 64 + wave * 8 + (q >> 2);
      unsigned char* dst = (unsigned char*)Ob + ((size_t)(b * SEQ + tq) * 16 + g * 4 + (q & 3)) * 64 + hf * 32;
#pragma unroll
      for (int c = 0; c < 2; ++c) { unsigned w[4];
#pragma unroll
          for (int e = 0; e < 4; ++e) { const f32x4 a = *(const LAS f32x4*)(src + 16 * c + 4 * e); int x = 0; x = __builtin_amdgcn_cvt_pk_fp8_f32(a.x, a.y, x, false); x = __builtin_amdgcn_cvt_pk_fp8_f32(a.z, a.w, x, true); w[e] = (unsigned)x; }
          *(u32x4*)(dst + 16 * c) = (u32x4){w[0], w[1], w[2], w[3]}; } }
    __syncthreads();
}
template <int VAR>
DI void attn_phase(Frame& F, bf16_t* Ob) {
    int it = 0;
    const bf16_t* kcmp_all = (const bf16_t*)(F.ws + WS_CMPO);
    const bool bal = (F.G == 256);
    const int bg0 = F.vcu >> 4, sft = F.vcu & 15;
    const int nun = bal ? 8 : (2048 - F.vcu + F.G - 1) / F.G;
    auto unit_of = [&](int i, int& bg, int& qblk) {
        if (bal) { const int base = (i >> 1) * 32; bg = bg0; qblk = 127 - ((i & 1) ? base + 31 - sft : base + sft); }
        else { const int u = F.vcu + i * F.G; bg = u >> 7; qblk = 127 - (u & 127); } };
    u32x4 kr;
    if (nun > 0) { int bg, qb; unit_of(0, bg, qb); at_load(kcmp_all + (size_t)bg * 512 * 64, 0, F.tid, kr); }
#pragma unroll 1
    for (int i = 0; i < nun; ++i) {
        int bg, qb, nbg = 0, nqb = 0; unit_of(i, bg, qb);
        const bf16_t* nk = nullptr; if (i + 1 < nun) { unit_of(i + 1, nbg, nqb); nk = kcmp_all + (size_t)nbg * 512 * 64; }
        attn_unit<VAR>(F, bg, qb, it, Ob, kr, nk);
    }
}

constexpr int NPHASE = 18;
__global__ void __launch_bounds__(NTHR, 2) fwd_kernel(Args args) {
    extern __shared__ __attribute__((aligned(16))) unsigned char lds_raw[];
    cg::grid_group grid = cg::this_grid();
    Frame F;
    F.lds = (LAS unsigned char*)lds_raw;
    F.tid = threadIdx.x; F.lane = F.tid & 63; F.wave = __builtin_amdgcn_readfirstlane(F.tid >> 6);
    F.G = gridDim.x; { const int bx = blockIdx.x; F.vcu = (F.G % 8 == 0) ? (bx % 8) * (F.G / 8) + bx / 8 : bx; }
    F.in = args.in; F.out = args.out; F.ws = args.ws;
    unsigned char* ws = args.ws;
    const int lo = args.ph_lo, hi = args.ph_hi;
    volatile LAS unsigned* bar_st = (volatile LAS unsigned*)(F.lds + LDS_BYTES - 64);
    if (F.tid < 16) bar_st[F.tid] = 0u;
    __syncthreads();
    XcdBarrier xbar; xbar.bar = (unsigned*)(ws + WS_CTL) + CW_BAR; xbar.x = 0; xbar.st = bar_st;
#ifndef PHMASK
#define PHMASK 0xFFFFFFFFu
#endif
#define IN(k) (((PHMASK >> (k)) & 1u) && lo <= (k) && (k) < hi)
#ifdef TPH_LO
    unsigned long long tp0 = __builtin_amdgcn_s_memrealtime(), tp1 = tp0;
#define STAMP(k) do { if ((k) == TPH_LO - 1) tp0 = __builtin_amdgcn_s_memrealtime(); if ((k) == TPH_HI) tp1 = __builtin_amdgcn_s_memrealtime(); } while (0)
#else
#define STAMP(k) do { } while (0)
#endif
#define SEAM(k) do { if (IN(k) && IN((k) + 1)) { if ((k) == 0) { grid.sync(); xbar = xcd_barrier_post((unsigned*)(ws + WS_CTL) + CW_BAR, bar_st); } else xcd_barrier(xbar); } STAMP(k); } while (0)

    if (IN(0)) { p0_prep(F); } SEAM(0);
    if (IN(1)) { GemmPlain g; g.A = (const char*)(ws + WS_XB); g.K = 1024; g.lda2 = 2048; g.ldb2 = 2048; g.Bt = (const char*)(ws + WS_W0IN); g.ord.init(T, L0N, F.G, (int)blockIdx.x);
        g.C = (bf16_t*)(ws + WS_Z); g.ldc = L0N; pg8::gemm_phase(F.lds, g); } SEAM(1);
#ifdef XSYNC_N
    for (int xs = 0; xs < XSYNC_N; ++xs) grid.sync();
#endif
#ifdef XGEMM_K
    { grid.sync(); const unsigned long long xt0 = __builtin_amdgcn_s_memrealtime();
      GemmPlain g; g.A = (const char*)(ws + WS_XB); g.K = XGEMM_K; g.lda2 = 2048; g.ldb2 = 2048; g.Bt = (const char*)(ws + WS_W0IN); g.ord.init(T, XGEMM_N, F.G, (int)blockIdx.x);
      g.C = (bf16_t*)F.out; g.ldc = XGEMM_N; pg8::gemm_phase(F.lds, g); grid.sync(); (void)xt0; }
#endif
    if (IN(2)) { for (int u = F.vcu; u < 512; u += F.G) lru_tile<false>(F, u >> 7, u & 127); } SEAM(2);
    if (IN(3)) { for (int u = F.vcu; u < 512; u += F.G) lru_tile<true>(F, u >> 7, u & 127); } SEAM(3);
    bf16_t* const OA = (bf16_t*)F.out; bf16_t* const OB = OA + (size_t)T * D;
    if (IN(4)) { GemmResid<true, false> g; g.A = (const char*)(ws + WS_XB); g.K = 1024; g.lda2 = 2048; g.ldb2 = 2048; g.Bt = (const char*)(ws + WS_W0OUT); g.ord.init(T, D, F.G, (int)blockIdx.x);
        g.res32 = F.in[0]; g.res16 = nullptr; g.out = OA; pg8::gemm_phase(F.lds, g); } SEAM(4);
#define MOE_LAYER(layer, pb, SRC, FIN, DST16) do { \
        if (IN(pb)) { ln_router_phase(F, layer, SRC); } SEAM(pb); \
        if (IN((pb) + 1)) { MoeTab tab = moe_tables(F, layer); \
            GemmMoeUp g; g.A = (const char*)(ws + WS_X8); g.K = 512; g.lda2 = 1024; g.ldb2 = 1024; g.Bt = (const char*)(ws + ((layer) ? WS_WGU1 : WS_WGU0)); g.G = F.G; g.c = (int)blockIdx.x; \
            g.tab = tab; g.list = (const unsigned*)(ws + WS_LIST); g.H = (bf16_t*)(ws + WS_H); pg8::gemm_phase(F.lds, g); } SEAM((pb) + 1); \
        if (IN((pb) + 2)) { MoeTab tab = moe_tables(F, layer); \
            GemmMoeDown g; g.A = (const char*)(ws + WS_H); g.K = 256; g.lda2 = 512; g.ldb2 = 512; g.Bt = (const char*)(ws + ((layer) ? WS_WD1 : WS_WD0)); g.G = F.G; g.c = (int)blockIdx.x; \
            g.tab = tab; g.Y = (bf16_t*)(ws + WS_Y); pg8::gemm_phase(F.lds, g); } SEAM((pb) + 2); \
        if (IN((pb) + 3)) { MoeTab tab = moe_tables(F, layer); ln2_phase<FIN>(F, layer, tab, DST16, F.out, (unsigned char*)OB); } } while (0)
    MOE_LAYER(0, 5, OA, false, OA); SEAM(8);
    if (IN(9)) { GemmL1In g; g.A = (const char*)OB; g.K = 512; g.lda2 = 1024; g.ldb2 = 1024; g.Bt = (const char*)(ws + WS_W1IN); g.ord.init(T, L1NP, F.G, (int)blockIdx.x);
        g.Q = (bf16_t*)(ws + WS_Q); g.KV = ws + WS_KV; g.gates = (float*)(ws + WS_GATES); g.cosT = (const float*)(ws + WS_COS); g.sinT = (const float*)(ws + WS_SIN); pg8::gemm_phase(F.lds, g); } SEAM(9);
    if (IN(10)) { GemmCmp1 g; g.A = (const char*)(ws + WS_KV); g.K = 2048; g.lda2 = 2048; g.ldb2 = 4096; g.Bt = (const char*)(ws + WS_WC1); g.G = F.G; g.c = (int)blockIdx.x;
        g.cbias = (const float*)(ws + WS_SMALL + SM_CBIAS); g.Hd = (bf16_t*)(ws + WS_CMPH); pg8::gemm_phase(F.lds, g); p0_moe1(F, F.G >= 128 ? 64 : 0); } SEAM(10);
    if (IN(11)) { GemmCmp2 g; g.A = (const char*)(ws + WS_CMPH); g.K = 256; g.lda2 = 512; g.ldb2 = 512; g.Bt = (const char*)(ws + WS_WC2); g.G = F.G; g.c = (int)blockIdx.x;
        g.O = (bf16_t*)(ws + WS_CMPO); pg8::gemm_phase(F.lds, g); } SEAM(11);
#ifdef XATT_VAR
    { xcd_barrier(xbar); attn_phase<XATT_VAR>(F, (bf16_t*)(ws + WS_XB)); xcd_barrier(xbar); }
#endif
    if (IN(12)) { attn_phase<0>(F, (bf16_t*)(ws + WS_XB)); } SEAM(12);
    if (IN(13)) { GemmResid<false, true> g; g.A = (const char*)(ws + WS_XB); g.K = 512; g.lda2 = 1024; g.ldb2 = 1024; g.Bt = (const char*)(ws + WS_W1OUT); g.ord.init(T, D, F.G, (int)blockIdx.x);
        g.res32 = nullptr; g.res16 = OA; g.out = OB; pg8::gemm_phase(F.lds, g); } SEAM(13);
    MOE_LAYER(1, 14, OB, true, nullptr);
#undef MOE_LAYER
#ifdef TPH_LO
    grid.sync(); STAMP(17);
    if (blockIdx.x == 0 && threadIdx.x == 0) { const unsigned long long span = (tp1 - tp0) * TPH_MUL, ts = __builtin_amdgcn_s_memrealtime(); while (__builtin_amdgcn_s_memrealtime() - ts < span) __builtin_amdgcn_s_sleep(32); }
#endif
#undef IN
#undef SEAM
}

extern "C" void kernel_launch(void* const* d_in, const int* in_sizes, int n_in, void* d_out, int out_size, void* d_ws, size_t ws_size, hipStream_t stream) {
    static int grid = 0;
    if (grid == 0) {
        if (n_in != 41 || out_size != T * D || ws_size < WS_END) { fprintf(stderr, "kernel_launch: unexpected problem (n_in %d out %d ws %zu, need %zu)\n", n_in, out_size, ws_size, (size_t)WS_END); grid = -1; return; }
        int dev = 0, cus = 0, per_cu = 0;
        hipGetDevice(&dev); hipDeviceGetAttribute(&cus, hipDeviceAttributeMultiprocessorCount, dev);
        hipFuncSetAttribute((const void*)fwd_kernel, hipFuncAttributeMaxDynamicSharedMemorySize, LDS_BYTES);
        hipOccupancyMaxActiveBlocksPerMultiprocessor(&per_cu, (const void*)fwd_kernel, NTHR, LDS_BYTES);
        if (per_cu < 1) { fprintf(stderr, "kernel_launch: occupancy query says %d blocks/CU\n", per_cu); per_cu = 1; }
        grid = cus * per_cu; if (grid > cus) grid = cus;
        (void)hipGetLastError();
    }
    if (grid < 0) return;
    Args a{};
    for (int i = 0; i < 41; ++i) a.in[i] = (const float*)d_in[i];
    a.out = (float*)d_out; a.ws = (unsigned char*)d_ws; a.ph_lo = 0; a.ph_hi = NPHASE;
    void* kargs[] = {&a};
    hipError_t e = hipLaunchCooperativeKernel((const void*)fwd_kernel, dim3(grid), dim3(NTHR), kargs, LDS_BYTES, stream);
    if (e != hipSuccess) fprintf(stderr, "cooperative launch failed: %s (grid %d)\n", hipGetErrorString(e), grid);
}
```

```cpp
#include <hip/hip_runtime.h>
#include <hip/hip_cooperative_groups.h>
#include <cstdio>
#include <cstdint>
#include <cmath>
namespace cg = cooperative_groups;

#define LAS __attribute__((address_space(3)))
#define DI __device__ __forceinline__
typedef unsigned short bf16_t;
typedef short bf16x8 __attribute__((ext_vector_type(8)));
typedef short s16x4 __attribute__((ext_vector_type(4)));
typedef float f32x2 __attribute__((ext_vector_type(2)));
typedef float f32x4 __attribute__((ext_vector_type(4)));
typedef float f32x16 __attribute__((ext_vector_type(16)));
typedef unsigned u32x2 __attribute__((ext_vector_type(2)));
typedef unsigned u32x4 __attribute__((ext_vector_type(4)));

constexpr int NB = 4, SEQ = 8192, T = NB * SEQ, D = 1024;
constexpr int L0N = 2560;
constexpr int L1N = 2608, L1NP = 2816;
constexpr int NEXP = 32, FF = 512;
constexpr float DN_ALPHA = 1.4142135623730951f;
constexpr float LN_EPS = 1e-5f;
constexpr int NWAVES = 8, NTHR = 512;
constexpr int NCMP = 512;

constexpr size_t MiB = 1u << 20;
constexpr size_t WS_CTL = 0;
constexpr size_t WS_COS = 1 * MiB, WS_SIN = 2 * MiB;
constexpr size_t WS_SMALL = 3 * MiB;
constexpr size_t SM_LRUBT = 0;
constexpr size_t SM_CBIAS = 256 * 1024;
constexpr size_t SM_RWT = 320 * 1024;
constexpr size_t WS_W0IN = 4 * MiB, WS_W0OUT = 9 * MiB, WS_W1IN = 11 * MiB, WS_W1OUT = 17 * MiB;
constexpr size_t WS_WC1 = 19 * MiB;
constexpr size_t WS_WC2 = 21 * MiB;
constexpr size_t WS_LIST = 22 * MiB;
constexpr size_t WS_WSLOT = 26 * MiB;
constexpr size_t WS_POSLOC = WS_WSLOT + 256 * 1024;
constexpr size_t WS_SCAN = 27 * MiB;
constexpr size_t WS_WGU0 = 32 * MiB, WS_WD0 = 96 * MiB, WS_WGU1 = 128 * MiB, WS_WD1 = 192 * MiB;
constexpr size_t WS_ACT = 224 * MiB;
constexpr size_t WS_XB = WS_ACT;
constexpr size_t WS_Z = WS_ACT + 64 * MiB;
constexpr size_t WS_H = WS_ACT + 64 * MiB;
constexpr size_t WS_X8 = WS_ACT + 100 * MiB;
constexpr size_t WS_Y = WS_ACT + 136 * MiB;
constexpr size_t WS_Q = WS_ACT + 64 * MiB;
constexpr size_t WS_KV = WS_ACT + 128 * MiB;
constexpr size_t KV_STRIDE = 17 * MiB;
constexpr size_t WS_GATES = WS_ACT + 232 * MiB;
constexpr size_t WS_CMPH = WS_ACT + 240 * MiB;
constexpr size_t WS_CMPO = WS_ACT + 248 * MiB;
constexpr size_t WS_END = WS_ACT + 280 * MiB;
constexpr int CW_CNT = 64;
constexpr int CW_BAR = 1024;
constexpr int CTL_WORDS = 8192;

DI unsigned f2bf(float f) { unsigned u = __builtin_bit_cast(unsigned, f); return (u + 0x7fffu + ((u >> 16) & 1u)) >> 16; }
DI unsigned pk2(float lo, float hi) { return f2bf(lo) | (f2bf(hi) << 16); }
DI float bf2f(unsigned short b) { return __builtin_bit_cast(float, (unsigned)b << 16); }
DI float bflo(unsigned w) { return __builtin_bit_cast(float, w << 16); }
DI float bfhi(unsigned w) { return __builtin_bit_cast(float, w & 0xffff0000u); }
DI unsigned cvt_pk_bf16(float lo, float hi) { unsigned r; asm volatile("v_cvt_pk_bf16_f32 %0, %1, %2" : "=v"(r) : "v"(lo), "v"(hi)); return r; }
DI float wave_sum(float v) {
    int x = __float_as_int(v);
    x = __float_as_int(__int_as_float(x) + __int_as_float(__builtin_amdgcn_mov_dpp(x, 0xB1, 0xF, 0xF, true)));
    x = __float_as_int(__int_as_float(x) + __int_as_float(__builtin_amdgcn_mov_dpp(x, 0x4E, 0xF, 0xF, true)));
    x = __float_as_int(__int_as_float(x) + __int_as_float(__builtin_amdgcn_mov_dpp(x, 0x141, 0xF, 0xF, true)));
    x = __float_as_int(__int_as_float(x) + __int_as_float(__builtin_amdgcn_mov_dpp(x, 0x140, 0xF, 0xF, true)));
    x = __float_as_int(__int_as_float(x) + __int_as_float(__builtin_amdgcn_update_dpp(0, x, 0x142, 0xA, 0xF, false)));
    x = __float_as_int(__int_as_float(x) + __int_as_float(__builtin_amdgcn_update_dpp(0, x, 0x143, 0xC, 0xF, false)));
    return __int_as_float(__builtin_amdgcn_readlane(x, 63));
}
DI float sigmoidf_(float x) { return __builtin_amdgcn_rcpf(1.0f + __builtin_amdgcn_exp2f(-1.4426950408889634f * x)); }
DI float gelu_tanh(float x) { const float u = 0.7978845608028654f * (x + 0.044715f * x * x * x); return x * __builtin_amdgcn_rcpf(1.0f + __builtin_amdgcn_exp2f(-2.8853900817779268f * u)); }
#define LDS_WAIT() asm volatile("s_waitcnt lgkmcnt(0)" ::: "memory")

namespace pg8 {
constexpr int BM = 256, BK = 64, HALF = 128, HTB = HALF * BK * 2, STAGE_BYTES = 8 * HTB;
__host__ __device__ __forceinline__ int lds_byte(int r, int c) { const int st = (r >> 4) * 2 + (c >> 5), rr = r & 15, cc = c & 31, ob = rr * 64 + cc * 2; return st * 1024 + (ob ^ (((ob >> 9) & 1) << 5)); }
__host__ __device__ __forceinline__ void stage_rc(int b, int& R, int& C) { const int st = b / 1024, sb = b % 1024, swz = sb ^ (((sb >> 9) & 1) << 5); R = (st >> 1) * 16 + swz / 64; C = (st & 1) * 32 + (swz % 64) / 2; }
__host__ __device__ __forceinline__ int perm32(int rho) { const int n = rho >> 4, i = rho & 15; return 8 * (i >> 2) + 4 * n + (i & 3); }
struct GU { int pm, pn, e; };
__device__ __forceinline__ void mfma_f8_inplace(f32x4& acc, const int __attribute__((ext_vector_type(8)))& a, const int __attribute__((ext_vector_type(8)))& b, int sc) {
    asm volatile("v_mfma_scale_f32_16x16x128_f8f6f4 %0, %1, %2, %0, %3, %3 op_sel_hi:[0,0,0]" : "+v"(acc) : "v"(a), "v"(b), "v"(sc));
}
typedef int v8i32 __attribute__((ext_vector_type(8))); typedef int v4i32 __attribute__((ext_vector_type(4))); typedef long v2i64 __attribute__((ext_vector_type(2)));
__device__ __forceinline__ v8i32 cat8(bf16x8 a, bf16x8 b) { const v4i32 x = __builtin_bit_cast(v4i32, a), y = __builtin_bit_cast(v4i32, b); return __builtin_shufflevector(x, y, 0, 1, 2, 3, 4, 5, 6, 7); }
template <class P>
__device__ __forceinline__ void gemm_phase(LAS unsigned char* lds, const P& p) {
    const int tid = threadIdx.x, wid = __builtin_amdgcn_readfirstlane(tid >> 6), lane = tid & 63, wr = wid >> 2, wc = wid & 3, fr = lane & 15, fq = lane >> 4;
    const int nt = p.K / BK;
    int Rr[2]; unsigned Cc2[2], voffB[2];
#pragma unroll
    for (int i = 0; i < 2; ++i) { int R, C; stage_rc(tid * 16 + i * 8192, R, C); const int Rb = P::PERM ? ((R & ~31) + perm32(R & 31)) : R;
        Rr[i] = R; Cc2[i] = (unsigned)C * 2u; voffB[i] = (unsigned)Rb * p.ldb2 + (unsigned)C * 2u; }
    const size_t kstep = (size_t)(BK * 2);
    const size_t hstepB = (size_t)HALF * p.ldb2;
    const unsigned ldsw = (unsigned)wid * 1024u;
    const int aoff = lds_byte(wr * 64 + fr, fq * 8), boff = lds_byte(wc * 32 + fr, fq * 8);
#define PG8_SA(b, h) (((b) * 2 + (h)) * HTB)
#define PG8_SB(b, h) ((4 + (b) * 2 + (h)) * HTB)
#define PG8_STAGE(bufoff, gbase, voff) do { _Pragma("unroll") for (int _i = 0; _i < 2; ++_i) \
        __builtin_amdgcn_global_load_lds((const unsigned*)((const char*)(gbase) + (voff)[_i]), (LAS unsigned*)(lds + (bufoff) + ldsw + _i * 8192), 16, 0, 0); } while (0)
#define PG8_LDA(dst, b, h) do { _Pragma("unroll") for (int m = 0; m < 4; ++m) { if constexpr (P::FP8) dst##8[m] = cat8(*(const LAS bf16x8*)(lds + PG8_SA(b, h) + aoff + m * 2048), *(const LAS bf16x8*)(lds + PG8_SA(b, h) + aoff + m * 2048 + 1024)); \
        else { _Pragma("unroll") for (int k = 0; k < 2; ++k) dst[m][k] = *(const LAS bf16x8*)(lds + PG8_SA(b, h) + aoff + m * 2048 + k * 1024); } } } while (0)
#define PG8_LDB(dst, b, h) do { _Pragma("unroll") for (int n = 0; n < 2; ++n) { if constexpr (P::FP8) dst##8[n] = cat8(*(const LAS bf16x8*)(lds + PG8_SB(b, h) + boff + n * 2048), *(const LAS bf16x8*)(lds + PG8_SB(b, h) + boff + n * 2048 + 1024)); \
        else { _Pragma("unroll") for (int k = 0; k < 2; ++k) dst[n][k] = *(const LAS bf16x8*)(lds + PG8_SB(b, h) + boff + n * 2048 + k * 1024); } } } while (0)
#define PG8_MMA(ai, bj, At, Bt) do { __builtin_amdgcn_s_setprio(1); _Pragma("unroll") for (int m = 0; m < 4; ++m) _Pragma("unroll") for (int n = 0; n < 2; ++n) { \
        if constexpr (P::FP8) { mfma_f8_inplace(acc[ai][bj][m][n], Bt##8[n], At##8[m], scale1); } \
        else { _Pragma("unroll") for (int k = 0; k < 2; ++k) acc[ai][bj][m][n] = __builtin_amdgcn_mfma_f32_16x16x32_bf16(Bt[n][k], At[m][k], acc[ai][bj][m][n], 0, 0, 0); } } \
        __builtin_amdgcn_s_setprio(0); } while (0)
#define PG8_WAIT_V(n) asm volatile("s_waitcnt vmcnt(" #n ")" ::: "memory")
#define PG8_WAIT_L(n) asm volatile("s_waitcnt lgkmcnt(" #n ")" ::: "memory")
#define PG8_BAR __builtin_amdgcn_s_barrier()
#define PG8_SCHED __builtin_amdgcn_sched_barrier(0)
    GU cur, nxt; int ui = 0;
    if (!p.next(0, cur)) return;
    f32x4 acc[2][2][4][2];
#pragma unroll
    for (int a = 0; a < 2; ++a)
#pragma unroll
        for (int b = 0; b < 2; ++b)
#pragma unroll
            for (int m = 0; m < 4; ++m)
#pragma unroll
                for (int n = 0; n < 2; ++n) acc[a][b][m][n] = (f32x4){0.f, 0.f, 0.f, 0.f};
    bf16x8 At[4][2], B0[2][2], B1[2][2]; v8i32 At8[4], B08[2], B18[2]; const int scale1 = 0x7f7f7f7f;
    unsigned cA0[2], cA1[2], nA0[2], nA1[2];
    size_t cU = 0, nU = 0;
#pragma unroll
    for (int i = 0; i < 2; ++i) {
        if constexpr (P::AUNI) { cA0[i] = (unsigned)Rr[i] * p.lda2 + Cc2[i]; cA1[i] = (unsigned)(HALF + Rr[i]) * p.lda2 + Cc2[i]; }
        else { cA0[i] = p.a_row_off(cur, Rr[i]) + Cc2[i]; cA1[i] = p.a_row_off(cur, HALF + Rr[i]) + Cc2[i]; } }
    if constexpr (P::AUNI) cU = p.a_base(cur);
    const char* const Ab0 = p.A;
#define Ab (Ab0 + cU)
    const char* cB = p.b_tile(cur);
    PG8_STAGE(PG8_SB(0, 0), cB, voffB); PG8_STAGE(PG8_SB(0, 1), cB + hstepB, voffB); PG8_STAGE(PG8_SA(0, 0), Ab, cA0); PG8_STAGE(PG8_SA(0, 1), Ab, cA1);
    if (wr == 1) PG8_BAR;
    PG8_WAIT_V(2); PG8_BAR;
    PG8_STAGE(PG8_SB(1, 0), cB + kstep, voffB); PG8_STAGE(PG8_SA(1, 0), Ab + kstep, cA0); PG8_STAGE(PG8_SB(1, 1), cB + hstepB + kstep, voffB);
    PG8_WAIT_V(6); PG8_BAR;
    for (;;) {
        const bool has_next = p.next(ui + 1, nxt);
        const char* nB = has_next ? p.b_tile(nxt) : cB;
        if constexpr (P::AUNI) nU = has_next ? p.a_base(nxt) : cU;
        else {
#pragma unroll
            for (int i = 0; i < 2; ++i) { nA0[i] = has_next ? p.a_row_off(nxt, Rr[i]) + Cc2[i] : cA0[i]; nA1[i] = has_next ? p.a_row_off(nxt, HALF + Rr[i]) + Cc2[i] : cA1[i]; } }
        for (int t = 0; t < nt; t += 2) {
            const bool last = (t == nt - 2);
            const char* a1 = Ab + (size_t)(t + 1) * kstep;
            const char* a2 = last ? (P::AUNI ? Ab0 + nU : Ab) : Ab + (size_t)(t + 2) * kstep; const char* b2 = last ? nB : cB + (size_t)(t + 2) * kstep;
            const char* a3 = a2 + kstep; const char* b3 = b2 + kstep;
            unsigned o0[2], o1[2];
#pragma unroll
            for (int i = 0; i < 2; ++i) { if constexpr (P::AUNI) { o0[i] = cA0[i]; o1[i] = cA1[i]; } else { o0[i] = last ? nA0[i] : cA0[i]; o1[i] = last ? nA1[i] : cA1[i]; } }
            PG8_LDB(B0, 0, 0); PG8_LDB(B1, 0, 1); PG8_SCHED; PG8_LDA(At, 0, 0); PG8_STAGE(PG8_SA(1, 1), a1, cA1);
            PG8_WAIT_V(8); PG8_WAIT_L(0); PG8_BAR; PG8_MMA(0, 0, At, B0); PG8_MMA(0, 1, At, B1); PG8_BAR; PG8_SCHED;
            PG8_LDA(At, 0, 1); PG8_STAGE(PG8_SB(0, 0), b2, voffB); PG8_STAGE(PG8_SB(0, 1), b2 + hstepB, voffB); PG8_STAGE(PG8_SA(0, 0), a2, o0);
            PG8_WAIT_V(8); PG8_WAIT_L(0); PG8_BAR; PG8_MMA(1, 0, At, B0); PG8_MMA(1, 1, At, B1); PG8_BAR; PG8_SCHED;
            PG8_LDB(B0, 1, 0); PG8_LDB(B1, 1, 1); PG8_SCHED; PG8_LDA(At, 1, 0); PG8_STAGE(PG8_SA(0, 1), a2, o1);
            PG8_WAIT_V(8); PG8_WAIT_L(0); PG8_BAR; PG8_MMA(0, 0, At, B0); PG8_MMA(0, 1, At, B1); PG8_BAR; PG8_SCHED;
            PG8_LDA(At, 1, 1); PG8_STAGE(PG8_SB(1, 0), b3, voffB); PG8_STAGE(PG8_SB(1, 1), b3 + hstepB, voffB); PG8_STAGE(PG8_SA(1, 0), a3, o0);
            PG8_WAIT_V(8); PG8_WAIT_L(0); PG8_BAR; PG8_MMA(1, 0, At, B0); PG8_MMA(1, 1, At, B1); PG8_BAR; PG8_SCHED;
        }
#ifndef PG8_NOALIGN
        if (wr == 0) PG8_BAR;
#endif
        if constexpr (P::FP8) asm volatile("s_nop 7\n\ts_nop 7" ::: "memory");
        p.epi(acc, cur, wr, wc, fr, fq);
        if (!has_next) break;
#pragma unroll
        for (int a = 0; a < 2; ++a)
#pragma unroll
            for (int b = 0; b < 2; ++b)
#pragma unroll
                for (int m = 0; m < 4; ++m)
#pragma unroll
                    for (int n = 0; n < 2; ++n) acc[a][b][m][n] = (f32x4){0.f, 0.f, 0.f, 0.f};
        cur = nxt; cB = nB; ++ui;
        if constexpr (P::AUNI) cU = nU;
        else {
#pragma unroll
            for (int i = 0; i < 2; ++i) { cA0[i] = nA0[i]; cA1[i] = nA1[i]; } }
#ifndef PG8_NOALIGN
        if (wr == 1) PG8_BAR;
#endif
    }
    PG8_WAIT_V(0);
#ifdef PG8_NOALIGN
    if (wr == 0) PG8_BAR;
#endif
    PG8_BAR;
#undef Ab
#undef PG8_SA
#undef PG8_SB
#undef PG8_STAGE
#undef PG8_LDA
#undef PG8_LDB
#undef PG8_MMA
#undef PG8_WAIT_V
#undef PG8_WAIT_L
#undef PG8_BAR
#undef PG8_SCHED
}
struct TileOrder {
    int nM, nN, nwg, G, c;
    __device__ void init(int M, int N, int G_, int c_) { nM = M / BM; nN = N / BM; nwg = nM * nN; G = G_; c = c_; }
    __device__ bool next(int i, GU& u) const {
        const long L = (long)i * G + c; if (L >= nwg) return false;
        int wgid = (int)L; { const int q = nwg / 8, r = nwg % 8, xcd = wgid % 8, off = wgid / 8; wgid = (xcd < r ? xcd * (q + 1) : r * (q + 1) + (xcd - r) * q) + off; }
        const int WGM = 8; const int nig = WGM * nN, gid = wgid / nig, fm = gid * WGM, gsz = (nM - fm) < WGM ? (nM - fm) : WGM;
        u.pm = fm + ((wgid % nig) % gsz); u.pn = (wgid % nig) / gsz; u.e = 0; return true;
    }
};
}
using pg8::GU;

struct Args { const float* in[41]; float* out; unsigned char* ws; int ph_lo, ph_hi; };

struct GemmPlain {
    static constexpr bool AUNI = true;
    static constexpr bool FP8 = false;
    static constexpr bool PERM = true;
    const char* A; int K; unsigned lda2, ldb2; const char* Bt; pg8::TileOrder ord;
    bf16_t* C; int ldc;
    DI bool next(int i, GU& u) const { return ord.next(i, u); }
    DI unsigned a_row_off(const GU& u, int r) const { return (unsigned)(u.pm * 256 + r) * lda2; }
    DI size_t a_base(const GU& u) const { return (size_t)(u.pm * 256) * lda2; }
    DI const char* b_tile(const GU& u) const { return Bt + (size_t)u.pn * 256 * ldb2; }
    DI void epi(const f32x4 (&acc)[2][2][4][2], const GU& u, int wr, int wc, int fr, int fq) const {
        const int row0 = u.pm * 256 + wr * 64 + fr, col0 = u.pn * 256 + wc * 32 + 8 * fq;
#pragma unroll
        for (int ai = 0; ai < 2; ++ai)
#pragma unroll
            for (int m = 0; m < 4; ++m) { bf16_t* rowp = C + (size_t)(row0 + ai * 128 + m * 16) * ldc + col0;
#pragma unroll
                for (int bj = 0; bj < 2; ++bj) { const f32x4 v0 = acc[ai][bj][m][0], v1 = acc[ai][bj][m][1];
                    u32x4 w; w.x = cvt_pk_bf16(v0[0], v0[1]); w.y = cvt_pk_bf16(v0[2], v0[3]); w.z = cvt_pk_bf16(v1[0], v1[1]); w.w = cvt_pk_bf16(v1[2], v1[3]);
                    *(u32x4*)(rowp + bj * 128) = w; } }
    }
};
template <bool RES32, bool FP8_>
struct GemmResid {
    static constexpr bool AUNI = true;
    static constexpr bool FP8 = FP8_;
    static constexpr bool PERM = true;
    const char* A; int K; unsigned lda2, ldb2; const char* Bt; pg8::TileOrder ord;
    const float* res32; const bf16_t* res16; bf16_t* out;
    DI bool next(int i, GU& u) const { return ord.next(i, u); }
    DI unsigned a_row_off(const GU& u, int r) const { return (unsigned)(u.pm * 256 + r) * lda2; }
    DI size_t a_base(const GU& u) const { return (size_t)(u.pm * 256) * lda2; }
    DI const char* b_tile(const GU& u) const { return Bt + (size_t)u.pn * 256 * ldb2; }
    DI void epi(const f32x4 (&acc)[2][2][4][2], const GU& u, int wr, int wc, int fr, int fq) const {
        const int col0 = u.pn * 256 + wc * 32 + 8 * fq; const size_t rbase = (size_t)(u.pm * 256 + wr * 64 + fr) * D + col0;
        if constexpr (RES32) {
#pragma unroll
            for (int ai = 0; ai < 2; ++ai) {
                f32x4 r[4][2][2];
#pragma unroll
                for (int m = 0; m < 4; ++m)
#pragma unroll
                    for (int bj = 0; bj < 2; ++bj) { const float* rp = res32 + rbase + (size_t)(ai * 128 + m * 16) * D + bj * 128; r[m][bj][0] = *(const f32x4*)rp; r[m][bj][1] = *(const f32x4*)(rp + 4); }
#pragma unroll
                for (int m = 0; m < 4; ++m)
#pragma unroll
                    for (int bj = 0; bj < 2; ++bj) { const f32x4 v0 = r[m][bj][0] * DN_ALPHA + acc[ai][bj][m][0], v1 = r[m][bj][1] * DN_ALPHA + acc[ai][bj][m][1];
                        u32x4 w; w.x = cvt_pk_bf16(v0[0], v0[1]); w.y = cvt_pk_bf16(v0[2], v0[3]); w.z = cvt_pk_bf16(v1[0], v1[1]); w.w = cvt_pk_bf16(v1[2], v1[3]);
                        *(u32x4*)(out + rbase + (size_t)(ai * 128 + m * 16) * D + bj * 128) = w; }
            }
        } else {
            u32x4 r[2][4][2];
#pragma unroll
            for (int ai = 0; ai < 2; ++ai)
#pragma unroll
                for (int m = 0; m < 4; ++m)
#pragma unroll
                    for (int bj = 0; bj < 2; ++bj) r[ai][m][bj] = *(const u32x4*)(res16 + rbase + (size_t)(ai * 128 + m * 16) * D + bj * 128);
#pragma unroll
            for (int ai = 0; ai < 2; ++ai)
#pragma unroll
                for (int m = 0; m < 4; ++m)
#pragma unroll
                    for (int bj = 0; bj < 2; ++bj) { const u32x4 q = r[ai][m][bj]; const float sc = FP8_ ? 0.03125f : 1.0f; const f32x4 a0 = acc[ai][bj][m][0] * sc, a1 = acc[ai][bj][m][1] * sc;
                        u32x4 w; w.x = cvt_pk_bf16(bflo(q.x) * DN_ALPHA + a0[0], bfhi(q.x) * DN_ALPHA + a0[1]); w.y = cvt_pk_bf16(bflo(q.y) * DN_ALPHA + a0[2], bfhi(q.y) * DN_ALPHA + a0[3]);
                        w.z = cvt_pk_bf16(bflo(q.z) * DN_ALPHA + a1[0], bfhi(q.z) * DN_ALPHA + a1[1]); w.w = cvt_pk_bf16(bflo(q.w) * DN_ALPHA + a1[2], bfhi(q.w) * DN_ALPHA + a1[3]);
                        *(u32x4*)(out + rbase + (size_t)(ai * 128 + m * 16) * D + bj * 128) = w; }
        }
    }
};
struct MoeTab { const LAS int* tbase; const LAS int* cnt; int ntiles; };
struct GemmMoeUp {
    static constexpr bool AUNI = false;
    static constexpr bool FP8 = true;
    static constexpr bool PERM = true;
    const char* A; int K; unsigned lda2, ldb2; const char* Bt; int G, c;
    MoeTab tab; const unsigned* list; bf16_t* H;
    DI bool next(int i, GU& u) const {
        const int L = i * G + c; if (L >= tab.ntiles * 4) return false;
        const int tile = L >> 2; u.pn = L & 3; int e = 0;
#pragma unroll 1
        while (tab.tbase[e + 1] <= tile) ++e;
        u.e = e; u.pm = tile - tab.tbase[e]; return true;
    }
    DI unsigned a_row_off(const GU& u, int r) const {
        const int li = u.pm * 256 + r; const int cn = tab.cnt[u.e];
        const unsigned slot = li < cn ? list[(size_t)u.e * T + li] : 0u;
        return (slot >> 1) * lda2;
    }
    DI size_t a_base(const GU&) const { return 0; }
    DI const char* b_tile(const GU& u) const { return Bt + ((size_t)u.e * 1024 + (size_t)u.pn * 256) * ldb2; }
    DI void epi(const f32x4 (&acc)[2][2][4][2], const GU& u, int wr, int wc, int fr, int fq) const {
        const int hrow0 = (tab.tbase[u.e] + u.pm) * 256 + wr * 64 + fr, col0 = u.pn * 128 + wc * 32 + 8 * fq;
#pragma unroll
        for (int ai = 0; ai < 2; ++ai)
#pragma unroll
            for (int m = 0; m < 4; ++m) { unsigned char* rowp = (unsigned char*)H + (size_t)(hrow0 + ai * 128 + m * 16) * FF + col0;
                float h[8];
#pragma unroll
                for (int n = 0; n < 2; ++n)
#pragma unroll
                    for (int j = 0; j < 4; ++j) { const float g = acc[ai][0][m][n][j] * 0.03125f, uu = acc[ai][1][m][n][j] * 0.03125f; h[n * 4 + j] = g * uu * __builtin_amdgcn_rcpf(1.0f + __builtin_amdgcn_exp2f(-1.4426950408889634f * g)); }
                int w0 = 0, w1 = 0; w0 = __builtin_amdgcn_cvt_pk_fp8_f32(h[0], h[1], w0, false); w0 = __builtin_amdgcn_cvt_pk_fp8_f32(h[2], h[3], w0, true);
                w1 = __builtin_amdgcn_cvt_pk_fp8_f32(h[4], h[5], w1, false); w1 = __builtin_amdgcn_cvt_pk_fp8_f32(h[6], h[7], w1, true);
                *(u32x2*)rowp = (u32x2){(unsigned)w0, (unsigned)w1}; }
    }
};
struct GemmMoeDown {
    static constexpr bool AUNI = true;
    static constexpr bool FP8 = true;
    static constexpr bool PERM = true;
    const char* A; int K; unsigned lda2, ldb2; const char* Bt; int G, c;
    MoeTab tab; bf16_t* Y;
    DI bool next(int i, GU& u) const {
        const int L = i * G + c; if (L >= tab.ntiles * 4) return false;
        const int tile = L >> 2; u.pn = L & 3; int e = 0;
#pragma unroll 1
        while (tab.tbase[e + 1] <= tile) ++e;
        u.e = e; u.pm = tile - tab.tbase[e]; return true;
    }
    DI unsigned a_row_off(const GU& u, int r) const { return (unsigned)((tab.tbase[u.e] + u.pm) * 256 + r) * lda2; }
    DI size_t a_base(const GU& u) const { return (size_t)((tab.tbase[u.e] + u.pm) * 256) * lda2; }
    DI const char* b_tile(const GU& u) const { return Bt + ((size_t)u.e * 1024 + (size_t)u.pn * 256) * ldb2; }
    DI void epi(const f32x4 (&acc)[2][2][4][2], const GU& u, int wr, int wc, int fr, int fq) const {
        const int row0 = (tab.tbase[u.e] + u.pm) * 256 + wr * 64 + fr, col0 = u.pn * 256 + wc * 32 + 8 * fq;
#pragma unroll
        for (int ai = 0; ai < 2; ++ai)
#pragma unroll
            for (int m = 0; m < 4; ++m) { bf16_t* rowp = Y + (size_t)(row0 + ai * 128 + m * 16) * D + col0;
#pragma unroll
                for (int bj = 0; bj < 2; ++bj) { const f32x4 v0 = acc[ai][bj][m][0] * 0.03125f, v1 = acc[ai][bj][m][1] * 0.03125f;
                    u32x4 w; w.x = cvt_pk_bf16(v0[0], v0[1]); w.y = cvt_pk_bf16(v0[2], v0[3]); w.z = cvt_pk_bf16(v1[0], v1[1]); w.w = cvt_pk_bf16(v1[2], v1[3]);
                    *(u32x4*)(rowp + bj * 128) = w; } }
    }
};

#define XB_TMO      128
#define XB_XCNT(j)  (256  + 64 * (j))
#define XB_XSUB(j)  (1280 + 64 * (j))
#define XB_XGEN(j)  (2304 + 64 * (j))
#define XB_TOP      3328
#define XB_TOPGEN   3392
#define XCD_BAR_WORDS 3456
#define XB_SPIN_CAP (1u << 18)
__device__ __forceinline__ unsigned xb_ld(unsigned* p)              { return __hip_atomic_load(p, __ATOMIC_RELAXED, __HIP_MEMORY_SCOPE_AGENT); }
__device__ __forceinline__ unsigned xb_add(unsigned* p, unsigned v) { return __hip_atomic_fetch_add(p, v, __ATOMIC_RELAXED, __HIP_MEMORY_SCOPE_AGENT); }
__device__ __forceinline__ unsigned xb_xcc_id() { return (unsigned)__builtin_amdgcn_s_getreg((3 << 11) | 20) & 0xFu; }
#define XB_SPIN(cond, bar) do { unsigned _sp = 0; while (cond) { __builtin_amdgcn_s_sleep(1); \
    if ((++_sp & 255u) == 0u) { if (xb_ld(&(bar)[XB_TMO])) break; if (_sp > XB_SPIN_CAP) { atomicAdd(&(bar)[XB_TMO], 1u); break; } } } } while (0)
struct XcdBarrier { unsigned* bar; unsigned x; volatile LAS unsigned* st; };
__device__ __forceinline__ XcdBarrier xcd_barrier_post(unsigned* bar, volatile LAS unsigned* st) {
    XcdBarrier b; b.bar = bar; b.x = xb_xcc_id(); b.st = st;
    if (threadIdx.x == 0) (void)xb_add(&bar[XB_XCNT(b.x)], 1u);
    return b;
}
__device__ __forceinline__ void xcd_barrier_complete(unsigned* bar, unsigned x, unsigned& nloc, unsigned& nx) {
    const unsigned G = gridDim.x * gridDim.y * gridDim.z;
    unsigned sum, cnt, mine, sp = 0u;
    for (;;) {
        sum = 0u; cnt = 0u; mine = 0u;
#pragma unroll
        for (unsigned j = 0; j < 16; ++j) { const unsigned c = xb_ld(&bar[XB_XCNT(j)]); sum += c; cnt += (c > 0u) ? 1u : 0u; mine = (j == x) ? c : mine; }
        if (sum == G) break;
        __builtin_amdgcn_s_sleep(1);
        if ((++sp & 255u) == 0u) { if (xb_ld(&bar[XB_TMO])) break; if (sp > XB_SPIN_CAP) { atomicAdd(&bar[XB_TMO], 1u); break; } }
    }
    nloc = mine > 0u ? mine : 1u; nx = cnt > 0u ? cnt : 1u;
}
__device__ __forceinline__ void xcd_barrier(const XcdBarrier& b) {
    asm volatile("s_waitcnt vmcnt(0)" ::: "memory");
    __syncthreads();
    if (threadIdx.x == 0) {
        unsigned* bar = b.bar;
        __builtin_amdgcn_s_waitcnt(0);
        unsigned nloc = b.st[0], nx = b.st[1];
        if (nloc == 0u) { xcd_barrier_complete(bar, b.x, nloc, nx); b.st[0] = nloc; b.st[1] = nx; }
        const unsigned old = xb_add(&bar[XB_XSUB(b.x)], 1u);
        const unsigned gen = old / nloc;
        if (old + 1u == (gen + 1u) * nloc) {
            __builtin_amdgcn_fence(__ATOMIC_RELEASE, "agent");
            asm volatile("s_waitcnt vmcnt(0)" ::: "memory");
            const unsigned og = xb_add(&bar[XB_TOP], 1u);
            const unsigned tg = og / nx;
            if (og + 1u == (tg + 1u) * nx) xb_add(&bar[XB_TOPGEN], 1u);
            else XB_SPIN(xb_ld(&bar[XB_TOPGEN]) == tg, bar);
            __builtin_amdgcn_fence(__ATOMIC_ACQUIRE, "agent");
            xb_add(&bar[XB_XGEN(b.x)], 1u);
            asm volatile("s_waitcnt vmcnt(0)" ::: "memory");
        } else {
            XB_SPIN(xb_ld(&bar[XB_XGEN(b.x)]) == gen, bar);
            __builtin_amdgcn_fence(__ATOMIC_ACQUIRE, "agent");
            asm volatile("s_waitcnt vmcnt(0)" ::: "memory");
        }
    }
    __syncthreads();
}

struct Frame {
    LAS unsigned char* lds;
    int tid, lane, wave, vcu, G;
    const float* const* in; float* out; unsigned char* ws;
};
constexpr int LDS_RING = 131072;
constexpr int LDS_MISC = LDS_RING;
constexpr int LDS_BYTES = 147456;

template <class Map>
DI void p0_transpose_item(const float* W, int K, int N, bf16_t* WT, const Map& map, LAS float* scr_, int item, int lane) {
    LAS unsigned char* scr = (LAS unsigned char*)scr_;
    const int nblk = (N + 63) / 64, kb = item / nblk, nb = item % nblk, k0 = 64 * kb, n0 = 64 * nb;
    const int kk = lane >> 4, n4 = 4 * (lane & 15);
    const bool nok = (n0 + n4) < N;
    f32x4 v[16];
#pragma unroll
    for (int i = 0; i < 16; ++i) v[i] = nok ? *(const f32x4*)(W + (size_t)(k0 + 16 * kk + i) * N + n0 + n4) : (f32x4){0.f, 0.f, 0.f, 0.f};
#pragma unroll
    for (int c = 0; c < 4; ++c) {
        u32x4 lo, hi;
        lo.x = pk2(v[0][c], v[1][c]); lo.y = pk2(v[2][c], v[3][c]); lo.z = pk2(v[4][c], v[5][c]); lo.w = pk2(v[6][c], v[7][c]);
        hi.x = pk2(v[8][c], v[9][c]); hi.y = pk2(v[10][c], v[11][c]); hi.z = pk2(v[12][c], v[13][c]); hi.w = pk2(v[14][c], v[15][c]);
        *(LAS u32x4*)(scr + (n4 + c) * 144 + kk * 32) = lo; *(LAS u32x4*)(scr + (n4 + c) * 144 + kk * 32 + 16) = hi;
    }
    LDS_WAIT(); asm volatile("" ::: "memory");
#pragma unroll
    for (int j = 0; j < 8; ++j) { const int n = (lane >> 3) + 8 * j, ch = lane & 7;
        const u32x4 o = *(const LAS u32x4*)(scr + n * 144 + ch * 16);
        if (n0 + n < N) *(u32x4*)(WT + (size_t)map(n0 + n) * K + k0 + 8 * ch) = o; }
    LDS_WAIT(); asm volatile("" ::: "memory");
}
template <class Map>
DI void p0_transpose_item_f8(const float* W, int K, int N, unsigned char* WT, const Map& map, LAS float* scr_, int item, int lane) {
    LAS unsigned char* scr = (LAS unsigned char*)scr_;
    const int nblk = (N + 63) / 64, kb = item / nblk, nb = item % nblk, k0 = 64 * kb, n0 = 64 * nb;
    const int kk = lane >> 4, n4 = 4 * (lane & 15);
    const bool nok = (n0 + n4) < N;
    f32x4 v[16];
#pragma unroll
    for (int i = 0; i < 16; ++i) v[i] = nok ? *(const f32x4*)(W + (size_t)(k0 + 16 * kk + i) * N + n0 + n4) * 32.0f : (f32x4){0.f, 0.f, 0.f, 0.f};
#pragma unroll
    for (int c = 0; c < 4; ++c) { int w[4];
#pragma unroll
        for (int q = 0; q < 4; ++q) { int x = 0; x = __builtin_amdgcn_cvt_pk_fp8_f32(v[4 * q][c], v[4 * q + 1][c], x, false); x = __builtin_amdgcn_cvt_pk_fp8_f32(v[4 * q + 2][c], v[4 * q + 3][c], x, true); w[q] = x; }
        *(LAS u32x4*)(scr + (n4 + c) * 80 + kk * 16) = (u32x4){(unsigned)w[0], (unsigned)w[1], (unsigned)w[2], (unsigned)w[3]}; }
    LDS_WAIT(); asm volatile("" ::: "memory");
#pragma unroll
    for (int j = 0; j < 4; ++j) { const int n = (lane >> 2) + 16 * j, ch = lane & 3;
        const u32x4 o = *(const LAS u32x4*)(scr + n * 80 + ch * 16);
        if (n0 + n < N) *(u32x4*)(WT + (size_t)map(n0 + n) * K + k0 + 16 * ch) = o; }
    LDS_WAIT(); asm volatile("" ::: "memory");
}
struct MapId { int off; DI int operator()(int n) const { return n + off; } };
DI int rope_perm(int d) { return (d & 15) | ((d & 16) << 1) | ((d & 32) >> 1); }
struct MapL1In { DI int operator()(int n) const {
    if (n < 1024) return (n & ~63) | rope_perm(n & 63);
    if (n < 2560) { const int j = (n - 1024) >> 8; return (j & 1) ? n : ((n & ~63) | rope_perm(n & 63)); }
    return n; } };
struct MapGU { int up; DI int operator()(int c) const { return (c >> 7) * 256 + up * 128 + (c & 127); } };

DI void p0_prep(Frame& F) {
    LAS float* scr = (LAS float*)(F.lds + F.wave * 16384);
    const int gw = F.vcu * NWAVES + F.wave, NGW = F.G * NWAVES;
    const int gt = F.vcu * NTHR + F.tid, NGT = F.G * NTHR;
    unsigned char* ws = F.ws;
    for (int i = gt; i < CTL_WORDS; i += NGT) ((unsigned*)(ws + WS_CTL))[i] = 0u;
    constexpr int I_W0IN = 16 * 40, I_W0OUT = 16 * 16, I_W1IN = 16 * 41, I_W1OUT = 16 * 16, I_WC1 = 32 * 4, I_WC2 = 4 * 1, I_MOE = 32 * 128;
    constexpr int NITEMS = I_W0IN + I_W0OUT + I_W1IN + I_W1OUT + 2 * I_WC1 + 2 * I_WC2 + 3 * I_MOE;
    for (int it = gw; it < NITEMS; it += NGW) {
        int r = it;
        if (r < I_W0IN) { p0_transpose_item(F.in[1], 1024, L0N, (bf16_t*)(ws + WS_W0IN), MapId{0}, scr, r, F.lane); continue; } r -= I_W0IN;
        if (r < I_W0OUT) { p0_transpose_item(F.in[10], 1024, 1024, (bf16_t*)(ws + WS_W0OUT), MapId{0}, scr, r, F.lane); continue; } r -= I_W0OUT;
        if (r < I_W1IN) { p0_transpose_item_f8(F.in[22], 1024, L1N, ws + WS_W1IN, MapL1In{}, scr, r, F.lane); continue; } r -= I_W1IN;
        if (r < I_W1OUT) { p0_transpose_item_f8(F.in[29], 1024, 1024, ws + WS_W1OUT, MapId{0}, scr, r, F.lane); continue; } r -= I_W1OUT;
        if (r < I_WC1) { p0_transpose_item(F.in[24], 2048, 256, (bf16_t*)(ws + WS_WC1), MapId{0}, scr, r, F.lane); continue; } r -= I_WC1;
        if (r < I_WC1) { p0_transpose_item(F.in[27], 2048, 256, (bf16_t*)(ws + WS_WC1) + 256 * 2048, MapId{0}, scr, r, F.lane); continue; } r -= I_WC1;
        if (r < I_WC2) { p0_transpose_item(F.in[25], 256, 64, (bf16_t*)(ws + WS_WC2), MapId{0}, scr, r, F.lane); continue; } r -= I_WC2;
        if (r < I_WC2) { p0_transpose_item(F.in[28], 256, 64, (bf16_t*)(ws + WS_WC2) + 256 * 256, MapId{0}, scr, r, F.lane); continue; } r -= I_WC2;
#pragma unroll 1
        for (int l = 0; l < 1; ++l) {
            const int ib = l ? 36 : 17; unsigned char* wgu = ws + (l ? WS_WGU1 : WS_WGU0); unsigned char* wd = ws + (l ? WS_WD1 : WS_WD0);
            if (r < I_MOE) { const int e = r >> 7; p0_transpose_item_f8(F.in[ib] + (size_t)e * 1024 * 512, 1024, 512, wgu + (size_t)e * 1024 * 1024, MapGU{0}, scr, r & 127, F.lane); r = -1; break; } r -= I_MOE;
            if (r < I_MOE) { const int e = r >> 7; p0_transpose_item_f8(F.in[ib + 1] + (size_t)e * 1024 * 512, 1024, 512, wgu + (size_t)e * 1024 * 1024, MapGU{1}, scr, r & 127, F.lane); r = -1; break; } r -= I_MOE;
            if (r < I_MOE) { const int e = r >> 7; p0_transpose_item_f8(F.in[ib + 2] + (size_t)e * 512 * 1024, 512, 1024, wd + (size_t)e * 1024 * 512, MapId{0}, scr, r & 127, F.lane); r = -1; break; } r -= I_MOE;
        }
    }
    { u32x4 z = (u32x4){0u, 0u, 0u, 0u};
      u32x4* p1 = (u32x4*)(ws + WS_W1IN + (size_t)L1N * 1024); const int n1 = (L1NP - L1N) * 1024 / 16;
      for (int i = gt; i < n1; i += NGT) p1[i] = z;
      for (int kv = 0; kv < 2; ++kv) { u32x4* p2 = (u32x4*)((bf16_t*)(ws + WS_WC2) + (size_t)kv * 65536 + 64 * 256); const int n2 = 192 * 256 / 8; for (int i = gt; i < n2; i += NGT) p2[i] = z; } }
    { const float* x = F.in[0]; bf16_t* xb = (bf16_t*)(ws + WS_XB);
      for (int m = gw; m < T; m += NGW) { const f32x4* xr = (const f32x4*)(x + (size_t)m * D) + F.lane; u32x2* o = (u32x2*)(xb + (size_t)m * D) + F.lane;
#pragma unroll
          for (int j = 0; j < 4; ++j) { const f32x4 v = xr[64 * j]; o[64 * j] = (u32x2){pk2(v.x, v.y), pk2(v.z, v.w)}; } } }
    { float* ct = (float*)(ws + WS_COS); float* st = (float*)(ws + WS_SIN);
      for (int i = gt; i < SEQ * 32; i += NGT) { const int pos = i >> 5, k = i & 31; const float inv = (float)pow(10000.0, -(double)(2 * k) / 64.0); const float ang = (float)pos * inv;
          ct[i] = (float)cos((double)ang); st[i] = (float)sin((double)ang); } }
    { bf16_t* bt = (bf16_t*)(ws + WS_SMALL + SM_LRUBT);
      for (int i = gt; i < 2 * 8 * 4096; i += NGT) { const int g = i >> 15, h = (i >> 12) & 7, j = (i >> 6) & 63, ii = i & 63; const float* w = F.in[g ? 7 : 5];
          bt[i] = (bf16_t)f2bf(w[h * 4096 + ii * 64 + j]); } }
    { float* rw = (float*)(ws + WS_SMALL + SM_RWT);
      for (int i = gt; i < 2 * 36 * 1024; i += NGT) { const int l = i / (36 * 1024), o = (i / 1024) % 36, k = i & 1023; const float* wg = F.in[l ? 32 : 13]; const float* we = F.in[l ? 34 : 15];
          rw[i] = o < 4 ? wg[k * 4 + o] : we[k * 32 + (o - 4)]; } }
    { float* cb = (float*)(ws + WS_SMALL + SM_CBIAS);
      for (int o = gw; o < 512; o += NGW) { const int kv = o >> 8, j = o & 255; const float* pe = F.in[kv ? 26 : 23]; const float* w1 = F.in[kv ? 27 : 24];
          float s = 0.f; for (int k = F.lane; k < 2048; k += 64) s += pe[k] * w1[(size_t)k * 256 + j];
          s = wave_sum(s); if (F.lane == 0) cb[o] = s; } }
}

DI void p0_moe1(Frame& F, int first) {
    LAS float* scr = (LAS float*)(F.lds + F.wave * 16384);
    const int nb = F.G - first; if (nb <= 0 || (int)blockIdx.x < first) return;
    const int gw = ((int)blockIdx.x - first) * NWAVES + F.wave, NGW = nb * NWAVES;
    unsigned char* ws = F.ws; constexpr int I_MOE = 32 * 128;
    unsigned char* wgu = ws + WS_WGU1; unsigned char* wd = ws + WS_WD1;
    for (int it = gw; it < 3 * I_MOE; it += NGW) {
        int r = it;
        if (r < I_MOE) { const int e = r >> 7; p0_transpose_item_f8(F.in[36] + (size_t)e * 1024 * 512, 1024, 512, wgu + (size_t)e * 1024 * 1024, MapGU{0}, scr, r & 127, F.lane); continue; } r -= I_MOE;
        if (r < I_MOE) { const int e = r >> 7; p0_transpose_item_f8(F.in[37] + (size_t)e * 1024 * 512, 1024, 512, wgu + (size_t)e * 1024 * 1024, MapGU{1}, scr, r & 127, F.lane); continue; } r -= I_MOE;
        { const int e = r >> 7; p0_transpose_item_f8(F.in[38] + (size_t)e * 512 * 1024, 512, 1024, wd + (size_t)e * 1024 * 512, MapId{0}, scr, r & 127, F.lane); }
    }
}

constexpr int XCL_STRIDE = 520;
constexpr int LDS_XC = 0, LDS_GT = 66560, LDS_HIN = 133120;
DI f32x2 lds_swap(float v) { auto rr = __builtin_amdgcn_permlane32_swap(__float_as_uint(v), __float_as_uint(v), false, false); return (f32x2){__uint_as_float(rr[0]), __uint_as_float(rr[1])}; }

template <int CTRL> DI float quad_xor(float v) { return __int_as_float(__builtin_amdgcn_mov_dpp(__float_as_int(v), CTRL, 0xF, 0xF, true)); }

template <bool FINAL>
DI void lru_tile(Frame& F, int b, int ch) {
    const unsigned char* ws = F.ws;
    const bf16_t* z = (const bf16_t*)(ws + WS_Z);
    bf16_t* ycat = (bf16_t*)(ws + WS_XB);
    f32x2* SAH = (f32x2*)(ws + WS_SCAN);
    LAS bf16_t* xcL = (LAS bf16_t*)(F.lds + LDS_XC); LAS bf16_t* gL = (LAS bf16_t*)(F.lds + LDS_GT); LAS float* hin = (LAS float*)(F.lds + LDS_HIN);
    const int tid = F.tid, lane = F.lane, wave = F.wave;
    const int t0 = ch * 64; const size_t row0 = (size_t)b * SEQ + t0;
    const int c8 = tid & 63, tg = tid >> 6;
    {
        float w[4][8], bias[8];
        const float* cw = F.in[3]; const float* cbv = F.in[4];
#pragma unroll
        for (int k = 0; k < 4; ++k)
#pragma unroll
            for (int j = 0; j < 8; ++j) w[k][j] = cw[k * 512 + c8 * 8 + j];
#pragma unroll
        for (int j = 0; j < 8; ++j) bias[j] = cbv[c8 * 8 + j];
        float xv[11][8];
#pragma unroll
        for (int i = 0; i < 11; ++i) { const int t = t0 + tg * 8 + i - 3;
            if (t >= 0) { const u32x4 v = *(const u32x4*)(z + ((size_t)b * SEQ + t) * L0N + 2048 + c8 * 8);
                xv[i][0] = bflo(v.x); xv[i][1] = bfhi(v.x); xv[i][2] = bflo(v.y); xv[i][3] = bfhi(v.y); xv[i][4] = bflo(v.z); xv[i][5] = bfhi(v.z); xv[i][6] = bflo(v.w); xv[i][7] = bfhi(v.w); }
            else {
#pragma unroll
                for (int j = 0; j < 8; ++j) xv[i][j] = 0.f; } }
#pragma unroll
        for (int i = 0; i < 8; ++i) { float o[8];
#pragma unroll
            for (int j = 0; j < 8; ++j) o[j] = bias[j] + w[0][j] * xv[i][j] + w[1][j] * xv[i + 1][j] + w[2][j] * xv[i + 2][j] + w[3][j] * xv[i + 3][j];
            u32x4 pk; pk.x = pk2(o[0], o[1]); pk.y = pk2(o[2], o[3]); pk.z = pk2(o[4], o[5]); pk.w = pk2(o[6], o[7]);
            *(LAS u32x4*)(xcL + (tg * 8 + i) * XCL_STRIDE + c8 * 8) = pk; }
    }
    if constexpr (FINAL) {
#pragma unroll
        for (int i = 0; i < 8; ++i) { const int tl = tg * 8 + i; const u32x4 v = *(const u32x4*)(z + (row0 + tl) * L0N + 1536 + c8 * 8); *(LAS u32x4*)(gL + tl * XCL_STRIDE + c8 * 8) = v; }
        float w[3][8]; const float* cw = F.in[2];
#pragma unroll
        for (int k = 0; k < 3; ++k)
#pragma unroll
            for (int j = 0; j < 8; ++j) w[k][j] = cw[k * 512 + c8 * 8 + j];
        float pv[10][8];
#pragma unroll
        for (int i = 0; i < 10; ++i) { const int t = t0 + tg * 8 + i - 2;
            if (t >= 0) { const bf16_t* zr = z + ((size_t)b * SEQ + t) * L0N + c8 * 8; const u32x4 a = *(const u32x4*)(zr + 512), c = *(const u32x4*)(zr + 1024);
                pv[i][0] = bflo(a.x) * bflo(c.x); pv[i][1] = bfhi(a.x) * bfhi(c.x); pv[i][2] = bflo(a.y) * bflo(c.y); pv[i][3] = bfhi(a.y) * bfhi(c.y);
                pv[i][4] = bflo(a.z) * bflo(c.z); pv[i][5] = bfhi(a.z) * bfhi(c.z); pv[i][6] = bflo(a.w) * bflo(c.w); pv[i][7] = bfhi(a.w) * bfhi(c.w); }
            else {
#pragma unroll
                for (int j = 0; j < 8; ++j) pv[i][j] = 0.f; } }
#pragma unroll
        for (int i = 0; i < 8; ++i) { const int tl = tg * 8 + i; const u32x4 bgv = *(const u32x4*)(z + (row0 + tl) * L0N + c8 * 8);
            const float bgf[8] = {bflo(bgv.x), bfhi(bgv.x), bflo(bgv.y), bfhi(bgv.y), bflo(bgv.z), bfhi(bgv.z), bflo(bgv.w), bfhi(bgv.w)};
            float o[8];
#pragma unroll
            for (int j = 0; j < 8; ++j) o[j] = bgf[j] * (w[0][j] * pv[i][j] + w[1][j] * pv[i + 1][j] + w[2][j] * pv[i + 2][j]);
            u32x4 pk; pk.x = pk2(o[0], o[1]); pk.y = pk2(o[2], o[3]); pk.z = pk2(o[4], o[5]); pk.w = pk2(o[6], o[7]);
            *(u32x4*)(ycat + (row0 + tl) * D + c8 * 8) = pk; }
        { float h = 0.f; const f32x4* sp4 = (const f32x4*)(SAH + ((size_t)b * 512 + tid) * 128);
#pragma unroll 8
          for (int k2 = 0; k2 < (ch >> 1); ++k2) { const f32x4 v = sp4[k2]; h = v.x * h + v.y; h = v.z * h + v.w; }
          if (ch & 1) { const f32x2 v = SAH[((size_t)b * 512 + tid) * 128 + ch - 1]; h = v.x * h + v.y; }
          hin[tid] = h; }
    }
    __syncthreads();
    {
        const int head = wave, r32 = lane & 31, hh = lane >> 5;
        const bf16_t* lbt = (const bf16_t*)(ws + WS_SMALL + SM_LRUBT);
        const float* b_a = F.in[6]; const float* b_x = F.in[8]; const float* lam = F.in[9];
#pragma unroll 1
        for (int ct = 0; ct < 2; ++ct) {
            const int c = head * 64 + ct * 32 + r32;
            f32x16 acc[2][2];
#pragma unroll
            for (int g = 0; g < 2; ++g)
#pragma unroll
                for (int rt = 0; rt < 2; ++rt)
#pragma unroll
                    for (int i = 0; i < 16; ++i) acc[g][rt][i] = 0.f;
#pragma unroll
            for (int ks = 0; ks < 4; ++ks) {
                bf16x8 af[2], bfr[2];
#pragma unroll
                for (int rt = 0; rt < 2; ++rt) af[rt] = *(const LAS bf16x8*)(xcL + (rt * 32 + r32) * XCL_STRIDE + head * 64 + ks * 16 + hh * 8);
#pragma unroll
                for (int g = 0; g < 2; ++g) bfr[g] = *(const bf16x8*)(lbt + ((size_t)(g * 8 + head) * 64 + ct * 32 + r32) * 64 + ks * 16 + hh * 8);
#pragma unroll
                for (int g = 0; g < 2; ++g)
#pragma unroll
                    for (int rt = 0; rt < 2; ++rt) acc[g][rt] = __builtin_amdgcn_mfma_f32_32x32x16_bf16(af[rt], bfr[g], acc[g][rt], 0, 0, 0);
            }
            const float ba = b_a[c], bx = b_x[c]; const float lm = lam[c];
            const float sp = (lm > 15.f) ? __expf(-lm) : log1pf(__expf(-lm));
            float carry = FINAL ? hin[c] : 0.f, atot = 1.f;
#pragma unroll
            for (int rt = 0; rt < 2; ++rt) {
#pragma unroll
                for (int g4 = 0; g4 < 4; ++g4) {
                    float av[4], uv[4]; float Ag = 1.f, Hg = 0.f;
#pragma unroll
                    for (int j = 0; j < 4; ++j) { const int reg = g4 * 4 + j; const int tl = rt * 32 + 8 * g4 + 4 * hh + j;
                        const float r = sigmoidf_(acc[0][rt][reg] + ba), ig = sigmoidf_(acc[1][rt][reg] + bx);
                        const float a = __builtin_amdgcn_exp2f(-11.541560327111707f * r * sp); const float mult = __builtin_amdgcn_sqrtf(fmaxf((1.0f - a) * (1.0f + a), 0.f));
                        const float xc = bf2f(xcL[tl * XCL_STRIDE + c]);
                        av[j] = a; uv[j] = mult * ig * xc; Ag = a * Ag; Hg = a * Hg + uv[j]; }
                    const f32x2 As = lds_swap(Ag), Hs = lds_swap(Hg);
                    const float mid = As[0] * carry + Hs[0];
                    if constexpr (FINAL) {
                        float s = hh ? mid : carry;
#pragma unroll
                        for (int j = 0; j < 4; ++j) { const int tl = rt * 32 + 8 * g4 + 4 * hh + j; s = av[j] * s + uv[j];
                            const float gv = bf2f(gL[tl * XCL_STRIDE + c]); gL[tl * XCL_STRIDE + c] = (bf16_t)f2bf(s * gelu_tanh(gv)); }
                    }
                    carry = As[1] * mid + Hs[1]; atot = atot * As[0] * As[1];
                }
            }
            if constexpr (!FINAL) { if (hh == 0) SAH[((size_t)b * 512 + c) * 128 + ch] = (f32x2){atot, carry}; }
        }
    }
    __syncthreads();
    if constexpr (FINAL) {
#pragma unroll
        for (int i = 0; i < 8; ++i) { const int tl = tg * 8 + i; const u32x4 v = *(const LAS u32x4*)(gL + tl * XCL_STRIDE + c8 * 8); *(u32x4*)(ycat + (row0 + tl) * D + 512 + c8 * 8) = v; }
        __syncthreads();
    }
}

constexpr int LDS_RI = 0;
constexpr int LDS_HIST = 4096;
DI void ln_router_phase(Frame& F, int layer, const bf16_t* src) {
    bf16_t* xb = (bf16_t*)(F.ws + WS_XB); unsigned char* x8 = F.ws + WS_X8;
    const float* gam = F.in[layer ? 30 : 11]; const float* bet = F.in[layer ? 31 : 12];
    const float* rw = (const float*)(F.ws + WS_SMALL + SM_RWT) + (size_t)layer * 36 * 1024;
    const float* bg = F.in[layer ? 33 : 14]; const float* be = F.in[layer ? 35 : 16];
    unsigned* cnt = (unsigned*)(F.ws + WS_CTL) + CW_CNT + layer * 32;
    unsigned* list = (unsigned*)(F.ws + WS_LIST); float* wslot = (float*)(F.ws + WS_WSLOT); unsigned* posloc = (unsigned*)(F.ws + WS_POSLOC);
    LAS int* e0s = (LAS int*)(F.lds + LDS_RI); LAS int* e1s = e0s + 128; LAS float* w0s = (LAS float*)(e1s + 128); LAS float* w1s = w0s + 128;
    LAS int* hist = (LAS int*)(F.lds + LDS_HIST); LAS int* base = hist + 32;
    const int lane = F.lane;
    f32x4 gv[4], bv[4];
#pragma unroll
    for (int j = 0; j < 4; ++j) { gv[j] = ((const f32x4*)gam)[lane + 64 * j]; bv[j] = ((const f32x4*)bet)[lane + 64 * j]; }
    for (int chunk = F.vcu; chunk < T / 128; chunk += F.G) {
        if (F.tid < 32) hist[F.tid] = 0;
        __syncthreads();
        for (int rr = F.wave; rr < 128; rr += NWAVES) {
            const size_t row = (size_t)chunk * 128 + rr;
            const u32x2* xr = (const u32x2*)(src + row * D) + lane;
            f32x4 v[4]; float s = 0.f;
#pragma unroll
            for (int j = 0; j < 4; ++j) { const u32x2 q = xr[64 * j]; v[j] = (f32x4){bflo(q.x), bfhi(q.x), bflo(q.y), bfhi(q.y)}; s += (v[j].x + v[j].y) + (v[j].z + v[j].w); }
            const float mean = wave_sum(s) * (1.f / D); float s2 = 0.f;
#pragma unroll
            for (int j = 0; j < 4; ++j) { v[j] = v[j] - mean; s2 += (v[j].x * v[j].x + v[j].y * v[j].y) + (v[j].z * v[j].z + v[j].w * v[j].w); }
            const float rstd = 1.f / sqrtf(wave_sum(s2) * (1.f / D) + LN_EPS);
            u32x2* ob = (u32x2*)(xb + row * D) + lane;
#pragma unroll
            for (int j = 0; j < 4; ++j) { v[j] = v[j] * rstd * gv[j] + bv[j]; ob[64 * j] = (u32x2){pk2(v[j].x, v[j].y), pk2(v[j].z, v[j].w)};
                int w8 = 0; w8 = __builtin_amdgcn_cvt_pk_fp8_f32(v[j].x, v[j].y, w8, false); w8 = __builtin_amdgcn_cvt_pk_fp8_f32(v[j].z, v[j].w, w8, true); ((unsigned*)(x8 + row * D))[lane + 64 * j] = (unsigned)w8; }
            float gl[4];
#pragma unroll
            for (int o = 0; o < 4; ++o) { const f32x4* wr_ = (const f32x4*)(rw + o * 1024) + lane; float a = 0.f;
#pragma unroll
                for (int j = 0; j < 4; ++j) { const f32x4 w = wr_[64 * j]; a += (v[j].x * w.x + v[j].y * w.y) + (v[j].z * w.z + v[j].w * w.w); }
                gl[o] = wave_sum(a) + bg[o]; }
            float g0 = gl[0]; int gs = 0;
#pragma unroll
            for (int o = 1; o < 4; ++o) if (gl[o] > g0) { g0 = gl[o]; gs = o; }
            float gsum = 0.f;
#pragma unroll
            for (int o = 0; o < 4; ++o) gsum += __expf(gl[o] - g0);
            const float pgrp = 1.0f / gsum;
            gs = __builtin_amdgcn_readfirstlane(gs);
            float le[8];
#pragma unroll
            for (int hf = 0; hf < 2; ++hf) {
#pragma unroll
                for (int oo = 0; oo < 4; ++oo) { const int o = hf * 4 + oo; const f32x4* wr_ = (const f32x4*)(rw + (4 + gs * 8 + o) * 1024) + lane; float a = 0.f;
#pragma unroll
                    for (int j = 0; j < 4; ++j) { const f32x4 w = wr_[64 * j]; a += (v[j].x * w.x + v[j].y * w.y) + (v[j].z * w.z + v[j].w * w.w); }
                    le[o] = wave_sum(a) + be[gs * 8 + o]; }
                asm volatile("" ::: "memory"); }
            float m0 = le[0]; int i0 = 0;
#pragma unroll
            for (int o = 1; o < 8; ++o) if (le[o] > m0) { m0 = le[o]; i0 = o; }
            float m1 = -3.0e38f; int i1 = 0;
#pragma unroll
            for (int o = 0; o < 8; ++o) if (o != i0 && le[o] > m1) { m1 = le[o]; i1 = o; }
            const float e1 = __expf(m1 - m0); const float w0 = pgrp / (1.0f + e1), w1 = pgrp * e1 / (1.0f + e1);
            if (lane == 0) { e0s[rr] = gs * 8 + i0; e1s[rr] = gs * 8 + i1; w0s[rr] = w0; w1s[rr] = w1; }
        }
        __syncthreads();
        int myrank = 0, mye = 0;
        if (F.tid < 256) { const int rr = F.tid >> 1, k = F.tid & 1; mye = k ? e1s[rr] : e0s[rr]; myrank = atomicAdd((int*)&hist[mye], 1); }
        __syncthreads();
        if (F.tid < 32) { const int h = hist[F.tid]; base[F.tid] = h ? (int)atomicAdd(&cnt[F.tid], (unsigned)h) : 0; }
        __syncthreads();
        if (F.tid < 256) { const int rr = F.tid >> 1, k = F.tid & 1; const unsigned slot = (unsigned)((chunk * 128 + rr) * 2 + k);
            const int li = base[mye] + myrank; list[(size_t)mye * T + li] = slot; wslot[slot] = k ? w1s[rr] : w0s[rr]; posloc[slot] = ((unsigned)mye << 20) | (unsigned)li; }
        __syncthreads();
    }
}

DI MoeTab moe_tables(Frame& F, int layer) {
    LAS int* tb = (LAS int*)(F.lds + LDS_MISC); LAS int* cn = tb + 64; LAS int* nt = cn + 64;
    const unsigned* cnt = (const unsigned*)(F.ws + WS_CTL) + CW_CNT + layer * 32;
    if (F.tid < 32) cn[F.tid] = (int)__hip_atomic_load(cnt + F.tid, __ATOMIC_RELAXED, __HIP_MEMORY_SCOPE_AGENT);
    __syncthreads();
    if (F.tid == 0) { int acc = 0; for (int e = 0; e < 32; ++e) { tb[e] = acc; acc += (cn[e] + 255) >> 8; } tb[32] = acc; nt[0] = acc; }
    __syncthreads();
    MoeTab t; t.tbase = tb; t.cnt = cn; t.ntiles = nt[0]; return t;
}

template <bool FINAL_F32>
DI void ln2_phase(Frame& F, int layer, const MoeTab& tab, bf16_t* dst16, float* dst32, unsigned char* dst8) {
    const bf16_t* x1 = (const bf16_t*)(F.ws + WS_XB); const bf16_t* Y = (const bf16_t*)(F.ws + WS_Y);
    const float* wslot = (const float*)(F.ws + WS_WSLOT); const unsigned* posloc = (const unsigned*)(F.ws + WS_POSLOC);
    const float* gam = F.in[layer ? 39 : 20]; const float* bet = F.in[layer ? 40 : 21];
    const int lane = F.lane; const int gw = F.vcu * NWAVES + F.wave, NGW = F.G * NWAVES;
    f32x4 gv[4], bv[4];
#pragma unroll
    for (int j = 0; j < 4; ++j) { gv[j] = ((const f32x4*)gam)[lane + 64 * j]; bv[j] = ((const f32x4*)bet)[lane + 64 * j]; }
#pragma unroll 2
    for (int row = gw; row < T; row += NGW) {
        const unsigned pl0 = posloc[2 * row], pl1 = posloc[2 * row + 1]; const float w0 = wslot[2 * row], w1 = wslot[2 * row + 1];
        const size_t h0 = (size_t)tab.tbase[pl0 >> 20] * 256 + (pl0 & 0xfffffu), h1 = (size_t)tab.tbase[pl1 >> 20] * 256 + (pl1 & 0xfffffu);
        const u32x2* xr = (const u32x2*)(x1 + (size_t)row * D) + lane;
        const u32x2* y0 = (const u32x2*)(Y + h0 * D) + lane; const u32x2* y1 = (const u32x2*)(Y + h1 * D) + lane;
        f32x4 v[4]; float s = 0.f;
#pragma unroll
        for (int j = 0; j < 4; ++j) { const u32x2 a = y0[64 * j], c = y1[64 * j], q = xr[64 * j];
            v[j].x = bflo(q.x) * DN_ALPHA + (w0 * bflo(a.x) + w1 * bflo(c.x)); v[j].y = bfhi(q.x) * DN_ALPHA + (w0 * bfhi(a.x) + w1 * bfhi(c.x));
            v[j].z = bflo(q.y) * DN_ALPHA + (w0 * bflo(a.y) + w1 * bflo(c.y)); v[j].w = bfhi(q.y) * DN_ALPHA + (w0 * bfhi(a.y) + w1 * bfhi(c.y));
            s += (v[j].x + v[j].y) + (v[j].z + v[j].w); }
        const float mean = wave_sum(s) * (1.f / D); float s2 = 0.f;
#pragma unroll
        for (int j = 0; j < 4; ++j) { v[j] = v[j] - mean; s2 += (v[j].x * v[j].x + v[j].y * v[j].y) + (v[j].z * v[j].z + v[j].w * v[j].w); }
        const float rstd = 1.f / sqrtf(wave_sum(s2) * (1.f / D) + LN_EPS);
#pragma unroll
        for (int j = 0; j < 4; ++j) { v[j] = v[j] * rstd * gv[j] + bv[j];
            if (FINAL_F32) ((f32x4*)(dst32 + (size_t)row * D))[lane + 64 * j] = v[j];
            else { ((u32x2*)(dst16 + (size_t)row * D))[lane + 64 * j] = (u32x2){pk2(v[j].x, v[j].y), pk2(v[j].z, v[j].w)};
                int w8 = 0; w8 = __builtin_amdgcn_cvt_pk_fp8_f32(v[j].x, v[j].y, w8, false); w8 = __builtin_amdgcn_cvt_pk_fp8_f32(v[j].z, v[j].w, w8, true); ((unsigned*)(dst8 + (size_t)row * D))[lane + 64 * j] = (unsigned)w8; } }
    }
}

constexpr float QSCALE = 0.125f * 1.4426950408889634f;
struct GemmL1In {
    static constexpr bool AUNI = true;
    static constexpr bool FP8 = true;
    static constexpr bool PERM = false;
    const char* A; int K; unsigned lda2, ldb2; const char* Bt; pg8::TileOrder ord;
    bf16_t* Q; unsigned char* KV; float* gates; const float* cosT; const float* sinT;
    DI bool next(int i, GU& u) const { return ord.next(i, u); }
    DI unsigned a_row_off(const GU& u, int r) const { return (unsigned)(u.pm * 256 + r) * lda2; }
    DI size_t a_base(const GU& u) const { return (size_t)(u.pm * 256) * lda2; }
    DI const char* b_tile(const GU& u) const { return Bt + (size_t)u.pn * 256 * ldb2; }
    DI void epi(const f32x4 (&acc)[2][2][4][2], const GU& u, int wr, int wc, int fr, int fq) const {
        const int pn = u.pn;
#pragma unroll
        for (int ai = 0; ai < 2; ++ai)
#pragma unroll
            for (int m = 0; m < 4; ++m) {
                const int row = u.pm * 256 + ai * 128 + wr * 64 + m * 16 + fr; const int pos = row & (SEQ - 1), b = row >> 13;
                if (pn == 10) {
                    if (wc < 2) {
#pragma unroll
                        for (int n = 0; n < 2; ++n) { if (n == 1 && wc == 1) continue; const f32x4 v = acc[ai][0][m][n] * 0.03125f;
                            f32x4 o; o.x = sigmoidf_(v.x); o.y = sigmoidf_(v.y); o.z = sigmoidf_(v.z); o.w = sigmoidf_(v.w);
                            *(f32x4*)(gates + (size_t)row * 48 + 32 * wc + 16 * n + 4 * fq) = o; }
                    }
                } else if (pn < 5 || pn == 6 || pn == 8) {
                    const int a = wc & 1, i0 = 16 * a + 4 * fq;
                    const f32x4 c4 = *(const f32x4*)(cosT + pos * 32 + i0), s4 = *(const f32x4*)(sinT + pos * 32 + i0);
#pragma unroll
                    for (int bj = 0; bj < 2; ++bj) { const f32x4 x1 = acc[ai][bj][m][0] * 0.03125f, x2 = acc[ai][bj][m][1] * 0.03125f;
                        f32x4 o1 = x1 * c4 - x2 * s4, o2 = x2 * c4 + x1 * s4;
                        const int hl = bj * 2 + (wc >> 1); bf16_t* dst;
                        if (pn < 4) { o1 = o1 * QSCALE; o2 = o2 * QSCALE; dst = Q + ((size_t)row * 16 + pn * 4 + hl) * 64; }
                        else dst = (bf16_t*)(KV + (size_t)(pn - 4) * KV_STRIDE) + ((size_t)(b * 4 + hl) * SEQ + pos) * 64;
                        *(u32x2*)(dst + i0) = (u32x2){cvt_pk_bf16(o1.x, o1.y), cvt_pk_bf16(o1.z, o1.w)};
                        *(u32x2*)(dst + 32 + i0) = (u32x2){cvt_pk_bf16(o2.x, o2.y), cvt_pk_bf16(o2.z, o2.w)}; }
                } else {
#pragma unroll
                    for (int bj = 0; bj < 2; ++bj) { const int gg = bj * 2 + (wc >> 1);
                        bf16_t* dst = (bf16_t*)(KV + (size_t)(pn - 4) * KV_STRIDE) + ((size_t)(b * 4 + gg) * SEQ + pos) * 64 + 32 * (wc & 1) + 4 * fq;
#pragma unroll
                        for (int n = 0; n < 2; ++n) { const f32x4 v = acc[ai][bj][m][n] * 0.03125f; *(u32x2*)(dst + 16 * n) = (u32x2){cvt_pk_bf16(v.x, v.y), cvt_pk_bf16(v.z, v.w)}; } }
                }
            }
    }
};
struct GemmCmp1 {
    static constexpr bool AUNI = true;
    static constexpr bool FP8 = false;
    static constexpr bool PERM = true;
    const char* A; int K; unsigned lda2, ldb2; const char* Bt; int G, c;
    const float* cbias; bf16_t* Hd;
    DI bool next(int i, GU& u) const { const int L = i * G + c; if (L >= 64) return false; u.e = L >> 5; u.pm = L & 31; u.pn = 0; return true; }
    DI unsigned a_row_off(const GU& u, int r) const { return (unsigned)u.e * (unsigned)KV_STRIDE + (unsigned)(u.pm * 256 + r) * lda2; }
    DI size_t a_base(const GU& u) const { return (size_t)u.e * KV_STRIDE + (size_t)(u.pm * 256) * lda2; }
    DI const char* b_tile(const GU& u) const { return Bt + (size_t)u.e * 256 * ldb2; }
    DI void epi(const f32x4 (&acc)[2][2][4][2], const GU& u, int wr, int wc, int fr, int fq) const {
        const int row0 = u.pm * 256 + wr * 64 + fr, col0 = wc * 32 + 8 * fq;
        f32x4 bv[2][2];
#pragma unroll
        for (int bj = 0; bj < 2; ++bj)
#pragma unroll
            for (int n = 0; n < 2; ++n) bv[bj][n] = *(const f32x4*)(cbias + u.e * 256 + col0 + bj * 128 + 4 * n);
#pragma unroll
        for (int ai = 0; ai < 2; ++ai)
#pragma unroll
            for (int m = 0; m < 4; ++m) { bf16_t* rowp = Hd + ((size_t)u.e * 8192 + row0 + ai * 128 + m * 16) * 256 + col0;
#pragma unroll
                for (int bj = 0; bj < 2; ++bj) { const f32x4 v0 = acc[ai][bj][m][0] + bv[bj][0], v1 = acc[ai][bj][m][1] + bv[bj][1];
                    u32x4 w; w.x = cvt_pk_bf16(gelu_tanh(v0[0]), gelu_tanh(v0[1])); w.y = cvt_pk_bf16(gelu_tanh(v0[2]), gelu_tanh(v0[3]));
                    w.z = cvt_pk_bf16(gelu_tanh(v1[0]), gelu_tanh(v1[1])); w.w = cvt_pk_bf16(gelu_tanh(v1[2]), gelu_tanh(v1[3]));
                    *(u32x4*)(rowp + bj * 128) = w; } }
    }
};
struct GemmCmp2 {
    static constexpr bool AUNI = true;
    static constexpr bool FP8 = false;
    static constexpr bool PERM = true;
    const char* A; int K; unsigned lda2, ldb2; const char* Bt; int G, c;
    bf16_t* O;
    DI bool next(int i, GU& u) const { const int L = i * G + c; if (L >= 64) return false; u.e = L >> 5; u.pm = L & 31; u.pn = 0; return true; }
    DI unsigned a_row_off(const GU& u, int r) const { return (unsigned)(u.e * 8192 + u.pm * 256 + r) * lda2; }
    DI size_t a_base(const GU& u) const { return (size_t)(u.e * 8192 + u.pm * 256) * lda2; }
    DI const char* b_tile(const GU& u) const { return Bt + (size_t)u.e * 256 * ldb2; }
    DI void epi(const f32x4 (&acc)[2][2][4][2], const GU& u, int wr, int wc, int fr, int fq) const {
        if (wc >= 2) return;
        const int row0 = u.pm * 256 + wr * 64 + fr, col0 = wc * 32 + 8 * fq;
#pragma unroll
        for (int ai = 0; ai < 2; ++ai)
#pragma unroll
            for (int m = 0; m < 4; ++m) { bf16_t* rowp = O + ((size_t)u.e * 8192 + row0 + ai * 128 + m * 16) * 64 + col0;
                const f32x4 v0 = acc[ai][0][m][0], v1 = acc[ai][0][m][1];
                u32x4 w; w.x = cvt_pk_bf16(v0[0], v0[1]); w.y = cvt_pk_bf16(v0[2], v0[3]); w.z = cvt_pk_bf16(v1[0], v1[1]); w.w = cvt_pk_bf16(v1[2], v1[3]);
                *(u32x4*)rowp = w; }
    }
};

constexpr int AL_KB = 0, AL_VB = 16384, AL_FAC = 40960, AL_SELM = 41984, AL_IMPS = 43008, IMP_STRIDE = 129, AL_IMPC = AL_IMPS + 64 * IMP_STRIDE * 4, AL_OT = AL_IMPS  , OT_STRIDE = 68;
static_assert(AL_OT + 8 * 32 * OT_STRIDE * 4 <= LDS_RING, "attention LDS map");
typedef short v4i16_t __attribute__((ext_vector_type(4)));
typedef __bf16 bf16x2_t __attribute__((ext_vector_type(2)));
DI unsigned cvtpk_s(float lo, float hi) { f32x2 v = {lo, hi}; bf16x2_t b = __builtin_convertvector(v, bf16x2_t); return __builtin_bit_cast(unsigned, b); }
DI int crow(int r, int hi) { return (r & 3) + 8 * (r >> 2) + 4 * hi; }
#define NEGINF (-__builtin_inff())

struct AttnW {
    int tid, lane, wave, r32, hh;
    LAS unsigned char* lds; LAS float* fac; LAS float* ot;
};
DI void at_load(const bf16_t* slab, int tile, int tid, u32x4& r) { r = *(const u32x4*)(slab + (size_t)tile * 4096 + tid * 8); }
DI void at_store_k(LAS unsigned char* kb, int tid, const u32x4& r) { const int key = tid >> 3, ch = tid & 7; *(LAS u32x4*)(kb + key * 128 + ((ch ^ ((key >> 1) & 7)) << 4)) = r; }
DI void at_store_v(LAS unsigned char* vb, int tid, const u32x4& r) { *(LAS u32x4*)(vb + tid * 16) = r; }
DI void at_qk(const LAS unsigned char* kb, const bf16x8 (&qf)[4], float cinit, int r32, int hh, f32x16& p0, f32x16& p1) {
#pragma unroll
    for (int i = 0; i < 16; ++i) { p0[i] = cinit; p1[i] = cinit; }
    const int sw = (r32 >> 1) & 7;
#pragma unroll
    for (int d0 = 0; d0 < 4; ++d0) {
        const bf16x8 a0 = *(const LAS bf16x8*)(kb + r32 * 128 + (((2 * d0 + hh) ^ sw) << 4));
        const bf16x8 a1 = *(const LAS bf16x8*)(kb + (32 + r32) * 128 + (((2 * d0 + hh) ^ sw) << 4));
        p0 = __builtin_amdgcn_mfma_f32_32x32x16_bf16(a0, qf[d0], p0, 0, 0, 0);
        p1 = __builtin_amdgcn_mfma_f32_32x32x16_bf16(a1, qf[d0], p1, 0, 0, 0);
    }
}
DI void at_pack(const f32x16& p0, const f32x16& p1, u32x4 (&pw)[4]) {
#pragma unroll
    for (int s = 0; s < 2; ++s) {
        pw[s] = (u32x4){cvtpk_s(p0[8 * s], p0[8 * s + 1]), cvtpk_s(p0[8 * s + 2], p0[8 * s + 3]), cvtpk_s(p0[8 * s + 4], p0[8 * s + 5]), cvtpk_s(p0[8 * s + 6], p0[8 * s + 7])};
        pw[2 + s] = (u32x4){cvtpk_s(p1[8 * s], p1[8 * s + 1]), cvtpk_s(p1[8 * s + 2], p1[8 * s + 3]), cvtpk_s(p1[8 * s + 4], p1[8 * s + 5]), cvtpk_s(p1[8 * s + 6], p1[8 * s + 7])};
    }
}
DI void at_pv(const LAS unsigned char* vb, const u32x4 (&pw)[4], f32x16 (&o)[2], int lane) {
    const int hh = lane >> 5;
    const LAS unsigned char* vp = vb + (4 * hh + ((lane & 15) >> 2)) * 128 + (16 * ((lane >> 4) & 1) + 4 * (lane & 3)) * 2;
#pragma unroll
    for (int s = 0; s < 4; ++s)
#pragma unroll
        for (int d0 = 0; d0 < 2; ++d0) {
            const s16x4 lo = __builtin_bit_cast(s16x4, __builtin_amdgcn_ds_read_tr16_b64_v4i16((LAS v4i16_t*)(vp + s * 2048 + d0 * 64)));
            const s16x4 hi = __builtin_bit_cast(s16x4, __builtin_amdgcn_ds_read_tr16_b64_v4i16((LAS v4i16_t*)(vp + s * 2048 + d0 * 64 + 1024)));
            const bf16x8 vf = (bf16x8){lo[0], lo[1], lo[2], lo[3], hi[0], hi[1], hi[2], hi[3]};
            o[d0] = __builtin_amdgcn_mfma_f32_32x32x16_bf16(__builtin_bit_cast(bf16x8, pw[s]), vf, o[d0], 0, 0, 0);
        }
}
DI float at_rowmax(const f32x16& p0, const f32x16& p1) {
    float a = fmaxf(fmaxf(p0[0], p1[0]), p0[1]), c = fmaxf(fmaxf(p1[1], p0[2]), p1[2]);
#pragma unroll
    for (int r = 3; r < 15; r += 2) { a = fmaxf(fmaxf(a, p0[r]), p1[r]); c = fmaxf(fmaxf(c, p0[r + 1]), p1[r + 1]); }
    a = fmaxf(fmaxf(a, p0[15]), p1[15]); a = fmaxf(a, c);
    const f32x2 s = lds_swap(a); return fmaxf(s[0], s[1]);
}
DI void at_scale_rows(f32x16 (&o)[2], float f, const AttnW& W) {
    if (W.hh == 0) W.fac[W.r32] = f;
#pragma unroll
    for (int g4 = 0; g4 < 4; ++g4) { const f32x4 fv = *(const LAS f32x4*)(W.fac + 8 * g4 + 4 * W.hh);
#pragma unroll
        for (int j = 0; j < 4; ++j) { o[0][4 * g4 + j] *= fv[j]; o[1][4 * g4 + j] *= fv[j]; } }
}
template <bool FIRST> DI void at_axpy_rows(const f32x16 (&o)[2], float f, const AttnW& W) {
    if (W.hh == 0) W.fac[W.r32] = f;
#pragma unroll
    for (int g4 = 0; g4 < 4; ++g4) { const f32x4 fv = *(const LAS f32x4*)(W.fac + 8 * g4 + 4 * W.hh);
#pragma unroll
        for (int j = 0; j < 4; ++j) { LAS float* d = W.ot + (8 * g4 + 4 * W.hh + j) * OT_STRIDE + W.r32;
            if (FIRST) { d[0] = fv[j] * o[0][4 * g4 + j]; d[32] = fv[j] * o[1][4 * g4 + j]; }
            else { d[0] += fv[j] * o[0][4 * g4 + j]; d[32] += fv[j] * o[1][4 * g4 + j]; } } }
}
template <bool GT> DI void at_mask(f32x16& p0, f32x16& p1, int lim, int hh) {
#pragma unroll
    for (int r = 0; r < 16; ++r) { const int kv = crow(r, hh);
        if (GT) { if (kv > lim) p0[r] = NEGINF; if (kv + 32 > lim) p1[r] = NEGINF; }
        else { if (kv <= lim) p0[r] = NEGINF; if (kv + 32 <= lim) p1[r] = NEGINF; } }
}
constexpr float AT_THR = 8.0f;
struct Flash { float mu, l; bool started; f32x16 o[2]; };
DI void flash_init(Flash& s) { s.mu = 0.f; s.l = 0.f; s.started = false;
#pragma unroll
    for (int i = 0; i < 16; ++i) { s.o[0][i] = 0.f; s.o[1][i] = 0.f; } }
template <bool WITH_O> DI void flash_update(Flash& s, f32x16& p0, f32x16& p1, const AttnW& W) {
    const float mx = at_rowmax(p0, p1);
    const bool fin = mx > NEGINF;
    const bool need = s.started ? (mx > AT_THR) : (fin && fabsf(mx) > AT_THR);
    if (__any(need)) {
        const float delta = need ? mx : 0.f;
        const float f = s.started ? __builtin_amdgcn_exp2f(-delta) : 1.0f;
        s.mu += delta; s.l *= f;
        if (WITH_O) at_scale_rows(s.o, f, W);
#pragma unroll
        for (int r = 0; r < 16; ++r) { p0[r] -= delta; p1[r] -= delta; }
    }
    s.started = s.started || fin;
    float sum0 = 0.f, sum1 = 0.f;
#pragma unroll
    for (int r = 0; r < 16; ++r) { p0[r] = __builtin_amdgcn_exp2f(p0[r]); p1[r] = __builtin_amdgcn_exp2f(p1[r]); sum0 += p0[r]; sum1 += p1[r]; }
    s.l += sum0 + sum1;
}

template <int VAR>
DI void attn_unit(Frame& F, int bg, int qblk, int& it, bf16_t* Ob, u32x4& kr, const bf16_t* next_kcmp) {
    AttnW W; W.tid = F.tid; W.lane = F.lane; W.wave = F.wave; W.r32 = F.lane & 31; W.hh = F.lane >> 5; W.lds = F.lds; W.fac = (LAS float*)(F.lds + AL_FAC) + F.wave * 32; W.ot = (LAS float*)(F.lds + AL_OT) + F.wave * 32 * OT_STRIDE;
    const int tid = W.tid, lane = W.lane, wave = W.wave, r32 = W.r32, hh = W.hh;
    const int b = bg >> 2, g = bg & 3;
    unsigned char* ws = F.ws;
    bf16_t* Qb = (bf16_t*)(ws + WS_Q);
    const float* gates = (const float*)(ws + WS_GATES);
    const bf16_t* kcmp = (const bf16_t*)(ws + WS_CMPO) + (size_t)bg * 512 * 64; const bf16_t* vcmp = kcmp + (size_t)8192 * 64;
    const bf16_t* ksl = (const bf16_t*)(ws + WS_KV + 2 * KV_STRIDE) + (size_t)bg * SEQ * 64; const bf16_t* vsl = (const bf16_t*)(ws + WS_KV + 3 * KV_STRIDE) + (size_t)bg * SEQ * 64;
    const bf16_t* kwl = (const bf16_t*)(ws + WS_KV + 4 * KV_STRIDE) + (size_t)bg * SEQ * 64; const bf16_t* vwl = (const bf16_t*)(ws + WS_KV + 5 * KV_STRIDE) + (size_t)bg * SEQ * 64;
    LAS unsigned char* KB = F.lds + AL_KB; LAS unsigned char* VB = F.lds + AL_VB;
    LAS unsigned* selm = (LAS unsigned*)(F.lds + AL_SELM); LAS float* impS = (LAS float*)(F.lds + AL_IMPS); LAS float* impC = (LAS float*)(F.lds + AL_IMPC);
    const int tl = wave * 8 + (r32 >> 2), hd = r32 & 3, t = qblk * 64 + tl;
    const size_t qrow = ((size_t)(b * SEQ + t) * 16 + g * 4 + hd) * 64;
    bf16x8 qf[4];
#pragma unroll
    for (int d0 = 0; d0 < 4; ++d0) qf[d0] = *(const bf16x8*)(Qb + qrow + d0 * 16 + hh * 8);
    const float* gp = gates + (size_t)(b * SEQ + t) * 48 + (g * 4 + hd) * 3;
    const bool need_topk = (qblk >= 16) && !(VAR & 128);
    f32x16 p0, p1; u32x4 vr, pw[4];
    const bool rotB = wave >= 4;
    int vs = 0;
#define V_NEXT() do { vs = (vs == 2) ? 0 : vs + 1; } while (0)

    const int nct = (4 * qblk + 2) / 64 + 1;
    const int cmax = (t - 31) >> 4;
    Flash fc; flash_init(fc);
    const int cfull = 4 * qblk - 2;
    for (int ti = 0; ti < nct; ++ti, ++it) {
        LAS unsigned char* kb = KB + (it & 1) * 8192;
        at_store_k(kb, tid, kr); if (!(VAR & 2)) __syncthreads();
        if (ti + 1 < nct) at_load(kcmp, ti + 1, tid, kr); else { at_load(kcmp, 0, tid, kr); at_load(vcmp, 0, tid, vr); }
        at_qk(kb, qf, -fc.mu, r32, hh, p0, p1);
        if (64 * ti + 63 > cfull) at_mask<true>(p0, p1, cmax - 64 * ti, hh);
        flash_update<false>(fc, p0, p1, W);
    }
    { const f32x2 ls = lds_swap(fc.l); fc.l = ls[0] + ls[1]; }
    const float inv_lc = 1.0f / fmaxf(fc.l, 1e-30f);
    if (need_topk) { for (int i = tid; i < 64 * IMP_STRIDE; i += NTHR) { impS[i] = 0.f; impC[i] = 0.f; } }
    for (int ti = 0; ti < nct; ++ti, ++it) {
        LAS unsigned char* kb = KB + (it & 1) * 8192; LAS unsigned char* vb = VB + vs * 8192; V_NEXT();
        at_store_k(kb, tid, kr); at_store_v(vb, tid, vr); if (!(VAR & 2)) __syncthreads();
        if (ti + 1 < nct) { at_load(kcmp, ti + 1, tid, kr); at_load(vcmp, ti + 1, tid, vr); } else { at_load(ksl, 0, tid, kr); at_load(vsl, 0, tid, vr); }
        at_qk(kb, qf, -fc.mu, r32, hh, p0, p1);
        if (64 * ti + 63 > cfull) at_mask<true>(p0, p1, cmax - 64 * ti, hh);
#pragma unroll
        for (int r = 0; r < 16; ++r) { p0[r] = __builtin_amdgcn_exp2f(p0[r]); p1[r] = __builtin_amdgcn_exp2f(p1[r]); }
        at_pack(p0, p1, pw);
        at_pv(vb, pw, fc.o, lane);
        if (need_topk) {
#pragma unroll
            for (int half = 0; half < 2; ++half)
#pragma unroll
                for (int g4 = 0; g4 < 4; ++g4) {
                    const f32x16& p = half ? p1 : p0;
                    float s4 = ((p[4 * g4] + p[4 * g4 + 1]) + (p[4 * g4 + 2] + p[4 * g4 + 3])) * inv_lc, c3 = p[4 * g4 + 3] * inv_lc;
                    s4 += quad_xor<0xB1>(s4); c3 += quad_xor<0xB1>(c3); s4 += quad_xor<0x4E>(s4); c3 += quad_xor<0x4E>(c3);
                    const int j = 16 * ti + 8 * half + 2 * g4 + hh;
                    if (hd == 0) { impS[tl * IMP_STRIDE + j] = s4; impC[tl * IMP_STRIDE + j] = c3; }
                }
        }
    }
    __syncthreads();
    if (need_topk) {
        #pragma unroll 1
        for (int rnd = 0; rnd < 2; ++rnd) {
        unsigned k0[4], k1[4], prefix[4];
#pragma unroll
        for (int tt = 0; tt < 4; ++tt) {
            const int tk = wave * 8 + rnd * 4 + tt; const LAS float* S = impS + tk * IMP_STRIDE; const LAS float* C = impC + tk * IMP_STRIDE;
            const int j0 = lane, j1 = 64 + lane;
            const float v0 = S[j0] + (j0 > 0 ? C[j0 - 1] : 0.f), v1 = S[j1] + C[j1 - 1];
            const bool c0 = (j0 >= 1) && (j0 <= qblk - 2), c1 = (j1 <= qblk - 2);
            k0[tt] = c0 ? ((__float_as_uint(v0) + 0x100u) & 0xffffff00u) : 0u; k1[tt] = c1 ? ((__float_as_uint(v1) + 0x100u) & 0xffffff00u) : 0u; prefix[tt] = 0u;
        }
#pragma unroll 1
        for (int bit = 30; bit >= 8; --bit) {
            unsigned long long bl0[4], bl1[4];
#pragma unroll
            for (int tt = 0; tt < 4; ++tt) { const unsigned trial = prefix[tt] | (1u << bit); bl0[tt] = __ballot(k0[tt] >= trial); bl1[tt] = __ballot(k1[tt] >= trial); }
#pragma unroll
            for (int tt = 0; tt < 4; ++tt) { asm volatile("" : "+s"(bl0[tt]), "+s"(bl1[tt])); }
#pragma unroll
            for (int tt = 0; tt < 4; ++tt) { const int cnt = __popcll(bl0[tt]) + __popcll(bl1[tt]); prefix[tt] = cnt >= 13 ? (prefix[tt] | (1u << bit)) : prefix[tt]; }
        }
#pragma unroll
        for (int tt = 0; tt < 4; ++tt) {
            const int tk = wave * 8 + rnd * 4 + tt; const int j0 = lane, j1 = 64 + lane; const unsigned pf = prefix[tt];
            const int G = __popcll(__ballot(k0[tt] > pf)) + __popcll(__ballot(k1[tt] > pf)); const int need = 13 - G;
            const unsigned long long e0 = __ballot(k0[tt] == pf), e1 = __ballot(k1[tt] == pf);
            const unsigned long long lt = (1ull << lane) - 1ull;
            const int rk0 = __popcll(e0 & lt), rk1 = __popcll(e0) + __popcll(e1 & lt);
            const bool s0 = (k0[tt] > pf) || (k0[tt] == pf && rk0 < need) || j0 == 0 || j0 == qblk || j0 == qblk - 1;
            const bool s1 = (k1[tt] > pf) || (k1[tt] == pf && rk1 < need) || j1 == qblk || j1 == qblk - 1;
            const unsigned long long m0 = __ballot(s0), m1 = __ballot(s1);
            if (lane == 0) { selm[tk * 4 + 0] = (unsigned)m0; selm[tk * 4 + 1] = (unsigned)(m0 >> 32); selm[tk * 4 + 2] = (unsigned)m1; selm[tk * 4 + 3] = (unsigned)(m1 >> 32); }
        }
        }
    } else {
        if (tid < 256) selm[tid] = 0xffffffffu;
    }
    __syncthreads();
    at_axpy_rows<true>(fc.o, gp[0] * inv_lc, W);

    {
        Flash fs; flash_init(fs);
        const int tbw = qblk >= 8 ? qblk - 8 : 0;
        const LAS unsigned char* vprev = VB; bool first = true;
#define SEL_HEAD() \
            LAS unsigned char* kb = KB + (it & 1) * 8192; LAS unsigned char* vb = VB + vs * 8192; V_NEXT(); \
            at_store_k(kb, tid, kr); at_store_v(vb, tid, vr); if (!(VAR & 2)) __syncthreads(); \
            if (ti < qblk) { if (!(VAR & 1)) { at_load(ksl, ti + 1, tid, kr); at_load(vsl, ti + 1, tid, vr); } } else { at_load(kwl, tbw, tid, kr); at_load(vwl, tbw, tid, vr); } \
            const unsigned wsel = selm[tl * 4 + (ti >> 5)]; \
            const bool selb = ((wsel >> (ti & 31)) & 1u) != 0u;
        if (!rotB) {
            for (int ti = (VAR & 32) ? qblk : 0; ti <= qblk; ++ti, ++it) {
                SEL_HEAD()
                at_qk(kb, qf, selb ? -fs.mu : NEGINF, r32, hh, p0, p1);
                if (ti == qblk) at_mask<true>(p0, p1, tl, hh);
                flash_update<true>(fs, p0, p1, W); at_pack(p0, p1, pw);
                at_pv(vb, pw, fs.o, lane);
            }
        } else {
            for (int ti = (VAR & 32) ? qblk : 0; ti <= qblk; ++ti, ++it) {
                SEL_HEAD()
                if (!first) at_pv(vprev, pw, fs.o, lane);
                at_qk(kb, qf, selb ? -fs.mu : NEGINF, r32, hh, p0, p1);
                if (ti == qblk) at_mask<true>(p0, p1, tl, hh);
                flash_update<true>(fs, p0, p1, W); at_pack(p0, p1, pw);
                vprev = vb; first = false;
            }
            at_pv(vprev, pw, fs.o, lane);
        }
#undef SEL_HEAD
        const f32x2 ls = lds_swap(fs.l); const float l = ls[0] + ls[1];
        at_axpy_rows<false>(fs.o, gp[1] / fmaxf(l, 1e-30f), W);
    }
    {
        Flash fw; flash_init(fw);
        const int tb = qblk >= 8 ? qblk - 8 : 0;
        const LAS unsigned char* vprev = VB; bool first = true;
#define WIN_HEAD() \
            LAS unsigned char* kb = KB + (it & 1) * 8192; LAS unsigned char* vb = VB + vs * 8192; V_NEXT(); \
            at_store_k(kb, tid, kr); at_store_v(vb, tid, vr); if (!(VAR & 2)) __syncthreads(); \
            if (ti < qblk) { if (!(VAR & 1)) { at_load(kwl, ti + 1, tid, kr); at_load(vwl, ti + 1, tid, vr); } } else if (next_kcmp) at_load(next_kcmp, 0, tid, kr);
        if (!rotB) {
            for (int ti = (VAR & 64) ? qblk : tb; ti <= qblk; ++ti, ++it) {
                WIN_HEAD()
                at_qk(kb, qf, -fw.mu, r32, hh, p0, p1);
                if (ti == qblk - 8) at_mask<false>(p0, p1, tl, hh);
                if (ti == qblk) at_mask<true>(p0, p1, tl, hh);
                flash_update<true>(fw, p0, p1, W); at_pack(p0, p1, pw);
                at_pv(vb, pw, fw.o, lane);
            }
        } else {
            for (int ti = (VAR & 64) ? qblk : tb; ti <= qblk; ++ti, ++it) {
                WIN_HEAD()
                if (!first) at_pv(vprev, pw, fw.o, lane);
                at_qk(kb, qf, -fw.mu, r32, hh, p0, p1);
                if (ti == qblk - 8) at_mask<false>(p0, p1, tl, hh);
                if (ti == qblk) at_mask<true>(p0, p1, tl, hh);
                flash_update<true>(fw, p0, p1, W); at_pack(p0, p1, pw);
                vprev = vb; first = false;
            }
            at_pv(vprev, pw, fw.o, lane);
        }
#undef WIN_HEAD
        const f32x2 ls = lds_swap(fw.l); const float l = ls[0] + ls[1];
        at_axpy_rows<false>(fw.o, gp[2] / fmaxf(l, 1e-30f), W);
    }
#undef V_NEXT
    { const int q = lane >> 1, hf = lane & 1; const LAS float* src = W.ot + q * OT_STRIDE + hf * 32; const int tq = qblk * 64 + wave * 8 + (q >> 2);
      unsigned char* dst = (unsigned char*)Ob + ((size_t)(b * SEQ + tq) * 16 + g * 4 + (q & 3)) * 64 + hf * 32;
#pragma unroll
      for (int c = 0; c < 2; ++c) { unsigned w[4];
#pragma unroll
          for (int e = 0; e < 4; ++e) { const f32x4 a = *(const LAS f32x4*)(src + 16 * c + 4 * e); int x = 0; x = __builtin_amdgcn_cvt_pk_fp8_f32(a.x, a.y, x, false); x = __builtin_amdgcn_cvt_pk_fp8_f32(a.z, a.w, x, true); w[e] = (unsigned)x; }
          *(u32x4*)(dst + 16 * c) = (u32x4){w[0], w[1], w[2], w[3]}; } }
    __syncthreads();
}
template <int VAR>
DI void attn_phase(Frame& F, bf16_t* Ob) {
    int it = 0;
    const bf16_t* kcmp_all = (const bf16_t*)(F.ws + WS_CMPO);
    const bool bal = (F.G == 256);
    const int bg0 = F.vcu >> 4, sft = F.vcu & 15;
    const int nun = bal ? 8 : (2048 - F.vcu + F.G - 1) / F.G;
    auto unit_of = [&](int i, int& bg, int& qblk) {
        if (bal) { const int base = (i >> 1) * 32; bg = bg0; qblk = 127 - ((i & 1) ? base + 31 - sft : base + sft); }
        else { const int u = F.vcu + i * F.G; bg = u >> 7; qblk = 127 - (u & 127); } };
    u32x4 kr;
    if (nun > 0) { int bg, qb; unit_of(0, bg, qb); at_load(kcmp_all + (size_t)bg * 512 * 64, 0, F.tid, kr); }
#pragma unroll 1
    for (int i = 0; i < nun; ++i) {
        int bg, qb, nbg = 0, nqb = 0; unit_of(i, bg, qb);
        const bf16_t* nk = nullptr; if (i + 1 < nun) { unit_of(i + 1, nbg, nqb); nk = kcmp_all + (size_t)nbg * 512 * 64; }
        attn_unit<VAR>(F, bg, qb, it, Ob, kr, nk);
    }
}

constexpr int NPHASE = 18;
__global__ void __launch_bounds__(NTHR, 2) fwd_kernel(Args args) {
    extern __shared__ __attribute__((aligned(16))) unsigned char lds_raw[];
    cg::grid_group grid = cg::this_grid();
    Frame F;
    F.lds = (LAS unsigned char*)lds_raw;
    F.tid = threadIdx.x; F.lane = F.tid & 63; F.wave = __builtin_amdgcn_readfirstlane(F.tid >> 6);
    F.G = gridDim.x; { const int bx = blockIdx.x; F.vcu = (F.G % 8 == 0) ? (bx % 8) * (F.G / 8) + bx / 8 : bx; }
    F.in = args.in; F.out = args.out; F.ws = args.ws;
    unsigned char* ws = args.ws;
    const int lo = args.ph_lo, hi = args.ph_hi;
    volatile LAS unsigned* bar_st = (volatile LAS unsigned*)(F.lds + LDS_BYTES - 64);
    if (F.tid < 16) bar_st[F.tid] = 0u;
    __syncthreads();
    XcdBarrier xbar; xbar.bar = (unsigned*)(ws + WS_CTL) + CW_BAR; xbar.x = 0; xbar.st = bar_st;
#ifndef PHMASK
#define PHMASK 0xFFFFFFFFu
#endif
#define IN(k) (((PHMASK >> (k)) & 1u) && lo <= (k) && (k) < hi)
#ifdef TPH_LO
    unsigned long long tp0 = __builtin_amdgcn_s_memrealtime(), tp1 = tp0;
#define STAMP(k) do { if ((k) == TPH_LO - 1) tp0 = __builtin_amdgcn_s_memrealtime(); if ((k) == TPH_HI) tp1 = __builtin_amdgcn_s_memrealtime(); } while (0)
#else
#define STAMP(k) do { } while (0)
#endif
#define SEAM(k) do { if (IN(k) && IN((k) + 1)) { if ((k) == 0) { grid.sync(); xbar = xcd_barrier_post((unsigned*)(ws + WS_CTL) + CW_BAR, bar_st); } else xcd_barrier(xbar); } STAMP(k); } while (0)

    if (IN(0)) { p0_prep(F); } SEAM(0);
    if (IN(1)) { GemmPlain g; g.A = (const char*)(ws + WS_XB); g.K = 1024; g.lda2 = 2048; g.ldb2 = 2048; g.Bt = (const char*)(ws + WS_W0IN); g.ord.init(T, L0N, F.G, (int)blockIdx.x);
        g.C = (bf16_t*)(ws + WS_Z); g.ldc = L0N; pg8::gemm_phase(F.lds, g); } SEAM(1);
#ifdef XSYNC_N
    for (int xs = 0; xs < XSYNC_N; ++xs) grid.sync();
#endif
#ifdef XGEMM_K
    { grid.sync(); const unsigned long long xt0 = __builtin_amdgcn_s_memrealtime();
      GemmPlain g; g.A = (const char*)(ws + WS_XB); g.K = XGEMM_K; g.lda2 = 2048; g.ldb2 = 2048; g.Bt = (const char*)(ws + WS_W0IN); g.ord.init(T, XGEMM_N, F.G, (int)blockIdx.x);
      g.C = (bf16_t*)F.out; g.ldc = XGEMM_N; pg8::gemm_phase(F.lds, g); grid.sync(); (void)xt0; }
#endif
    if (IN(2)) { for (int u = F.vcu; u < 512; u += F.G) lru_tile<false>(F, u >> 7, u & 127); } SEAM(2);
    if (IN(3)) { for (int u = F.vcu; u < 512; u += F.G) lru_tile<true>(F, u >> 7, u & 127); } SEAM(3);
    bf16_t* const OA = (bf16_t*)F.out; bf16_t* const OB = OA + (size_t)T * D;
    if (IN(4)) { GemmResid<true, false> g; g.A = (const char*)(ws + WS_XB); g.K = 1024; g.lda2 = 2048; g.ldb2 = 2048; g.Bt = (const char*)(ws + WS_W0OUT); g.ord.init(T, D, F.G, (int)blockIdx.x);
        g.res32 = F.in[0]; g.res16 = nullptr; g.out = OA; pg8::gemm_phase(F.lds, g); } SEAM(4);
#define MOE_LAYER(layer, pb, SRC, FIN, DST16) do { \
        if (IN(pb)) { ln_router_phase(F, layer, SRC); } SEAM(pb); \
        if (IN((pb) + 1)) { MoeTab tab = moe_tables(F, layer); \
            GemmMoeUp g; g.A = (const char*)(ws + WS_X8); g.K = 512; g.lda2 = 1024; g.ldb2 = 1024; g.Bt = (const char*)(ws + ((layer) ? WS_WGU1 : WS_WGU0)); g.G = F.G; g.c = (int)blockIdx.x; \
            g.tab = tab; g.list = (const unsigned*)(ws + WS_LIST); g.H = (bf16_t*)(ws + WS_H); pg8::gemm_phase(F.lds, g); } SEAM((pb) + 1); \
        if (IN((pb) + 2)) { MoeTab tab = moe_tables(F, layer); \
            GemmMoeDown g; g.A = (const char*)(ws + WS_H); g.K = 256; g.lda2 = 512; g.ldb2 = 512; g.Bt = (const char*)(ws + ((layer) ? WS_WD1 : WS_WD0)); g.G = F.G; g.c = (int)blockIdx.x; \
            g.tab = tab; g.Y = (bf16_t*)(ws + WS_Y); pg8::gemm_phase(F.lds, g); } SEAM((pb) + 2); \
        if (IN((pb) + 3)) { MoeTab tab = moe_tables(F, layer); ln2_phase<FIN>(F, layer, tab, DST16, F.out, (unsigned char*)OB); } } while (0)
    MOE_LAYER(0, 5, OA, false, OA); SEAM(8);
    if (IN(9)) { GemmL1In g; g.A = (const char*)OB; g.K = 512; g.lda2 = 1024; g.ldb2 = 1024; g.Bt = (const char*)(ws + WS_W1IN); g.ord.init(T, L1NP, F.G, (int)blockIdx.x);
        g.Q = (bf16_t*)(ws + WS_Q); g.KV = ws + WS_KV; g.gates = (float*)(ws + WS_GATES); g.cosT = (const float*)(ws + WS_COS); g.sinT = (const float*)(ws + WS_SIN); pg8::gemm_phase(F.lds, g); } SEAM(9);
    if (IN(10)) { GemmCmp1 g; g.A = (const char*)(ws + WS_KV); g.K = 2048; g.lda2 = 2048; g.ldb2 = 4096; g.Bt = (const char*)(ws + WS_WC1); g.G = F.G; g.c = (int)blockIdx.x;
        g.cbias = (const float*)(ws + WS_SMALL + SM_CBIAS); g.Hd = (bf16_t*)(ws + WS_CMPH); pg8::gemm_phase(F.lds, g); p0_moe1(F, F.G >= 128 ? 64 : 0); } SEAM(10);
    if (IN(11)) { GemmCmp2 g; g.A = (const char*)(ws + WS_CMPH); g.K = 256; g.lda2 = 512; g.ldb2 = 512; g.Bt = (const char*)(ws + WS_WC2); g.G = F.G; g.c = (int)blockIdx.x;
        g.O = (bf16_t*)(ws + WS_CMPO); pg8::gemm_phase(F.lds, g); } SEAM(11);
#ifdef XATT_VAR
    { xcd_barrier(xbar); attn_phase<XATT_VAR>(F, (bf16_t*)(ws + WS_XB)); xcd_barrier(xbar); }
#endif
    if (IN(12)) { attn_phase<0>(F, (bf16_t*)(ws + WS_XB)); } SEAM(12);
    if (IN(13)) { GemmResid<false, true> g; g.A = (const char*)(ws + WS_XB); g.K = 512; g.lda2 = 1024; g.ldb2 = 1024; g.Bt = (const char*)(ws + WS_W1OUT); g.ord.init(T, D, F.G, (int)blockIdx.x);
        g.res32 = nullptr; g.res16 = OA; g.out = OB; pg8::gemm_phase(F.lds, g); } SEAM(13);
    MOE_LAYER(1, 14, OB, true, nullptr);
#undef MOE_LAYER
#ifdef TPH_LO
    grid.sync(); STAMP(17);
    if (blockIdx.x == 0 && threadIdx.x == 0) { const unsigned long long span = (tp1 - tp0) * TPH_MUL, ts = __builtin_amdgcn_s_memrealtime(); while (__builtin_amdgcn_s_memrealtime() - ts < span) __builtin_amdgcn_s_sleep(32); }
#endif
#undef IN
#undef SEAM
}

extern "C" void kernel_launch(void* const* d_in, const int* in_sizes, int n_in, void* d_out, int out_size, void* d_ws, size_t ws_size, hipStream_t stream) {
    static int grid = 0;
    if (grid == 0) {
        if (n_in != 41 || out_size != T * D || ws_size < WS_END) { fprintf(stderr, "kernel_launch: unexpected problem (n_in %d out %d ws %zu, need %zu)\n", n_in, out_size, ws_size, (size_t)WS_END); grid = -1; return; }
        int dev = 0, cus = 0, per_cu = 0;
        hipGetDevice(&dev); hipDeviceGetAttribute(&cus, hipDeviceAttributeMultiprocessorCount, dev);
        hipFuncSetAttribute((const void*)fwd_kernel, hipFuncAttributeMaxDynamicSharedMemorySize, LDS_BYTES);
        hipOccupancyMaxActiveBlocksPerMultiprocessor(&per_cu, (const void*)fwd_kernel, NTHR, LDS_BYTES);
        if (per_cu < 1) { fprintf(stderr, "kernel_launch: occupancy query says %d blocks/CU\n", per_cu); per_cu = 1; }
        grid = cus * per_cu; if (grid > cus) grid = cus;
        (void)hipGetLastError();
    }
    if (grid < 0) return;
    Args a{};
    for (int i = 0; i < 41; ++i) a.in[i] = (const float*)d_in[i];
    a.out = (float*)d_out; a.ws = (unsigned char*)d_ws; a.ph_lo = 0; a.ph_hi = NPHASE;
    void* kargs[] = {&a};
    hipError_t e = hipLaunchCooperativeKernel((const void*)fwd_kernel, dim3(grid), dim3(NTHR), kargs, LDS_BYTES, stream);
    if (e != hipSuccess) fprintf(stderr, "cooperative launch failed: %s (grid %d)\n", hipGetErrorString(e), grid);
}
```

```cpp
#include <hip/hip_runtime.h>
#include <hip/hip_cooperative_groups.h>
#include <cstdio>
#include <cstdint>
#include <cmath>
namespace cg = cooperative_groups;

#define LAS __attribute__((address_space(3)))
#define DI __device__ __forceinline__
typedef unsigned short bf16_t;
typedef short bf16x8 __attribute__((ext_vector_type(8)));
typedef short s16x4 __attribute__((ext_vector_type(4)));
typedef float f32x2 __attribute__((ext_vector_type(2)));
typedef float f32x4 __attribute__((ext_vector_type(4)));
typedef float f32x16 __attribute__((ext_vector_type(16)));
typedef unsigned u32x2 __attribute__((ext_vector_type(2)));
typedef unsigned u32x4 __attribute__((ext_vector_type(4)));

constexpr int NB = 4, SEQ = 8192, T = NB * SEQ, D = 1024;
constexpr int L0N = 2560;
constexpr int L1N = 2608, L1NP = 2816;
constexpr int NEXP = 32, FF = 512;
constexpr float DN_ALPHA = 1.4142135623730951f;
constexpr float LN_EPS = 1e-5f;
constexpr int NWAVES = 8, NTHR = 512;
constexpr int NCMP = 512;

constexpr size_t MiB = 1u << 20;
constexpr size_t WS_CTL = 0;
constexpr size_t WS_COS = 1 * MiB, WS_SIN = 2 * MiB;
constexpr size_t WS_SMALL = 3 * MiB;
constexpr size_t SM_LRUBT = 0;
constexpr size_t SM_CBIAS = 256 * 1024;
constexpr size_t SM_RWT = 320 * 1024;
constexpr size_t WS_W0IN = 4 * MiB, WS_W0OUT = 9 * MiB, WS_W1IN = 11 * MiB, WS_W1OUT = 17 * MiB;
constexpr size_t WS_WC1 = 19 * MiB;
constexpr size_t WS_WC2 = 21 * MiB;
constexpr size_t WS_LIST = 22 * MiB;
constexpr size_t WS_WSLOT = 26 * MiB;
constexpr size_t WS_POSLOC = WS_WSLOT + 256 * 1024;
constexpr size_t WS_SCAN = 27 * MiB;
constexpr size_t WS_WGU0 = 32 * MiB, WS_WD0 = 96 * MiB, WS_WGU1 = 128 * MiB, WS_WD1 = 192 * MiB;
constexpr size_t WS_ACT = 224 * MiB;
constexpr size_t WS_XB = WS_ACT;
constexpr size_t WS_Z = WS_ACT + 64 * MiB;
constexpr size_t WS_H = WS_ACT + 64 * MiB;
constexpr size_t WS_X8 = WS_ACT + 100 * MiB;
constexpr size_t WS_Y = WS_ACT + 136 * MiB;
constexpr size_t WS_Q = WS_ACT + 64 * MiB;
constexpr size_t WS_KV = WS_ACT + 128 * MiB;
constexpr size_t KV_STRIDE = 17 * MiB;
constexpr size_t WS_GATES = WS_ACT + 232 * MiB;
constexpr size_t WS_CMPH = WS_ACT + 240 * MiB;
constexpr size_t WS_CMPO = WS_ACT + 248 * MiB;
constexpr size_t WS_END = WS_ACT + 280 * MiB;
constexpr int CW_CNT = 4608;
constexpr int CW_BAR = 1024;
constexpr int CTL_WORDS = 16384;

DI unsigned f2bf(float f) { unsigned u = __builtin_bit_cast(unsigned, f); return (u + 0x7fffu + ((u >> 16) & 1u)) >> 16; }
DI unsigned pk2(float lo, float hi) { return f2bf(lo) | (f2bf(hi) << 16); }
DI float bf2f(unsigned short b) { return __builtin_bit_cast(float, (unsigned)b << 16); }
DI float bflo(unsigned w) { return __builtin_bit_cast(float, w << 16); }
DI float bfhi(unsigned w) { return __builtin_bit_cast(float, w & 0xffff0000u); }
DI unsigned cvt_pk_bf16(float lo, float hi) { unsigned r; asm volatile("v_cvt_pk_bf16_f32 %0, %1, %2" : "=v"(r) : "v"(lo), "v"(hi)); return r; }
DI float wave_sum(float v) {
    int x = __float_as_int(v);
    x = __float_as_int(__int_as_float(x) + __int_as_float(__builtin_amdgcn_mov_dpp(x, 0xB1, 0xF, 0xF, true)));
    x = __float_as_int(__int_as_float(x) + __int_as_float(__builtin_amdgcn_mov_dpp(x, 0x4E, 0xF, 0xF, true)));
    x = __float_as_int(__int_as_float(x) + __int_as_float(__builtin_amdgcn_mov_dpp(x, 0x141, 0xF, 0xF, true)));
    x = __float_as_int(__int_as_float(x) + __int_as_float(__builtin_amdgcn_mov_dpp(x, 0x140, 0xF, 0xF, true)));
    x = __float_as_int(__int_as_float(x) + __int_as_float(__builtin_amdgcn_update_dpp(0, x, 0x142, 0xA, 0xF, false)));
    x = __float_as_int(__int_as_float(x) + __int_as_float(__builtin_amdgcn_update_dpp(0, x, 0x143, 0xC, 0xF, false)));
    return __int_as_float(__builtin_amdgcn_readlane(x, 63));
}
DI float sigmoidf_(float x) { return __builtin_amdgcn_rcpf(1.0f + __builtin_amdgcn_exp2f(-1.4426950408889634f * x)); }
DI float gelu_tanh(float x) { const float u = 0.7978845608028654f * (x + 0.044715f * x * x * x); return x * __builtin_amdgcn_rcpf(1.0f + __builtin_amdgcn_exp2f(-2.8853900817779268f * u)); }
#define LDS_WAIT() asm volatile("s_waitcnt lgkmcnt(0)" ::: "memory")

namespace pg8 {
constexpr int BM = 256, BK = 64, HALF = 128, HTB = HALF * BK * 2, STAGE_BYTES = 8 * HTB;
__host__ __device__ __forceinline__ int lds_byte(int r, int c) { const int st = (r >> 4) * 2 + (c >> 5), rr = r & 15, cc = c & 31, ob = rr * 64 + cc * 2; return st * 1024 + (ob ^ (((ob >> 9) & 1) << 5)); }
__host__ __device__ __forceinline__ void stage_rc(int b, int& R, int& C) { const int st = b / 1024, sb = b % 1024, swz = sb ^ (((sb >> 9) & 1) << 5); R = (st >> 1) * 16 + swz / 64; C = (st & 1) * 32 + (swz % 64) / 2; }
__host__ __device__ __forceinline__ int perm32(int rho) { const int n = rho >> 4, i = rho & 15; return 8 * (i >> 2) + 4 * n + (i & 3); }
struct GU { int pm, pn, e; };
__device__ __forceinline__ void mfma_f8_inplace(f32x4& acc, const int __attribute__((ext_vector_type(8)))& a, const int __attribute__((ext_vector_type(8)))& b, int sc) {
    asm volatile("v_mfma_scale_f32_16x16x128_f8f6f4 %0, %1, %2, %0, %3, %3 op_sel_hi:[0,0,0]" : "+v"(acc) : "v"(a), "v"(b), "v"(sc));
}
typedef int v8i32 __attribute__((ext_vector_type(8))); typedef int v4i32 __attribute__((ext_vector_type(4))); typedef long v2i64 __attribute__((ext_vector_type(2)));
__device__ __forceinline__ v8i32 cat8(bf16x8 a, bf16x8 b) { const v4i32 x = __builtin_bit_cast(v4i32, a), y = __builtin_bit_cast(v4i32, b); return __builtin_shufflevector(x, y, 0, 1, 2, 3, 4, 5, 6, 7); }
template <class P>
__device__ __forceinline__ void gemm_phase(LAS unsigned char* lds, const P& p) {
    const int tid = threadIdx.x, wid = __builtin_amdgcn_readfirstlane(tid >> 6), lane = tid & 63, wr = wid >> 2, wc = wid & 3, fr = lane & 15, fq = lane >> 4;
    const int nt = p.K / BK;
    int Rr[2]; unsigned Cc2[2], voffB[2];
#pragma unroll
    for (int i = 0; i < 2; ++i) { int R, C; stage_rc(tid * 16 + i * 8192, R, C); const int Rb = P::PERM ? ((R & ~31) + perm32(R & 31)) : R;
        Rr[i] = R; Cc2[i] = (unsigned)C * 2u; voffB[i] = (unsigned)Rb * p.ldb2 + (unsigned)C * 2u; }
    const size_t kstep = (size_t)(BK * 2);
    const size_t hstepB = (size_t)HALF * p.ldb2;
    const unsigned ldsw = (unsigned)wid * 1024u;
    const int aoff = lds_byte(wr * 64 + fr, fq * 8), boff = lds_byte(wc * 32 + fr, fq * 8);
#define PG8_SA(b, h) (((b) * 2 + (h)) * HTB)
#define PG8_SB(b, h) ((4 + (b) * 2 + (h)) * HTB)
#define PG8_STAGE(bufoff, gbase, voff) do { _Pragma("unroll") for (int _i = 0; _i < 2; ++_i) \
        __builtin_amdgcn_global_load_lds((const unsigned*)((const char*)(gbase) + (voff)[_i]), (LAS unsigned*)(lds + (bufoff) + ldsw + _i * 8192), 16, 0, 0); } while (0)
#define PG8_LDA(dst, b, h) do { _Pragma("unroll") for (int m = 0; m < 4; ++m) { if constexpr (P::FP8) dst##8[m] = cat8(*(const LAS bf16x8*)(lds + PG8_SA(b, h) + aoff + m * 2048), *(const LAS bf16x8*)(lds + PG8_SA(b, h) + aoff + m * 2048 + 1024)); \
        else { _Pragma("unroll") for (int k = 0; k < 2; ++k) dst[m][k] = *(const LAS bf16x8*)(lds + PG8_SA(b, h) + aoff + m * 2048 + k * 1024); } } } while (0)
#define PG8_LDB(dst, b, h) do { _Pragma("unroll") for (int n = 0; n < 2; ++n) { if constexpr (P::FP8) dst##8[n] = cat8(*(const LAS bf16x8*)(lds + PG8_SB(b, h) + boff + n * 2048), *(const LAS bf16x8*)(lds + PG8_SB(b, h) + boff + n * 2048 + 1024)); \
        else { _Pragma("unroll") for (int k = 0; k < 2; ++k) dst[n][k] = *(const LAS bf16x8*)(lds + PG8_SB(b, h) + boff + n * 2048 + k * 1024); } } } while (0)
#define PG8_MMA(ai, bj, At, Bt) do { __builtin_amdgcn_s_setprio(1); _Pragma("unroll") for (int m = 0; m < 4; ++m) _Pragma("unroll") for (int n = 0; n < 2; ++n) { \
        if constexpr (P::FP8) { mfma_f8_inplace(acc[ai][bj][m][n], Bt##8[n], At##8[m], scale1); } \
        else { _Pragma("unroll") for (int k = 0; k < 2; ++k) acc[ai][bj][m][n] = __builtin_amdgcn_mfma_f32_16x16x32_bf16(Bt[n][k], At[m][k], acc[ai][bj][m][n], 0, 0, 0); } } \
        __builtin_amdgcn_s_setprio(0); } while (0)
#define PG8_WAIT_V(n) asm volatile("s_waitcnt vmcnt(" #n ")" ::: "memory")
#define PG8_WAIT_L(n) asm volatile("s_waitcnt lgkmcnt(" #n ")" ::: "memory")
#define PG8_BAR __builtin_amdgcn_s_barrier()
#define PG8_SCHED __builtin_amdgcn_sched_barrier(0)
    GU cur, nxt; int ui = 0;
    if (!p.next(0, cur)) return;
    f32x4 acc[2][2][4][2];
#pragma unroll
    for (int a = 0; a < 2; ++a)
#pragma unroll
        for (int b = 0; b < 2; ++b)
#pragma unroll
            for (int m = 0; m < 4; ++m)
#pragma unroll
                for (int n = 0; n < 2; ++n) acc[a][b][m][n] = (f32x4){0.f, 0.f, 0.f, 0.f};
    bf16x8 At[4][2], B0[2][2], B1[2][2]; v8i32 At8[4], B08[2], B18[2]; const int scale1 = 0x7f7f7f7f;
    unsigned cA0[2], cA1[2], nA0[2], nA1[2];
    size_t cU = 0, nU = 0;
#pragma unroll
    for (int i = 0; i < 2; ++i) {
        if constexpr (P::AUNI) { cA0[i] = (unsigned)Rr[i] * p.lda2 + Cc2[i]; cA1[i] = (unsigned)(HALF + Rr[i]) * p.lda2 + Cc2[i]; }
        else { cA0[i] = p.a_row_off(cur, Rr[i]) + Cc2[i]; cA1[i] = p.a_row_off(cur, HALF + Rr[i]) + Cc2[i]; } }
    if constexpr (P::AUNI) cU = p.a_base(cur);
    const char* const Ab0 = p.A;
#define Ab (Ab0 + cU)
    const char* cB = p.b_tile(cur);
    PG8_STAGE(PG8_SB(0, 0), cB, voffB); PG8_STAGE(PG8_SB(0, 1), cB + hstepB, voffB); PG8_STAGE(PG8_SA(0, 0), Ab, cA0); PG8_STAGE(PG8_SA(0, 1), Ab, cA1);
    if (wr == 1) PG8_BAR;
    PG8_WAIT_V(2); PG8_BAR;
    PG8_STAGE(PG8_SB(1, 0), cB + kstep, voffB); PG8_STAGE(PG8_SA(1, 0), Ab + kstep, cA0); PG8_STAGE(PG8_SB(1, 1), cB + hstepB + kstep, voffB);
    PG8_WAIT_V(6); PG8_BAR;
    for (;;) {
        const bool has_next = p.next(ui + 1, nxt);
        const char* nB = has_next ? p.b_tile(nxt) : cB;
        if constexpr (P::AUNI) nU = has_next ? p.a_base(nxt) : cU;
        else {
#pragma unroll
            for (int i = 0; i < 2; ++i) { nA0[i] = has_next ? p.a_row_off(nxt, Rr[i]) + Cc2[i] : cA0[i]; nA1[i] = has_next ? p.a_row_off(nxt, HALF + Rr[i]) + Cc2[i] : cA1[i]; } }
        for (int t = 0; t < nt; t += 2) {
            const bool last = (t == nt - 2);
            const char* a1 = Ab + (size_t)(t + 1) * kstep;
            const char* a2 = last ? (P::AUNI ? Ab0 + nU : Ab) : Ab + (size_t)(t + 2) * kstep; const char* b2 = last ? nB : cB + (size_t)(t + 2) * kstep;
            const char* a3 = a2 + kstep; const char* b3 = b2 + kstep;
            unsigned o0[2], o1[2];
#pragma unroll
            for (int i = 0; i < 2; ++i) { if constexpr (P::AUNI) { o0[i] = cA0[i]; o1[i] = cA1[i]; } else { o0[i] = last ? nA0[i] : cA0[i]; o1[i] = last ? nA1[i] : cA1[i]; } }
            PG8_LDB(B0, 0, 0); PG8_LDB(B1, 0, 1); PG8_SCHED; PG8_LDA(At, 0, 0); PG8_STAGE(PG8_SA(1, 1), a1, cA1);
            PG8_WAIT_V(8); PG8_WAIT_L(0); PG8_BAR; PG8_MMA(0, 0, At, B0); PG8_MMA(0, 1, At, B1); PG8_BAR; PG8_SCHED;
            PG8_LDA(At, 0, 1); PG8_STAGE(PG8_SB(0, 0), b2, voffB); PG8_STAGE(PG8_SB(0, 1), b2 + hstepB, voffB); PG8_STAGE(PG8_SA(0, 0), a2, o0);
            PG8_WAIT_V(8); PG8_WAIT_L(0); PG8_BAR; PG8_MMA(1, 0, At, B0); PG8_MMA(1, 1, At, B1); PG8_BAR; PG8_SCHED;
            PG8_LDB(B0, 1, 0); PG8_LDB(B1, 1, 1); PG8_SCHED; PG8_LDA(At, 1, 0); PG8_STAGE(PG8_SA(0, 1), a2, o1);
            PG8_WAIT_V(8); PG8_WAIT_L(0); PG8_BAR; PG8_MMA(0, 0, At, B0); PG8_MMA(0, 1, At, B1); PG8_BAR; PG8_SCHED;
            PG8_LDA(At, 1, 1); PG8_STAGE(PG8_SB(1, 0), b3, voffB); PG8_STAGE(PG8_SB(1, 1), b3 + hstepB, voffB); PG8_STAGE(PG8_SA(1, 0), a3, o0);
            PG8_WAIT_V(8); PG8_WAIT_L(0); PG8_BAR; PG8_MMA(1, 0, At, B0); PG8_MMA(1, 1, At, B1); PG8_BAR; PG8_SCHED;
        }
#ifndef PG8_NOALIGN
        if (wr == 0) PG8_BAR;
#endif
        if constexpr (P::FP8) asm volatile("s_nop 7\n\ts_nop 7" ::: "memory");
        p.epi(acc, cur, wr, wc, fr, fq);
        if (!has_next) break;
#pragma unroll
        for (int a = 0; a < 2; ++a)
#pragma unroll
            for (int b = 0; b < 2; ++b)
#pragma unroll
                for (int m = 0; m < 4; ++m)
#pragma unroll
                    for (int n = 0; n < 2; ++n) acc[a][b][m][n] = (f32x4){0.f, 0.f, 0.f, 0.f};
        cur = nxt; cB = nB; ++ui;
        if constexpr (P::AUNI) cU = nU;
        else {
#pragma unroll
            for (int i = 0; i < 2; ++i) { cA0[i] = nA0[i]; cA1[i] = nA1[i]; } }
#ifndef PG8_NOALIGN
        if (wr == 1) PG8_BAR;
#endif
    }
    PG8_WAIT_V(0);
#ifdef PG8_NOALIGN
    if (wr == 0) PG8_BAR;
#endif
    PG8_BAR;
#undef Ab
#undef PG8_SA
#undef PG8_SB
#undef PG8_STAGE
#undef PG8_LDA
#undef PG8_LDB
#undef PG8_MMA
#undef PG8_WAIT_V
#undef PG8_WAIT_L
#undef PG8_BAR
#undef PG8_SCHED
}
struct TileOrder {
    int nM, nN, nwg, G, c;
    __device__ void init(int M, int N, int G_, int c_) { nM = M / BM; nN = N / BM; nwg = nM * nN; G = G_; c = c_; }
    __device__ bool next(int i, GU& u) const {
        const long L = (long)i * G + c; if (L >= nwg) return false;
        int wgid = (int)L; { const int q = nwg / 8, r = nwg % 8, xcd = wgid % 8, off = wgid / 8; wgid = (xcd < r ? xcd * (q + 1) : r * (q + 1) + (xcd - r) * q) + off; }
        const int WGM = 8; const int nig = WGM * nN, gid = wgid / nig, fm = gid * WGM, gsz = (nM - fm) < WGM ? (nM - fm) : WGM;
        u.pm = fm + ((wgid % nig) % gsz); u.pn = (wgid % nig) / gsz; u.e = 0; return true;
    }
};
}
using pg8::GU;

struct Args { const float* in[41]; float* out; unsigned char* ws; int ph_lo, ph_hi; };

struct GemmPlain {
    static constexpr bool AUNI = true;
    static constexpr bool FP8 = false;
    static constexpr bool PERM = true;
    const char* A; int K; unsigned lda2, ldb2; const char* Bt; pg8::TileOrder ord;
    bf16_t* C; int ldc;
    DI bool next(int i, GU& u) const { return ord.next(i, u); }
    DI unsigned a_row_off(const GU& u, int r) const { return (unsigned)(u.pm * 256 + r) * lda2; }
    DI size_t a_base(const GU& u) const { return (size_t)(u.pm * 256) * lda2; }
    DI const char* b_tile(const GU& u) const { return Bt + (size_t)u.pn * 256 * ldb2; }
    DI void epi(const f32x4 (&acc)[2][2][4][2], const GU& u, int wr, int wc, int fr, int fq) const {
        const int row0 = u.pm * 256 + wr * 64 + fr, col0 = u.pn * 256 + wc * 32 + 8 * fq;
#pragma unroll
        for (int ai = 0; ai < 2; ++ai)
#pragma unroll
            for (int m = 0; m < 4; ++m) { bf16_t* rowp = C + (size_t)(row0 + ai * 128 + m * 16) * ldc + col0;
#pragma unroll
                for (int bj = 0; bj < 2; ++bj) { const f32x4 v0 = acc[ai][bj][m][0], v1 = acc[ai][bj][m][1];
                    u32x4 w; w.x = cvt_pk_bf16(v0[0], v0[1]); w.y = cvt_pk_bf16(v0[2], v0[3]); w.z = cvt_pk_bf16(v1[0], v1[1]); w.w = cvt_pk_bf16(v1[2], v1[3]);
                    *(u32x4*)(rowp + bj * 128) = w; } }
    }
};
template <bool RES32, bool FP8_>
struct GemmResid {
    static constexpr bool AUNI = true;
    static constexpr bool FP8 = FP8_;
    static constexpr bool PERM = true;
    const char* A; int K; unsigned lda2, ldb2; const char* Bt; pg8::TileOrder ord;
    const float* res32; const bf16_t* res16; bf16_t* out;
    DI bool next(int i, GU& u) const { return ord.next(i, u); }
    DI unsigned a_row_off(const GU& u, int r) const { return (unsigned)(u.pm * 256 + r) * lda2; }
    DI size_t a_base(const GU& u) const { return (size_t)(u.pm * 256) * lda2; }
    DI const char* b_tile(const GU& u) const { return Bt + (size_t)u.pn * 256 * ldb2; }
    DI void epi(const f32x4 (&acc)[2][2][4][2], const GU& u, int wr, int wc, int fr, int fq) const {
        const int col0 = u.pn * 256 + wc * 32 + 8 * fq; const size_t rbase = (size_t)(u.pm * 256 + wr * 64 + fr) * D + col0;
        if constexpr (RES32) {
#pragma unroll
            for (int ai = 0; ai < 2; ++ai) {
                f32x4 r[4][2][2];
#pragma unroll
                for (int m = 0; m < 4; ++m)
#pragma unroll
                    for (int bj = 0; bj < 2; ++bj) { const float* rp = res32 + rbase + (size_t)(ai * 128 + m * 16) * D + bj * 128; r[m][bj][0] = *(const f32x4*)rp; r[m][bj][1] = *(const f32x4*)(rp + 4); }
#pragma unroll
                for (int m = 0; m < 4; ++m)
#pragma unroll
                    for (int bj = 0; bj < 2; ++bj) { const f32x4 v0 = r[m][bj][0] * DN_ALPHA + acc[ai][bj][m][0], v1 = r[m][bj][1] * DN_ALPHA + acc[ai][bj][m][1];
                        u32x4 w; w.x = cvt_pk_bf16(v0[0], v0[1]); w.y = cvt_pk_bf16(v0[2], v0[3]); w.z = cvt_pk_bf16(v1[0], v1[1]); w.w = cvt_pk_bf16(v1[2], v1[3]);
                        *(u32x4*)(out + rbase + (size_t)(ai * 128 + m * 16) * D + bj * 128) = w; }
            }
        } else {
            u32x4 r[2][4][2];
#pragma unroll
            for (int ai = 0; ai < 2; ++ai)
#pragma unroll
                for (int m = 0; m < 4; ++m)
#pragma unroll
                    for (int bj = 0; bj < 2; ++bj) r[ai][m][bj] = *(const u32x4*)(res16 + rbase + (size_t)(ai * 128 + m * 16) * D + bj * 128);
#pragma unroll
            for (int ai = 0; ai < 2; ++ai)
#pragma unroll
                for (int m = 0; m < 4; ++m)
#pragma unroll
                    for (int bj = 0; bj < 2; ++bj) { const u32x4 q = r[ai][m][bj]; const float sc = FP8_ ? 0.03125f : 1.0f; const f32x4 a0 = acc[ai][bj][m][0] * sc, a1 = acc[ai][bj][m][1] * sc;
                        u32x4 w; w.x = cvt_pk_bf16(bflo(q.x) * DN_ALPHA + a0[0], bfhi(q.x) * DN_ALPHA + a0[1]); w.y = cvt_pk_bf16(bflo(q.y) * DN_ALPHA + a0[2], bfhi(q.y) * DN_ALPHA + a0[3]);
                        w.z = cvt_pk_bf16(bflo(q.z) * DN_ALPHA + a1[0], bfhi(q.z) * DN_ALPHA + a1[1]); w.w = cvt_pk_bf16(bflo(q.w) * DN_ALPHA + a1[2], bfhi(q.w) * DN_ALPHA + a1[3]);
                        *(u32x4*)(out + rbase + (size_t)(ai * 128 + m * 16) * D + bj * 128) = w; }
        }
    }
};
struct MoeTab { const LAS int* tbase; const LAS int* cnt; int ntiles; };
struct GemmMoeUp {
    static constexpr bool AUNI = false;
    static constexpr bool FP8 = true;
    static constexpr bool PERM = true;
    const char* A; int K; unsigned lda2, ldb2; const char* Bt; int G, c;
    MoeTab tab; const unsigned* list; bf16_t* H;
    DI bool next(int i, GU& u) const {
        const int L = i * G + c; if (L >= tab.ntiles * 4) return false;
        const int tile = L >> 2; u.pn = L & 3; int e = 0;
#pragma unroll 1
        while (tab.tbase[e + 1] <= tile) ++e;
        u.e = e; u.pm = tile - tab.tbase[e]; return true;
    }
    DI unsigned a_row_off(const GU& u, int r) const {
        const int li = u.pm * 256 + r; const int cn = tab.cnt[u.e];
        const unsigned slot = li < cn ? list[(size_t)u.e * T + li] : 0u;
        return (slot >> 1) * lda2;
    }
    DI size_t a_base(const GU&) const { return 0; }
    DI const char* b_tile(const GU& u) const { return Bt + ((size_t)u.e * 1024 + (size_t)u.pn * 256) * ldb2; }
    DI void epi(const f32x4 (&acc)[2][2][4][2], const GU& u, int wr, int wc, int fr, int fq) const {
        const int hrow0 = (tab.tbase[u.e] + u.pm) * 256 + wr * 64 + fr, col0 = u.pn * 128 + wc * 32 + 8 * fq;
#pragma unroll
        for (int ai = 0; ai < 2; ++ai)
#pragma unroll
            for (int m = 0; m < 4; ++m) { unsigned char* rowp = (unsigned char*)H + (size_t)(hrow0 + ai * 128 + m * 16) * FF + col0;
                float h[8];
#pragma unroll
                for (int n = 0; n < 2; ++n)
#pragma unroll
                    for (int j = 0; j < 4; ++j) { const float g = acc[ai][0][m][n][j] * 0.03125f, uu = acc[ai][1][m][n][j] * 0.03125f; h[n * 4 + j] = g * uu * __builtin_amdgcn_rcpf(1.0f + __builtin_amdgcn_exp2f(-1.4426950408889634f * g)); }
                int w0 = 0, w1 = 0; w0 = __builtin_amdgcn_cvt_pk_fp8_f32(h[0], h[1], w0, false); w0 = __builtin_amdgcn_cvt_pk_fp8_f32(h[2], h[3], w0, true);
                w1 = __builtin_amdgcn_cvt_pk_fp8_f32(h[4], h[5], w1, false); w1 = __builtin_amdgcn_cvt_pk_fp8_f32(h[6], h[7], w1, true);
                *(u32x2*)rowp = (u32x2){(unsigned)w0, (unsigned)w1}; }
    }
};
struct GemmMoeDown {
    static constexpr bool AUNI = true;
    static constexpr bool FP8 = true;
    static constexpr bool PERM = true;
    const char* A; int K; unsigned lda2, ldb2; const char* Bt; int G, c;
    MoeTab tab; bf16_t* Y;
    DI bool next(int i, GU& u) const {
        const int L = i * G + c; if (L >= tab.ntiles * 4) return false;
        const int tile = L >> 2; u.pn = L & 3; int e = 0;
#pragma unroll 1
        while (tab.tbase[e + 1] <= tile) ++e;
        u.e = e; u.pm = tile - tab.tbase[e]; return true;
    }
    DI unsigned a_row_off(const GU& u, int r) const { return (unsigned)((tab.tbase[u.e] + u.pm) * 256 + r) * lda2; }
    DI size_t a_base(const GU& u) const { return (size_t)((tab.tbase[u.e] + u.pm) * 256) * lda2; }
    DI const char* b_tile(const GU& u) const { return Bt + ((size_t)u.e * 1024 + (size_t)u.pn * 256) * ldb2; }
    DI void epi(const f32x4 (&acc)[2][2][4][2], const GU& u, int wr, int wc, int fr, int fq) const {
        const int row0 = (tab.tbase[u.e] + u.pm) * 256 + wr * 64 + fr, col0 = u.pn * 256 + wc * 32 + 8 * fq;
#pragma unroll
        for (int ai = 0; ai < 2; ++ai)
#pragma unroll
            for (int m = 0; m < 4; ++m) { bf16_t* rowp = Y + (size_t)(row0 + ai * 128 + m * 16) * D + col0;
#pragma unroll
                for (int bj = 0; bj < 2; ++bj) { const f32x4 v0 = acc[ai][bj][m][0] * 0.03125f, v1 = acc[ai][bj][m][1] * 0.03125f;
                    u32x4 w; w.x = cvt_pk_bf16(v0[0], v0[1]); w.y = cvt_pk_bf16(v0[2], v0[3]); w.z = cvt_pk_bf16(v1[0], v1[1]); w.w = cvt_pk_bf16(v1[2], v1[3]);
                    *(u32x4*)(rowp + bj * 128) = w; } }
    }
};

#define XB_TMO      128
#define XB_XCNT(j)  (256  + 64 * (j))
#define XB_XSUB(j)  (1280 + 64 * (j))
#define XB_XGEN(j)  (2304 + 64 * (j))
#define XB_TOP      3328
#define XB_TOPGEN   3392
#define XCD_BAR_WORDS 3456
#define XB_SPIN_CAP (1u << 18)
__device__ __forceinline__ unsigned xb_ld(unsigned* p)              { return __hip_atomic_load(p, __ATOMIC_RELAXED, __HIP_MEMORY_SCOPE_AGENT); }
__device__ __forceinline__ unsigned xb_add(unsigned* p, unsigned v) { return __hip_atomic_fetch_add(p, v, __ATOMIC_RELAXED, __HIP_MEMORY_SCOPE_AGENT); }
__device__ __forceinline__ unsigned xb_xcc_id() { return (unsigned)__builtin_amdgcn_s_getreg((3 << 11) | 20) & 0xFu; }
#define XB_SPIN(cond, bar) do { unsigned _sp = 0; while (cond) { __builtin_amdgcn_s_sleep(1); \
    if ((++_sp & 255u) == 0u) { if (xb_ld(&(bar)[XB_TMO])) break; if (_sp > XB_SPIN_CAP) { atomicAdd(&(bar)[XB_TMO], 1u); break; } } } } while (0)
struct XcdBarrier { unsigned* bar; unsigned x; volatile LAS unsigned* st; };
__device__ __forceinline__ XcdBarrier xcd_barrier_post(unsigned* bar, volatile LAS unsigned* st) {
    XcdBarrier b; b.bar = bar; b.x = xb_xcc_id(); b.st = st;
    if (threadIdx.x == 0) (void)xb_add(&bar[XB_XCNT(b.x)], 1u);
    return b;
}
__device__ __forceinline__ void xcd_barrier_complete(unsigned* bar, unsigned x, unsigned& nloc, unsigned& nx) {
    const unsigned G = gridDim.x * gridDim.y * gridDim.z;
    unsigned sum, cnt, mine, sp = 0u;
    for (;;) {
        sum = 0u; cnt = 0u; mine = 0u;
#pragma unroll
        for (unsigned j = 0; j < 16; ++j) { const unsigned c = xb_ld(&bar[XB_XCNT(j)]); sum += c; cnt += (c > 0u) ? 1u : 0u; mine = (j == x) ? c : mine; }
        if (sum == G) break;
        __builtin_amdgcn_s_sleep(1);
        if ((++sp & 255u) == 0u) { if (xb_ld(&bar[XB_TMO])) break; if (sp > XB_SPIN_CAP) { atomicAdd(&bar[XB_TMO], 1u); break; } }
    }
    nloc = mine > 0u ? mine : 1u; nx = cnt > 0u ? cnt : 1u;
}
__device__ __forceinline__ void xcd_barrier(const XcdBarrier& b) {
    asm volatile("s_waitcnt vmcnt(0)" ::: "memory");
    __syncthreads();
    if (threadIdx.x == 0) {
        unsigned* bar = b.bar;
        __builtin_amdgcn_s_waitcnt(0);
        unsigned nloc = b.st[0], nx = b.st[1];
        if (nloc == 0u) { xcd_barrier_complete(bar, b.x, nloc, nx); b.st[0] = nloc; b.st[1] = nx; }
        const unsigned old = xb_add(&bar[XB_XSUB(b.x)], 1u);
        const unsigned gen = old / nloc;
        if (old + 1u == (gen + 1u) * nloc) {
            __builtin_amdgcn_fence(__ATOMIC_RELEASE, "agent");
            asm volatile("s_waitcnt vmcnt(0)" ::: "memory");
            const unsigned og = xb_add(&bar[XB_TOP], 1u);
            const unsigned tg = og / nx;
            if (og + 1u == (tg + 1u) * nx) xb_add(&bar[XB_TOPGEN], 1u);
            else XB_SPIN(xb_ld(&bar[XB_TOPGEN]) == tg, bar);
            __builtin_amdgcn_fence(__ATOMIC_ACQUIRE, "agent");
            xb_add(&bar[XB_XGEN(b.x)], 1u);
            asm volatile("s_waitcnt vmcnt(0)" ::: "memory");
        } else {
            XB_SPIN(xb_ld(&bar[XB_XGEN(b.x)]) == gen, bar);
            __builtin_amdgcn_fence(__ATOMIC_ACQUIRE, "agent");
            asm volatile("s_waitcnt vmcnt(0)" ::: "memory");
        }
    }
    __syncthreads();
}

struct Frame {
    LAS unsigned char* lds;
    int tid, lane, wave, vcu, G;
    const float* const* in; float* out; unsigned char* ws;
};
constexpr int LDS_RING = 131072;
constexpr int LDS_MISC = LDS_RING;
constexpr int LDS_BYTES = 147456;

template <class Map>
DI void p0_transpose_item(const float* W, int K, int N, bf16_t* WT, const Map& map, LAS float* scr_, int item, int lane) {
    LAS unsigned char* scr = (LAS unsigned char*)scr_;
    const int nblk = (N + 63) / 64, kb = item / nblk, nb = item % nblk, k0 = 64 * kb, n0 = 64 * nb;
    const int kk = lane >> 4, n4 = 4 * (lane & 15);
    const bool nok = (n0 + n4) < N;
    f32x4 v[16];
#pragma unroll
    for (int i = 0; i < 16; ++i) v[i] = nok ? *(const f32x4*)(W + (size_t)(k0 + 16 * kk + i) * N + n0 + n4) : (f32x4){0.f, 0.f, 0.f, 0.f};
#pragma unroll
    for (int c = 0; c < 4; ++c) {
        u32x4 lo, hi;
        lo.x = pk2(v[0][c], v[1][c]); lo.y = pk2(v[2][c], v[3][c]); lo.z = pk2(v[4][c], v[5][c]); lo.w = pk2(v[6][c], v[7][c]);
        hi.x = pk2(v[8][c], v[9][c]); hi.y = pk2(v[10][c], v[11][c]); hi.z = pk2(v[12][c], v[13][c]); hi.w = pk2(v[14][c], v[15][c]);
        *(LAS u32x4*)(scr + (n4 + c) * 144 + kk * 32) = lo; *(LAS u32x4*)(scr + (n4 + c) * 144 + kk * 32 + 16) = hi;
    }
    LDS_WAIT(); asm volatile("" ::: "memory");
#pragma unroll
    for (int j = 0; j < 8; ++j) { const int n = (lane >> 3) + 8 * j, ch = lane & 7;
        const u32x4 o = *(const LAS u32x4*)(scr + n * 144 + ch * 16);
        if (n0 + n < N) *(u32x4*)(WT + (size_t)map(n0 + n) * K + k0 + 8 * ch) = o; }
    LDS_WAIT(); asm volatile("" ::: "memory");
}
template <class Map>
DI void p0_transpose_item_f8(const float* W, int K, int N, unsigned char* WT, const Map& map, LAS float* scr_, int item, int lane) {
    LAS unsigned char* scr = (LAS unsigned char*)scr_;
    const int nblk = (N + 63) / 64, kb = item / nblk, nb = item % nblk, k0 = 64 * kb, n0 = 64 * nb;
    const int kk = lane >> 4, n4 = 4 * (lane & 15);
    const bool nok = (n0 + n4) < N;
    f32x4 v[16];
#pragma unroll
    for (int i = 0; i < 16; ++i) v[i] = nok ? *(const f32x4*)(W + (size_t)(k0 + 16 * kk + i) * N + n0 + n4) * 32.0f : (f32x4){0.f, 0.f, 0.f, 0.f};
#pragma unroll
    for (int c = 0; c < 4; ++c) { int w[4];
#pragma unroll
        for (int q = 0; q < 4; ++q) { int x = 0; x = __builtin_amdgcn_cvt_pk_fp8_f32(v[4 * q][c], v[4 * q + 1][c], x, false); x = __builtin_amdgcn_cvt_pk_fp8_f32(v[4 * q + 2][c], v[4 * q + 3][c], x, true); w[q] = x; }
        *(LAS u32x4*)(scr + (n4 + c) * 80 + kk * 16) = (u32x4){(unsigned)w[0], (unsigned)w[1], (unsigned)w[2], (unsigned)w[3]}; }
    LDS_WAIT(); asm volatile("" ::: "memory");
#pragma unroll
    for (int j = 0; j < 4; ++j) { const int n = (lane >> 2) + 16 * j, ch = lane & 3;
        const u32x4 o = *(const LAS u32x4*)(scr + n * 80 + ch * 16);
        if (n0 + n < N) *(u32x4*)(WT + (size_t)map(n0 + n) * K + k0 + 16 * ch) = o; }
    LDS_WAIT(); asm volatile("" ::: "memory");
}
struct MapId { int off; DI int operator()(int n) const { return n + off; } };
DI int rope_perm(int d) { return (d & 15) | ((d & 16) << 1) | ((d & 32) >> 1); }
struct MapL1In { DI int operator()(int n) const {
    if (n < 1024) return (n & ~63) | rope_perm(n & 63);
    if (n < 2560) { const int j = (n - 1024) >> 8; return (j & 1) ? n : ((n & ~63) | rope_perm(n & 63)); }
    return n; } };
struct MapGU { int up; DI int operator()(int c) const { return (c >> 7) * 256 + up * 128 + (c & 127); } };

DI void p0_prep(Frame& F) {
    LAS float* scr = (LAS float*)(F.lds + F.wave * 16384);
    const int gw = F.vcu * NWAVES + F.wave, NGW = F.G * NWAVES;
    const int gt = F.vcu * NTHR + F.tid, NGT = F.G * NTHR;
    unsigned char* ws = F.ws;
    for (int i = gt; i < CTL_WORDS; i += NGT) ((unsigned*)(ws + WS_CTL))[i] = 0u;
    constexpr int I_W0IN = 16 * 40, I_W0OUT = 16 * 16, I_W1IN = 16 * 41, I_W1OUT = 16 * 16, I_WC1 = 32 * 4, I_WC2 = 4 * 1, I_MOE = 32 * 128;
    constexpr int NITEMS = I_W0IN + I_W0OUT + I_W1IN + I_W1OUT + 2 * I_WC1 + 2 * I_WC2 + 3 * I_MOE;
    for (int it = gw; it < NITEMS; it += NGW) {
        int r = it;
        if (r < I_W0IN) { p0_transpose_item(F.in[1], 1024, L0N, (bf16_t*)(ws + WS_W0IN), MapId{0}, scr, r, F.lane); continue; } r -= I_W0IN;
        if (r < I_W0OUT) { p0_transpose_item(F.in[10], 1024, 1024, (bf16_t*)(ws + WS_W0OUT), MapId{0}, scr, r, F.lane); continue; } r -= I_W0OUT;
        if (r < I_W1IN) { p0_transpose_item_f8(F.in[22], 1024, L1N, ws + WS_W1IN, MapL1In{}, scr, r, F.lane); continue; } r -= I_W1IN;
        if (r < I_W1OUT) { p0_transpose_item_f8(F.in[29], 1024, 1024, ws + WS_W1OUT, MapId{0}, scr, r, F.lane); continue; } r -= I_W1OUT;
        if (r < I_WC1) { p0_transpose_item(F.in[24], 2048, 256, (bf16_t*)(ws + WS_WC1), MapId{0}, scr, r, F.lane); continue; } r -= I_WC1;
        if (r < I_WC1) { p0_transpose_item(F.in[27], 2048, 256, (bf16_t*)(ws + WS_WC1) + 256 * 2048, MapId{0}, scr, r, F.lane); continue; } r -= I_WC1;
        if (r < I_WC2) { p0_transpose_item(F.in[25], 256, 64, (bf16_t*)(ws + WS_WC2), MapId{0}, scr, r, F.lane); continue; } r -= I_WC2;
        if (r < I_WC2) { p0_transpose_item(F.in[28], 256, 64, (bf16_t*)(ws + WS_WC2) + 256 * 256, MapId{0}, scr, r, F.lane); continue; } r -= I_WC2;
#pragma unroll 1
        for (int l = 0; l < 1; ++l) {
            const int ib = l ? 36 : 17; unsigned char* wgu = ws + (l ? WS_WGU1 : WS_WGU0); unsigned char* wd = ws + (l ? WS_WD1 : WS_WD0);
            if (r < I_MOE) { const int e = r >> 7; p0_transpose_item_f8(F.in[ib] + (size_t)e * 1024 * 512, 1024, 512, wgu + (size_t)e * 1024 * 1024, MapGU{0}, scr, r & 127, F.lane); r = -1; break; } r -= I_MOE;
            if (r < I_MOE) { const int e = r >> 7; p0_transpose_item_f8(F.in[ib + 1] + (size_t)e * 1024 * 512, 1024, 512, wgu + (size_t)e * 1024 * 1024, MapGU{1}, scr, r & 127, F.lane); r = -1; break; } r -= I_MOE;
            if (r < I_MOE) { const int e = r >> 7; p0_transpose_item_f8(F.in[ib + 2] + (size_t)e * 512 * 1024, 512, 1024, wd + (size_t)e * 1024 * 512, MapId{0}, scr, r & 127, F.lane); r = -1; break; } r -= I_MOE;
        }
    }
    { u32x4 z = (u32x4){0u, 0u, 0u, 0u};
      u32x4* p1 = (u32x4*)(ws + WS_W1IN + (size_t)L1N * 1024); const int n1 = (L1NP - L1N) * 1024 / 16;
      for (int i = gt; i < n1; i += NGT) p1[i] = z;
      for (int kv = 0; kv < 2; ++kv) { u32x4* p2 = (u32x4*)((bf16_t*)(ws + WS_WC2) + (size_t)kv * 65536 + 64 * 256); const int n2 = 192 * 256 / 8; for (int i = gt; i < n2; i += NGT) p2[i] = z; } }
    { const float* x = F.in[0]; bf16_t* xb = (bf16_t*)(ws + WS_XB);
      for (int m = gw; m < T; m += NGW) { const f32x4* xr = (const f32x4*)(x + (size_t)m * D) + F.lane; u32x2* o = (u32x2*)(xb + (size_t)m * D) + F.lane;
#pragma unroll
          for (int j = 0; j < 4; ++j) { const f32x4 v = xr[64 * j]; o[64 * j] = (u32x2){pk2(v.x, v.y), pk2(v.z, v.w)}; } } }
    { float* ct = (float*)(ws + WS_COS); float* st = (float*)(ws + WS_SIN);
      for (int i = gt; i < SEQ * 32; i += NGT) { const int pos = i >> 5, k = i & 31; const float inv = (float)pow(10000.0, -(double)(2 * k) / 64.0); const float ang = (float)pos * inv;
          ct[i] = (float)cos((double)ang); st[i] = (float)sin((double)ang); } }
    { bf16_t* bt = (bf16_t*)(ws + WS_SMALL + SM_LRUBT);
      for (int i = gt; i < 2 * 8 * 4096; i += NGT) { const int g = i >> 15, h = (i >> 12) & 7, j = (i >> 6) & 63, ii = i & 63; const float* w = F.in[g ? 7 : 5];
          bt[i] = (bf16_t)f2bf(w[h * 4096 + ii * 64 + j]); } }
    { float* rw = (float*)(ws + WS_SMALL + SM_RWT);
      for (int i = gt; i < 2 * 36 * 1024; i += NGT) { const int l = i / (36 * 1024), o = (i / 1024) % 36, k = i & 1023; const float* wg = F.in[l ? 32 : 13]; const float* we = F.in[l ? 34 : 15];
          rw[i] = o < 4 ? wg[k * 4 + o] : we[k * 32 + (o - 4)]; } }
    { float* cb = (float*)(ws + WS_SMALL + SM_CBIAS);
      for (int o = gw; o < 512; o += NGW) { const int kv = o >> 8, j = o & 255; const float* pe = F.in[kv ? 26 : 23]; const float* w1 = F.in[kv ? 27 : 24];
          float s = 0.f; for (int k = F.lane; k < 2048; k += 64) s += pe[k] * w1[(size_t)k * 256 + j];
          s = wave_sum(s); if (F.lane == 0) cb[o] = s; } }
}

DI void p0_moe1(Frame& F, int first) {
    LAS float* scr = (LAS float*)(F.lds + F.wave * 16384);
    const int nb = F.G - first; if (nb <= 0 || (int)blockIdx.x < first) return;
    const int gw = ((int)blockIdx.x - first) * NWAVES + F.wave, NGW = nb * NWAVES;
    unsigned char* ws = F.ws; constexpr int I_MOE = 32 * 128;
    unsigned char* wgu = ws + WS_WGU1; unsigned char* wd = ws + WS_WD1;
    for (int it = gw; it < 3 * I_MOE; it += NGW) {
        int r = it;
        if (r < I_MOE) { const int e = r >> 7; p0_transpose_item_f8(F.in[36] + (size_t)e * 1024 * 512, 1024, 512, wgu + (size_t)e * 1024 * 1024, MapGU{0}, scr, r & 127, F.lane); continue; } r -= I_MOE;
        if (r < I_MOE) { const int e = r >> 7; p0_transpose_item_f8(F.in[37] + (size_t)e * 1024 * 512, 1024, 512, wgu + (size_t)e * 1024 * 1024, MapGU{1}, scr, r & 127, F.lane); continue; } r -= I_MOE;
        { const int e = r >> 7; p0_transpose_item_f8(F.in[38] + (size_t)e * 512 * 1024, 512, 1024, wd + (size_t)e * 1024 * 512, MapId{0}, scr, r & 127, F.lane); }
    }
}

constexpr int XCL_STRIDE = 520;
constexpr int LDS_XC = 0, LDS_GT = 66560, LDS_HIN = 133120;
DI f32x2 lds_swap(float v) { auto rr = __builtin_amdgcn_permlane32_swap(__float_as_uint(v), __float_as_uint(v), false, false); return (f32x2){__uint_as_float(rr[0]), __uint_as_float(rr[1])}; }

template <int CTRL> DI float quad_xor(float v) { return __int_as_float(__builtin_amdgcn_mov_dpp(__float_as_int(v), CTRL, 0xF, 0xF, true)); }

template <bool FINAL>
DI void lru_tile(Frame& F, int b, int ch) {
    const unsigned char* ws = F.ws;
    const bf16_t* z = (const bf16_t*)(ws + WS_Z);
    bf16_t* ycat = (bf16_t*)(ws + WS_XB);
    f32x2* SAH = (f32x2*)(ws + WS_SCAN);
    LAS bf16_t* xcL = (LAS bf16_t*)(F.lds + LDS_XC); LAS bf16_t* gL = (LAS bf16_t*)(F.lds + LDS_GT); LAS float* hin = (LAS float*)(F.lds + LDS_HIN);
    const int tid = F.tid, lane = F.lane, wave = F.wave;
    const int t0 = ch * 64; const size_t row0 = (size_t)b * SEQ + t0;
    const int c8 = tid & 63, tg = tid >> 6;
    {
        float w[4][8], bias[8];
        const float* cw = F.in[3]; const float* cbv = F.in[4];
#pragma unroll
        for (int k = 0; k < 4; ++k)
#pragma unroll
            for (int j = 0; j < 8; ++j) w[k][j] = cw[k * 512 + c8 * 8 + j];
#pragma unroll
        for (int j = 0; j < 8; ++j) bias[j] = cbv[c8 * 8 + j];
        float xv[11][8];
#pragma unroll
        for (int i = 0; i < 11; ++i) { const int t = t0 + tg * 8 + i - 3;
            if (t >= 0) { const u32x4 v = *(const u32x4*)(z + ((size_t)b * SEQ + t) * L0N + 2048 + c8 * 8);
                xv[i][0] = bflo(v.x); xv[i][1] = bfhi(v.x); xv[i][2] = bflo(v.y); xv[i][3] = bfhi(v.y); xv[i][4] = bflo(v.z); xv[i][5] = bfhi(v.z); xv[i][6] = bflo(v.w); xv[i][7] = bfhi(v.w); }
            else {
#pragma unroll
                for (int j = 0; j < 8; ++j) xv[i][j] = 0.f; } }
#pragma unroll
        for (int i = 0; i < 8; ++i) { float o[8];
#pragma unroll
            for (int j = 0; j < 8; ++j) o[j] = bias[j] + w[0][j] * xv[i][j] + w[1][j] * xv[i + 1][j] + w[2][j] * xv[i + 2][j] + w[3][j] * xv[i + 3][j];
            u32x4 pk; pk.x = pk2(o[0], o[1]); pk.y = pk2(o[2], o[3]); pk.z = pk2(o[4], o[5]); pk.w = pk2(o[6], o[7]);
            *(LAS u32x4*)(xcL + (tg * 8 + i) * XCL_STRIDE + c8 * 8) = pk; }
    }
    if constexpr (FINAL) {
#pragma unroll
        for (int i = 0; i < 8; ++i) { const int tl = tg * 8 + i; const u32x4 v = *(const u32x4*)(z + (row0 + tl) * L0N + 1536 + c8 * 8); *(LAS u32x4*)(gL + tl * XCL_STRIDE + c8 * 8) = v; }
        float w[3][8]; const float* cw = F.in[2];
#pragma unroll
        for (int k = 0; k < 3; ++k)
#pragma unroll
            for (int j = 0; j < 8; ++j) w[k][j] = cw[k * 512 + c8 * 8 + j];
        float pv[10][8];
#pragma unroll
        for (int i = 0; i < 10; ++i) { const int t = t0 + tg * 8 + i - 2;
            if (t >= 0) { const bf16_t* zr = z + ((size_t)b * SEQ + t) * L0N + c8 * 8; const u32x4 a = *(const u32x4*)(zr + 512), c = *(const u32x4*)(zr + 1024);
                pv[i][0] = bflo(a.x) * bflo(c.x); pv[i][1] = bfhi(a.x) * bfhi(c.x); pv[i][2] = bflo(a.y) * bflo(c.y); pv[i][3] = bfhi(a.y) * bfhi(c.y);
                pv[i][4] = bflo(a.z) * bflo(c.z); pv[i][5] = bfhi(a.z) * bfhi(c.z); pv[i][6] = bflo(a.w) * bflo(c.w); pv[i][7] = bfhi(a.w) * bfhi(c.w); }
            else {
#pragma unroll
                for (int j = 0; j < 8; ++j) pv[i][j] = 0.f; } }
#pragma unroll
        for (int i = 0; i < 8; ++i) { const int tl = tg * 8 + i; const u32x4 bgv = *(const u32x4*)(z + (row0 + tl) * L0N + c8 * 8);
            const float bgf[8] = {bflo(bgv.x), bfhi(bgv.x), bflo(bgv.y), bfhi(bgv.y), bflo(bgv.z), bfhi(bgv.z), bflo(bgv.w), bfhi(bgv.w)};
            float o[8];
#pragma unroll
            for (int j = 0; j < 8; ++j) o[j] = bgf[j] * (w[0][j] * pv[i][j] + w[1][j] * pv[i + 1][j] + w[2][j] * pv[i + 2][j]);
            u32x4 pk; pk.x = pk2(o[0], o[1]); pk.y = pk2(o[2], o[3]); pk.z = pk2(o[4], o[5]); pk.w = pk2(o[6], o[7]);
            *(u32x4*)(ycat + (row0 + tl) * D + c8 * 8) = pk; }
        { float h = 0.f; const f32x4* sp4 = (const f32x4*)(SAH + ((size_t)b * 512 + tid) * 128);
#pragma unroll 8
          for (int k2 = 0; k2 < (ch >> 1); ++k2) { const f32x4 v = sp4[k2]; h = v.x * h + v.y; h = v.z * h + v.w; }
          if (ch & 1) { const f32x2 v = SAH[((size_t)b * 512 + tid) * 128 + ch - 1]; h = v.x * h + v.y; }
          hin[tid] = h; }
    }
    __syncthreads();
    {
        const int head = wave, r32 = lane & 31, hh = lane >> 5;
        const bf16_t* lbt = (const bf16_t*)(ws + WS_SMALL + SM_LRUBT);
        const float* b_a = F.in[6]; const float* b_x = F.in[8]; const float* lam = F.in[9];
#pragma unroll 1
        for (int ct = 0; ct < 2; ++ct) {
            const int c = head * 64 + ct * 32 + r32;
            f32x16 acc[2][2];
#pragma unroll
            for (int g = 0; g < 2; ++g)
#pragma unroll
                for (int rt = 0; rt < 2; ++rt)
#pragma unroll
                    for (int i = 0; i < 16; ++i) acc[g][rt][i] = 0.f;
#pragma unroll
            for (int ks = 0; ks < 4; ++ks) {
                bf16x8 af[2], bfr[2];
#pragma unroll
                for (int rt = 0; rt < 2; ++rt) af[rt] = *(const LAS bf16x8*)(xcL + (rt * 32 + r32) * XCL_STRIDE + head * 64 + ks * 16 + hh * 8);
#pragma unroll
                for (int g = 0; g < 2; ++g) bfr[g] = *(const bf16x8*)(lbt + ((size_t)(g * 8 + head) * 64 + ct * 32 + r32) * 64 + ks * 16 + hh * 8);
#pragma unroll
                for (int g = 0; g < 2; ++g)
#pragma unroll
                    for (int rt = 0; rt < 2; ++rt) acc[g][rt] = __builtin_amdgcn_mfma_f32_32x32x16_bf16(af[rt], bfr[g], acc[g][rt], 0, 0, 0);
            }
            const float ba = b_a[c], bx = b_x[c]; const float lm = lam[c];
            const float sp = (lm > 15.f) ? __expf(-lm) : log1pf(__expf(-lm));
            float carry = FINAL ? hin[c] : 0.f, atot = 1.f;
#pragma unroll
            for (int rt = 0; rt < 2; ++rt) {
#pragma unroll
                for (int g4 = 0; g4 < 4; ++g4) {
                    float av[4], uv[4]; float Ag = 1.f, Hg = 0.f;
#pragma unroll
                    for (int j = 0; j < 4; ++j) { const int reg = g4 * 4 + j; const int tl = rt * 32 + 8 * g4 + 4 * hh + j;
                        const float r = sigmoidf_(acc[0][rt][reg] + ba), ig = sigmoidf_(acc[1][rt][reg] + bx);
                        const float a = __builtin_amdgcn_exp2f(-11.541560327111707f * r * sp); const float mult = __builtin_amdgcn_sqrtf(fmaxf((1.0f - a) * (1.0f + a), 0.f));
                        const float xc = bf2f(xcL[tl * XCL_STRIDE + c]);
                        av[j] = a; uv[j] = mult * ig * xc; Ag = a * Ag; Hg = a * Hg + uv[j]; }
                    const f32x2 As = lds_swap(Ag), Hs = lds_swap(Hg);
                    const float mid = As[0] * carry + Hs[0];
                    if constexpr (FINAL) {
                        float s = hh ? mid : carry;
#pragma unroll
                        for (int j = 0; j < 4; ++j) { const int tl = rt * 32 + 8 * g4 + 4 * hh + j; s = av[j] * s + uv[j];
                            const float gv = bf2f(gL[tl * XCL_STRIDE + c]); gL[tl * XCL_STRIDE + c] = (bf16_t)f2bf(s * gelu_tanh(gv)); }
                    }
                    carry = As[1] * mid + Hs[1]; atot = atot * As[0] * As[1];
                }
            }
            if constexpr (!FINAL) { if (hh == 0) SAH[((size_t)b * 512 + c) * 128 + ch] = (f32x2){atot, carry}; }
        }
    }
    __syncthreads();
    if constexpr (FINAL) {
#pragma unroll
        for (int i = 0; i < 8; ++i) { const int tl = tg * 8 + i; const u32x4 v = *(const LAS u32x4*)(gL + tl * XCL_STRIDE + c8 * 8); *(u32x4*)(ycat + (row0 + tl) * D + 512 + c8 * 8) = v; }
        __syncthreads();
    }
}

constexpr int LDS_RI = 0;
constexpr int LDS_HIST = 4096;
DI void ln_router_phase(Frame& F, int layer, const bf16_t* src) {
    bf16_t* xb = (bf16_t*)(F.ws + WS_XB); unsigned char* x8 = F.ws + WS_X8;
    const float* gam = F.in[layer ? 30 : 11]; const float* bet = F.in[layer ? 31 : 12];
    const float* rw = (const float*)(F.ws + WS_SMALL + SM_RWT) + (size_t)layer * 36 * 1024;
    const float* bg = F.in[layer ? 33 : 14]; const float* be = F.in[layer ? 35 : 16];
    unsigned* cnt = (unsigned*)(F.ws + WS_CTL) + CW_CNT + layer * 32 * 64;
    unsigned* list = (unsigned*)(F.ws + WS_LIST); float* wslot = (float*)(F.ws + WS_WSLOT); unsigned* posloc = (unsigned*)(F.ws + WS_POSLOC);
    LAS int* e0s = (LAS int*)(F.lds + LDS_RI); LAS int* e1s = e0s + 128; LAS float* w0s = (LAS float*)(e1s + 128); LAS float* w1s = w0s + 128;
    LAS int* hist = (LAS int*)(F.lds + LDS_HIST); LAS int* base = hist + 32;
    const int lane = F.lane;
    f32x4 gv[4], bv[4];
#pragma unroll
    for (int j = 0; j < 4; ++j) { gv[j] = ((const f32x4*)gam)[lane + 64 * j]; bv[j] = ((const f32x4*)bet)[lane + 64 * j]; }
    for (int chunk = F.vcu; chunk < T / 128; chunk += F.G) {
        if (F.tid < 32) hist[F.tid] = 0;
        __syncthreads();
        for (int rr = F.wave; rr < 128; rr += NWAVES) {
            const size_t row = (size_t)chunk * 128 + rr;
            const u32x2* xr = (const u32x2*)(src + row * D) + lane;
            f32x4 v[4]; float s = 0.f;
#pragma unroll
            for (int j = 0; j < 4; ++j) { const u32x2 q = xr[64 * j]; v[j] = (f32x4){bflo(q.x), bfhi(q.x), bflo(q.y), bfhi(q.y)}; s += (v[j].x + v[j].y) + (v[j].z + v[j].w); }
            const float mean = wave_sum(s) * (1.f / D); float s2 = 0.f;
#pragma unroll
            for (int j = 0; j < 4; ++j) { v[j] = v[j] - mean; s2 += (v[j].x * v[j].x + v[j].y * v[j].y) + (v[j].z * v[j].z + v[j].w * v[j].w); }
            const float rstd = 1.f / sqrtf(wave_sum(s2) * (1.f / D) + LN_EPS);
            u32x2* ob = (u32x2*)(xb + row * D) + lane;
#pragma unroll
            for (int j = 0; j < 4; ++j) { v[j] = v[j] * rstd * gv[j] + bv[j]; ob[64 * j] = (u32x2){pk2(v[j].x, v[j].y), pk2(v[j].z, v[j].w)};
                int w8 = 0; w8 = __builtin_amdgcn_cvt_pk_fp8_f32(v[j].x, v[j].y, w8, false); w8 = __builtin_amdgcn_cvt_pk_fp8_f32(v[j].z, v[j].w, w8, true); ((unsigned*)(x8 + row * D))[lane + 64 * j] = (unsigned)w8; }
            float gl[4];
#pragma unroll
            for (int o = 0; o < 4; ++o) { const f32x4* wr_ = (const f32x4*)(rw + o * 1024) + lane; float a = 0.f;
#pragma unroll
                for (int j = 0; j < 4; ++j) { const f32x4 w = wr_[64 * j]; a += (v[j].x * w.x + v[j].y * w.y) + (v[j].z * w.z + v[j].w * w.w); }
                gl[o] = wave_sum(a) + bg[o]; }
            float g0 = gl[0]; int gs = 0;
#pragma unroll
            for (int o = 1; o < 4; ++o) if (gl[o] > g0) { g0 = gl[o]; gs = o; }
            float gsum = 0.f;
#pragma unroll
            for (int o = 0; o < 4; ++o) gsum += __expf(gl[o] - g0);
            const float pgrp = 1.0f / gsum;
            gs = __builtin_amdgcn_readfirstlane(gs);
            float le[8];
#pragma unroll
            for (int hf = 0; hf < 2; ++hf) {
#pragma unroll
                for (int oo = 0; oo < 4; ++oo) { const int o = hf * 4 + oo; const f32x4* wr_ = (const f32x4*)(rw + (4 + gs * 8 + o) * 1024) + lane; float a = 0.f;
#pragma unroll
                    for (int j = 0; j < 4; ++j) { const f32x4 w = wr_[64 * j]; a += (v[j].x * w.x + v[j].y * w.y) + (v[j].z * w.z + v[j].w * w.w); }
                    le[o] = wave_sum(a) + be[gs * 8 + o]; }
                asm volatile("" ::: "memory"); }
            float m0 = le[0]; int i0 = 0;
#pragma unroll
            for (int o = 1; o < 8; ++o) if (le[o] > m0) { m0 = le[o]; i0 = o; }
            float m1 = -3.0e38f; int i1 = 0;
#pragma unroll
            for (int o = 0; o < 8; ++o) if (o != i0 && le[o] > m1) { m1 = le[o]; i1 = o; }
            const float e1 = __expf(m1 - m0); const float w0 = pgrp / (1.0f + e1), w1 = pgrp * e1 / (1.0f + e1);
            if (lane == 0) { e0s[rr] = gs * 8 + i0; e1s[rr] = gs * 8 + i1; w0s[rr] = w0; w1s[rr] = w1; }
        }
        __syncthreads();
        int myrank = 0, mye = 0;
        if (F.tid < 256) { const int rr = F.tid >> 1, k = F.tid & 1; mye = k ? e1s[rr] : e0s[rr]; myrank = atomicAdd((int*)&hist[mye], 1); }
        __syncthreads();
        if (F.tid < 32) { const int h = hist[F.tid]; base[F.tid] = h ? (int)atomicAdd(&cnt[64 * F.tid], (unsigned)h) : 0; }
        __syncthreads();
        if (F.tid < 256) { const int rr = F.tid >> 1, k = F.tid & 1; const unsigned slot = (unsigned)((chunk * 128 + rr) * 2 + k);
            const int li = base[mye] + myrank; list[(size_t)mye * T + li] = slot; wslot[slot] = k ? w1s[rr] : w0s[rr]; posloc[slot] = ((unsigned)mye << 20) | (unsigned)li; }
        __syncthreads();
    }
}

DI MoeTab moe_tables(Frame& F, int layer) {
    LAS int* tb = (LAS int*)(F.lds + LDS_MISC); LAS int* cn = tb + 64; LAS int* nt = cn + 64;
    const unsigned* cnt = (const unsigned*)(F.ws + WS_CTL) + CW_CNT + layer * 32 * 64;
    if (F.tid < 32) cn[F.tid] = (int)__hip_atomic_load(cnt + 64 * F.tid, __ATOMIC_RELAXED, __HIP_MEMORY_SCOPE_AGENT);
    __syncthreads();
    if (F.tid == 0) { int acc = 0; for (int e = 0; e < 32; ++e) { tb[e] = acc; acc += (cn[e] + 255) >> 8; } tb[32] = acc; nt[0] = acc; }
    __syncthreads();
    MoeTab t; t.tbase = tb; t.cnt = cn; t.ntiles = nt[0]; return t;
}

template <bool FINAL_F32>
DI void ln2_phase(Frame& F, int layer, const MoeTab& tab, bf16_t* dst16, float* dst32, unsigned char* dst8) {
    const bf16_t* x1 = (const bf16_t*)(F.ws + WS_XB); const bf16_t* Y = (const bf16_t*)(F.ws + WS_Y);
    const float* wslot = (const float*)(F.ws + WS_WSLOT); const unsigned* posloc = (const unsigned*)(F.ws + WS_POSLOC);
    const float* gam = F.in[layer ? 39 : 20]; const float* bet = F.in[layer ? 40 : 21];
    const int lane = F.lane; const int gw = F.vcu * NWAVES + F.wave, NGW = F.G * NWAVES;
    f32x4 gv[4], bv[4];
#pragma unroll
    for (int j = 0; j < 4; ++j) { gv[j] = ((const f32x4*)gam)[lane + 64 * j]; bv[j] = ((const f32x4*)bet)[lane + 64 * j]; }
#pragma unroll 2
    for (int row = gw; row < T; row += NGW) {
        const unsigned pl0 = posloc[2 * row], pl1 = posloc[2 * row + 1]; const float w0 = wslot[2 * row], w1 = wslot[2 * row + 1];
        const size_t h0 = (size_t)tab.tbase[pl0 >> 20] * 256 + (pl0 & 0xfffffu), h1 = (size_t)tab.tbase[pl1 >> 20] * 256 + (pl1 & 0xfffffu);
        const u32x2* xr = (const u32x2*)(x1 + (size_t)row * D) + lane;
        const u32x2* y0 = (const u32x2*)(Y + h0 * D) + lane; const u32x2* y1 = (const u32x2*)(Y + h1 * D) + lane;
        f32x4 v[4]; float s = 0.f;
#pragma unroll
        for (int j = 0; j < 4; ++j) { const u32x2 a = y0[64 * j], c = y1[64 * j], q = xr[64 * j];
            v[j].x = bflo(q.x) * DN_ALPHA + (w0 * bflo(a.x) + w1 * bflo(c.x)); v[j].y = bfhi(q.x) * DN_ALPHA + (w0 * bfhi(a.x) + w1 * bfhi(c.x));
            v[j].z = bflo(q.y) * DN_ALPHA + (w0 * bflo(a.y) + w1 * bflo(c.y)); v[j].w = bfhi(q.y) * DN_ALPHA + (w0 * bfhi(a.y) + w1 * bfhi(c.y));
            s += (v[j].x + v[j].y) + (v[j].z + v[j].w); }
        const float mean = wave_sum(s) * (1.f / D); float s2 = 0.f;
#pragma unroll
        for (int j = 0; j < 4; ++j) { v[j] = v[j] - mean; s2 += (v[j].x * v[j].x + v[j].y * v[j].y) + (v[j].z * v[j].z + v[j].w * v[j].w); }
        const float rstd = 1.f / sqrtf(wave_sum(s2) * (1.f / D) + LN_EPS);
#pragma unroll
        for (int j = 0; j < 4; ++j) { v[j] = v[j] * rstd * gv[j] + bv[j];
            if (FINAL_F32) ((f32x4*)(dst32 + (size_t)row * D))[lane + 64 * j] = v[j];
            else { ((u32x2*)(dst16 + (size_t)row * D))[lane + 64 * j] = (u32x2){pk2(v[j].x, v[j].y), pk2(v[j].z, v[j].w)};
                int w8 = 0; w8 = __builtin_amdgcn_cvt_pk_fp8_f32(v[j].x, v[j].y, w8, false); w8 = __builtin_amdgcn_cvt_pk_fp8_f32(v[j].z, v[j].w, w8, true); ((unsigned*)(dst8 + (size_t)row * D))[lane + 64 * j] = (unsigned)w8; } }
    }
}

constexpr float QSCALE = 0.125f * 1.4426950408889634f;
struct GemmL1In {
    static constexpr bool AUNI = true;
    static constexpr bool FP8 = true;
    static constexpr bool PERM = false;
    const char* A; int K; unsigned lda2, ldb2; const char* Bt; pg8::TileOrder ord;
    bf16_t* Q; unsigned char* KV; float* gates; const float* cosT; const float* sinT;
    DI bool next(int i, GU& u) const { return ord.next(i, u); }
    DI unsigned a_row_off(const GU& u, int r) const { return (unsigned)(u.pm * 256 + r) * lda2; }
    DI size_t a_base(const GU& u) const { return (size_t)(u.pm * 256) * lda2; }
    DI const char* b_tile(const GU& u) const { return Bt + (size_t)u.pn * 256 * ldb2; }
    DI void epi(const f32x4 (&acc)[2][2][4][2], const GU& u, int wr, int wc, int fr, int fq) const {
        const int pn = u.pn;
#pragma unroll
        for (int ai = 0; ai < 2; ++ai)
#pragma unroll
            for (int m = 0; m < 4; ++m) {
                const int row = u.pm * 256 + ai * 128 + wr * 64 + m * 16 + fr; const int pos = row & (SEQ - 1), b = row >> 13;
                if (pn == 10) {
                    if (wc < 2) {
#pragma unroll
                        for (int n = 0; n < 2; ++n) { if (n == 1 && wc == 1) continue; const f32x4 v = acc[ai][0][m][n] * 0.03125f;
                            f32x4 o; o.x = sigmoidf_(v.x); o.y = sigmoidf_(v.y); o.z = sigmoidf_(v.z); o.w = sigmoidf_(v.w);
                            *(f32x4*)(gates + (size_t)row * 48 + 32 * wc + 16 * n + 4 * fq) = o; }
                    }
                } else if (pn < 5 || pn == 6 || pn == 8) {
                    const int a = wc & 1, i0 = 16 * a + 4 * fq;
                    const f32x4 c4 = *(const f32x4*)(cosT + pos * 32 + i0), s4 = *(const f32x4*)(sinT + pos * 32 + i0);
#pragma unroll
                    for (int bj = 0; bj < 2; ++bj) { const f32x4 x1 = acc[ai][bj][m][0] * 0.03125f, x2 = acc[ai][bj][m][1] * 0.03125f;
                        f32x4 o1 = x1 * c4 - x2 * s4, o2 = x2 * c4 + x1 * s4;
                        const int hl = bj * 2 + (wc >> 1); bf16_t* dst;
                        if (pn < 4) { o1 = o1 * QSCALE; o2 = o2 * QSCALE; dst = Q + ((size_t)row * 16 + pn * 4 + hl) * 64; }
                        else dst = (bf16_t*)(KV + (size_t)(pn - 4) * KV_STRIDE) + ((size_t)(b * 4 + hl) * SEQ + pos) * 64;
                        *(u32x2*)(dst + i0) = (u32x2){cvt_pk_bf16(o1.x, o1.y), cvt_pk_bf16(o1.z, o1.w)};
                        *(u32x2*)(dst + 32 + i0) = (u32x2){cvt_pk_bf16(o2.x, o2.y), cvt_pk_bf16(o2.z, o2.w)}; }
                } else {
#pragma unroll
                    for (int bj = 0; bj < 2; ++bj) { const int gg = bj * 2 + (wc >> 1);
                        bf16_t* dst = (bf16_t*)(KV + (size_t)(pn - 4) * KV_STRIDE) + ((size_t)(b * 4 + gg) * SEQ + pos) * 64 + 32 * (wc & 1) + 4 * fq;
#pragma unroll
                        for (int n = 0; n < 2; ++n) { const f32x4 v = acc[ai][bj][m][n] * 0.03125f; *(u32x2*)(dst + 16 * n) = (u32x2){cvt_pk_bf16(v.x, v.y), cvt_pk_bf16(v.z, v.w)}; } }
                }
            }
    }
};
struct GemmCmp1 {
    static constexpr bool AUNI = true;
    static constexpr bool FP8 = false;
    static constexpr bool PERM = true;
    const char* A; int K; unsigned lda2, ldb2; const char* Bt; int G, c;
    const float* cbias; bf16_t* Hd;
    DI bool next(int i, GU& u) const { const int L = i * G + c; if (L >= 64) return false; u.e = L >> 5; u.pm = L & 31; u.pn = 0; return true; }
    DI unsigned a_row_off(const GU& u, int r) const { return (unsigned)u.e * (unsigned)KV_STRIDE + (unsigned)(u.pm * 256 + r) * lda2; }
    DI size_t a_base(const GU& u) const { return (size_t)u.e * KV_STRIDE + (size_t)(u.pm * 256) * lda2; }
    DI const char* b_tile(const GU& u) const { return Bt + (size_t)u.e * 256 * ldb2; }
    DI void epi(const f32x4 (&acc)[2][2][4][2], const GU& u, int wr, int wc, int fr, int fq) const {
        const int row0 = u.pm * 256 + wr * 64 + fr, col0 = wc * 32 + 8 * fq;
        f32x4 bv[2][2];
#pragma unroll
        for (int bj = 0; bj < 2; ++bj)
#pragma unroll
            for (int n = 0; n < 2; ++n) bv[bj][n] = *(const f32x4*)(cbias + u.e * 256 + col0 + bj * 128 + 4 * n);
#pragma unroll
        for (int ai = 0; ai < 2; ++ai)
#pragma unroll
            for (int m = 0; m < 4; ++m) { bf16_t* rowp = Hd + ((size_t)u.e * 8192 + row0 + ai * 128 + m * 16) * 256 + col0;
#pragma unroll
                for (int bj = 0; bj < 2; ++bj) { const f32x4 v0 = acc[ai][bj][m][0] + bv[bj][0], v1 = acc[ai][bj][m][1] + bv[bj][1];
                    u32x4 w; w.x = cvt_pk_bf16(gelu_tanh(v0[0]), gelu_tanh(v0[1])); w.y = cvt_pk_bf16(gelu_tanh(v0[2]), gelu_tanh(v0[3]));
                    w.z = cvt_pk_bf16(gelu_tanh(v1[0]), gelu_tanh(v1[1])); w.w = cvt_pk_bf16(gelu_tanh(v1[2]), gelu_tanh(v1[3]));
                    *(u32x4*)(rowp + bj * 128) = w; } }
    }
};
struct GemmCmp2 {
    static constexpr bool AUNI = true;
    static constexpr bool FP8 = false;
    static constexpr bool PERM = true;
    const char* A; int K; unsigned lda2, ldb2; const char* Bt; int G, c;
    bf16_t* O;
    DI bool next(int i, GU& u) const { const int L = i * G + c; if (L >= 64) return false; u.e = L >> 5; u.pm = L & 31; u.pn = 0; return true; }
    DI unsigned a_row_off(const GU& u, int r) const { return (unsigned)(u.e * 8192 + u.pm * 256 + r) * lda2; }
    DI size_t a_base(const GU& u) const { return (size_t)(u.e * 8192 + u.pm * 256) * lda2; }
    DI const char* b_tile(const GU& u) const { return Bt + (size_t)u.e * 256 * ldb2; }
    DI void epi(const f32x4 (&acc)[2][2][4][2], const GU& u, int wr, int wc, int fr, int fq) const {
        if (wc >= 2) return;
        const int row0 = u.pm * 256 + wr * 64 + fr, col0 = wc * 32 + 8 * fq;
#pragma unroll
        for (int ai = 0; ai < 2; ++ai)
#pragma unroll
            for (int m = 0; m < 4; ++m) { bf16_t* rowp = O + ((size_t)u.e * 8192 + row0 + ai * 128 + m * 16) * 64 + col0;
                const f32x4 v0 = acc[ai][0][m][0], v1 = acc[ai][0][m][1];
                u32x4 w; w.x = cvt_pk_bf16(v0[0], v0[1]); w.y = cvt_pk_bf16(v0[2], v0[3]); w.z = cvt_pk_bf16(v1[0], v1[1]); w.w = cvt_pk_bf16(v1[2], v1[3]);
                *(u32x4*)rowp = w; }
    }
};

constexpr int AL_KB = 0, AL_VB = 16384, AL_FAC = 40960, AL_SELM = 41984, AL_IMPS = 43008, IMP_STRIDE = 129, AL_IMPC = AL_IMPS + 64 * IMP_STRIDE * 4, AL_OT = AL_IMPS  , OT_STRIDE = 68;
static_assert(AL_OT + 8 * 32 * OT_STRIDE * 4 <= LDS_RING, "attention LDS map");
typedef short v4i16_t __attribute__((ext_vector_type(4)));
typedef __bf16 bf16x2_t __attribute__((ext_vector_type(2)));
DI unsigned cvtpk_s(float lo, float hi) { f32x2 v = {lo, hi}; bf16x2_t b = __builtin_convertvector(v, bf16x2_t); return __builtin_bit_cast(unsigned, b); }
DI int crow(int r, int hi) { return (r & 3) + 8 * (r >> 2) + 4 * hi; }
#define NEGINF (-__builtin_inff())

struct AttnW {
    int tid, lane, wave, r32, hh;
    LAS unsigned char* lds; LAS float* fac; LAS float* ot;
};
DI void at_load(const bf16_t* slab, int tile, int tid, u32x4& r) { r = *(const u32x4*)(slab + (size_t)tile * 4096 + tid * 8); }
DI void at_store_k(LAS unsigned char* kb, int tid, const u32x4& r) { const int key = tid >> 3, ch = tid & 7; *(LAS u32x4*)(kb + key * 128 + ((ch ^ ((key >> 1) & 7)) << 4)) = r; }
DI void at_store_v(LAS unsigned char* vb, int tid, const u32x4& r) { *(LAS u32x4*)(vb + tid * 16) = r; }
DI void at_qk(const LAS unsigned char* kb, const bf16x8 (&qf)[4], float cinit, int r32, int hh, f32x16& p0, f32x16& p1) {
#pragma unroll
    for (int i = 0; i < 16; ++i) { p0[i] = cinit; p1[i] = cinit; }
    const int sw = (r32 >> 1) & 7;
#pragma unroll
    for (int d0 = 0; d0 < 4; ++d0) {
        const bf16x8 a0 = *(const LAS bf16x8*)(kb + r32 * 128 + (((2 * d0 + hh) ^ sw) << 4));
        const bf16x8 a1 = *(const LAS bf16x8*)(kb + (32 + r32) * 128 + (((2 * d0 + hh) ^ sw) << 4));
        p0 = __builtin_amdgcn_mfma_f32_32x32x16_bf16(a0, qf[d0], p0, 0, 0, 0);
        p1 = __builtin_amdgcn_mfma_f32_32x32x16_bf16(a1, qf[d0], p1, 0, 0, 0);
    }
}
DI void at_pack(const f32x16& p0, const f32x16& p1, u32x4 (&pw)[4]) {
#pragma unroll
    for (int s = 0; s < 2; ++s) {
        pw[s] = (u32x4){cvtpk_s(p0[8 * s], p0[8 * s + 1]), cvtpk_s(p0[8 * s + 2], p0[8 * s + 3]), cvtpk_s(p0[8 * s + 4], p0[8 * s + 5]), cvtpk_s(p0[8 * s + 6], p0[8 * s + 7])};
        pw[2 + s] = (u32x4){cvtpk_s(p1[8 * s], p1[8 * s + 1]), cvtpk_s(p1[8 * s + 2], p1[8 * s + 3]), cvtpk_s(p1[8 * s + 4], p1[8 * s + 5]), cvtpk_s(p1[8 * s + 6], p1[8 * s + 7])};
    }
}
DI void at_pv(const LAS unsigned char* vb, const u32x4 (&pw)[4], f32x16 (&o)[2], int lane) {
    const int hh = lane >> 5;
    const LAS unsigned char* vp = vb + (4 * hh + ((lane & 15) >> 2)) * 128 + (16 * ((lane >> 4) & 1) + 4 * (lane & 3)) * 2;
#pragma unroll
    for (int s = 0; s < 4; ++s)
#pragma unroll
        for (int d0 = 0; d0 < 2; ++d0) {
            const s16x4 lo = __builtin_bit_cast(s16x4, __builtin_amdgcn_ds_read_tr16_b64_v4i16((LAS v4i16_t*)(vp + s * 2048 + d0 * 64)));
            const s16x4 hi = __builtin_bit_cast(s16x4, __builtin_amdgcn_ds_read_tr16_b64_v4i16((LAS v4i16_t*)(vp + s * 2048 + d0 * 64 + 1024)));
            const bf16x8 vf = (bf16x8){lo[0], lo[1], lo[2], lo[3], hi[0], hi[1], hi[2], hi[3]};
            o[d0] = __builtin_amdgcn_mfma_f32_32x32x16_bf16(__builtin_bit_cast(bf16x8, pw[s]), vf, o[d0], 0, 0, 0);
        }
}
DI float at_rowmax(const f32x16& p0, const f32x16& p1) {
    float a = fmaxf(fmaxf(p0[0], p1[0]), p0[1]), c = fmaxf(fmaxf(p1[1], p0[2]), p1[2]);
#pragma unroll
    for (int r = 3; r < 15; r += 2) { a = fmaxf(fmaxf(a, p0[r]), p1[r]); c = fmaxf(fmaxf(c, p0[r + 1]), p1[r + 1]); }
    a = fmaxf(fmaxf(a, p0[15]), p1[15]); a = fmaxf(a, c);
    const f32x2 s = lds_swap(a); return fmaxf(s[0], s[1]);
}
DI void at_scale_rows(f32x16 (&o)[2], float f, const AttnW& W) {
    if (W.hh == 0) W.fac[W.r32] = f;
#pragma unroll
    for (int g4 = 0; g4 < 4; ++g4) { const f32x4 fv = *(const LAS f32x4*)(W.fac + 8 * g4 + 4 * W.hh);
#pragma unroll
        for (int j = 0; j < 4; ++j) { o[0][4 * g4 + j] *= fv[j]; o[1][4 * g4 + j] *= fv[j]; } }
}
template <bool FIRST> DI void at_axpy_rows(const f32x16 (&o)[2], float f, const AttnW& W) {
    if (W.hh == 0) W.fac[W.r32] = f;
#pragma unroll
    for (int g4 = 0; g4 < 4; ++g4) { const f32x4 fv = *(const LAS f32x4*)(W.fac + 8 * g4 + 4 * W.hh);
#pragma unroll
        for (int j = 0; j < 4; ++j) { LAS float* d = W.ot + (8 * g4 + 4 * W.hh + j) * OT_STRIDE + W.r32;
            if (FIRST) { d[0] = fv[j] * o[0][4 * g4 + j]; d[32] = fv[j] * o[1][4 * g4 + j]; }
            else { d[0] += fv[j] * o[0][4 * g4 + j]; d[32] += fv[j] * o[1][4 * g4 + j]; } } }
}
template <bool GT> DI void at_mask(f32x16& p0, f32x16& p1, int lim, int hh) {
#pragma unroll
    for (int r = 0; r < 16; ++r) { const int kv = crow(r, hh);
        if (GT) { if (kv > lim) p0[r] = NEGINF; if (kv + 32 > lim) p1[r] = NEGINF; }
        else { if (kv <= lim) p0[r] = NEGINF; if (kv + 32 <= lim) p1[r] = NEGINF; } }
}
constexpr float AT_THR = 8.0f;
struct Flash { float mu, l; bool started; f32x16 o[2]; };
DI void flash_init(Flash& s) { s.mu = 0.f; s.l = 0.f; s.started = false;
#pragma unroll
    for (int i = 0; i < 16; ++i) { s.o[0][i] = 0.f; s.o[1][i] = 0.f; } }
template <bool WITH_O> DI void flash_update(Flash& s, f32x16& p0, f32x16& p1, const AttnW& W) {
    const float mx = at_rowmax(p0, p1);
    const bool fin = mx > NEGINF;
    const bool need = s.started ? (mx > AT_THR) : (fin && fabsf(mx) > AT_THR);
    if (__any(need)) {
        const float delta = need ? mx : 0.f;
        const float f = s.started ? __builtin_amdgcn_exp2f(-delta) : 1.0f;
        s.mu += delta; s.l *= f;
        if (WITH_O) at_scale_rows(s.o, f, W);
#pragma unroll
        for (int r = 0; r < 16; ++r) { p0[r] -= delta; p1[r] -= delta; }
    }
    s.started = s.started || fin;
    float sum0 = 0.f, sum1 = 0.f;
#pragma unroll
    for (int r = 0; r < 16; ++r) { p0[r] = __builtin_amdgcn_exp2f(p0[r]); p1[r] = __builtin_amdgcn_exp2f(p1[r]); sum0 += p0[r]; sum1 += p1[r]; }
    s.l += sum0 + sum1;
}

template <int VAR>
DI void attn_unit(Frame& F, int bg, int qblk, int& it, bf16_t* Ob, u32x4& kr, const bf16_t* next_kcmp) {
    AttnW W; W.tid = F.tid; W.lane = F.lane; W.wave = F.wave; W.r32 = F.lane & 31; W.hh = F.lane >> 5; W.lds = F.lds; W.fac = (LAS float*)(F.lds + AL_FAC) + F.wave * 32; W.ot = (LAS float*)(F.lds + AL_OT) + F.wave * 32 * OT_STRIDE;
    const int tid = W.tid, lane = W.lane, wave = W.wave, r32 = W.r32, hh = W.hh;
    const int b = bg >> 2, g = bg & 3;
    unsigned char* ws = F.ws;
    bf16_t* Qb = (bf16_t*)(ws + WS_Q);
    const float* gates = (const float*)(ws + WS_GATES);
    const bf16_t* kcmp = (const bf16_t*)(ws + WS_CMPO) + (size_t)bg * 512 * 64; const bf16_t* vcmp = kcmp + (size_t)8192 * 64;
    const bf16_t* ksl = (const bf16_t*)(ws + WS_KV + 2 * KV_STRIDE) + (size_t)bg * SEQ * 64; const bf16_t* vsl = (const bf16_t*)(ws + WS_KV + 3 * KV_STRIDE) + (size_t)bg * SEQ * 64;
    const bf16_t* kwl = (const bf16_t*)(ws + WS_KV + 4 * KV_STRIDE) + (size_t)bg * SEQ * 64; const bf16_t* vwl = (const bf16_t*)(ws + WS_KV + 5 * KV_STRIDE) + (size_t)bg * SEQ * 64;
    LAS unsigned char* KB = F.lds + AL_KB; LAS unsigned char* VB = F.lds + AL_VB;
    LAS unsigned* selm = (LAS unsigned*)(F.lds + AL_SELM); LAS float* impS = (LAS float*)(F.lds + AL_IMPS); LAS float* impC = (LAS float*)(F.lds + AL_IMPC);
    const int tl = wave * 8 + (r32 >> 2), hd = r32 & 3, t = qblk * 64 + tl;
    const size_t qrow = ((size_t)(b * SEQ + t) * 16 + g * 4 + hd) * 64;
    bf16x8 qf[4];
#pragma unroll
    for (int d0 = 0; d0 < 4; ++d0) qf[d0] = *(const bf16x8*)(Qb + qrow + d0 * 16 + hh * 8);
    const float* gp = gates + (size_t)(b * SEQ + t) * 48 + (g * 4 + hd) * 3;
    const bool need_topk = (qblk >= 16) && !(VAR & 128);
    f32x16 p0, p1; u32x4 vr, pw[4];
    const bool rotB = wave >= 4;
    int vs = 0;
#define V_NEXT() do { vs = (vs == 2) ? 0 : vs + 1; } while (0)

    const int nct = (4 * qblk + 2) / 64 + 1;
    const int cmax = (t - 31) >> 4;
    Flash fc; flash_init(fc);
    const int cfull = 4 * qblk - 2;
    for (int ti = 0; ti < nct; ++ti, ++it) {
        LAS unsigned char* kb = KB + (it & 1) * 8192;
        at_store_k(kb, tid, kr); if (!(VAR & 2)) __syncthreads();
        if (ti + 1 < nct) at_load(kcmp, ti + 1, tid, kr); else { at_load(kcmp, 0, tid, kr); at_load(vcmp, 0, tid, vr); }
        at_qk(kb, qf, -fc.mu, r32, hh, p0, p1);
        if (64 * ti + 63 > cfull) at_mask<true>(p0, p1, cmax - 64 * ti, hh);
        flash_update<false>(fc, p0, p1, W);
    }
    { const f32x2 ls = lds_swap(fc.l); fc.l = ls[0] + ls[1]; }
    const float inv_lc = 1.0f / fmaxf(fc.l, 1e-30f);
    if (need_topk) { for (int i = tid; i < 64 * IMP_STRIDE; i += NTHR) { impS[i] = 0.f; impC[i] = 0.f; } }
    for (int ti = 0; ti < nct; ++ti, ++it) {
        LAS unsigned char* kb = KB + (it & 1) * 8192; LAS unsigned char* vb = VB + vs * 8192; V_NEXT();
        at_store_k(kb, tid, kr); at_store_v(vb, tid, vr); if (!(VAR & 2)) __syncthreads();
        if (ti + 1 < nct) { at_load(kcmp, ti + 1, tid, kr); at_load(vcmp, ti + 1, tid, vr); } else { at_load(ksl, 0, tid, kr); at_load(vsl, 0, tid, vr); }
        at_qk(kb, qf, -fc.mu, r32, hh, p0, p1);
        if (64 * ti + 63 > cfull) at_mask<true>(p0, p1, cmax - 64 * ti, hh);
#pragma unroll
        for (int r = 0; r < 16; ++r) { p0[r] = __builtin_amdgcn_exp2f(p0[r]); p1[r] = __builtin_amdgcn_exp2f(p1[r]); }
        at_pack(p0, p1, pw);
        at_pv(vb, pw, fc.o, lane);
        if (need_topk) {
#pragma unroll
            for (int half = 0; half < 2; ++half)
#pragma unroll
                for (int g4 = 0; g4 < 4; ++g4) {
                    const f32x16& p = half ? p1 : p0;
                    float s4 = ((p[4 * g4] + p[4 * g4 + 1]) + (p[4 * g4 + 2] + p[4 * g4 + 3])) * inv_lc, c3 = p[4 * g4 + 3] * inv_lc;
                    s4 += quad_xor<0xB1>(s4); c3 += quad_xor<0xB1>(c3); s4 += quad_xor<0x4E>(s4); c3 += quad_xor<0x4E>(c3);
                    const int j = 16 * ti + 8 * half + 2 * g4 + hh;
                    if (hd == 0) { impS[tl * IMP_STRIDE + j] = s4; impC[tl * IMP_STRIDE + j] = c3; }
                }
        }
    }
    __syncthreads();
    if (need_topk) {
        #pragma unroll 1
        for (int rnd = 0; rnd < 2; ++rnd) {
        unsigned k0[4], k1[4], prefix[4];
#pragma unroll
        for (int tt = 0; tt < 4; ++tt) {
            const int tk = wave * 8 + rnd * 4 + tt; const LAS float* S = impS + tk * IMP_STRIDE; const LAS float* C = impC + tk * IMP_STRIDE;
            const int j0 = lane, j1 = 64 + lane;
            const float v0 = S[j0] + (j0 > 0 ? C[j0 - 1] : 0.f), v1 = S[j1] + C[j1 - 1];
            const bool c0 = (j0 >= 1) && (j0 <= qblk - 2), c1 = (j1 <= qblk - 2);
            k0[tt] = c0 ? ((__float_as_uint(v0) + 0x100u) & 0xffffff00u) : 0u; k1[tt] = c1 ? ((__float_as_uint(v1) + 0x100u) & 0xffffff00u) : 0u; prefix[tt] = 0u;
        }
#pragma unroll 1
        for (int bit = 30; bit >= 8; --bit) {
            unsigned long long bl0[4], bl1[4];
#pragma unroll
            for (int tt = 0; tt < 4; ++tt) { const unsigned trial = prefix[tt] | (1u << bit); bl0[tt] = __ballot(k0[tt] >= trial); bl1[tt] = __ballot(k1[tt] >= trial); }
#pragma unroll
            for (int tt = 0; tt < 4; ++tt) { asm volatile("" : "+s"(bl0[tt]), "+s"(bl1[tt])); }
#pragma unroll
            for (int tt = 0; tt < 4; ++tt) { const int cnt = __popcll(bl0[tt]) + __popcll(bl1[tt]); prefix[tt] = cnt >= 13 ? (prefix[tt] | (1u << bit)) : prefix[tt]; }
        }
#pragma unroll
        for (int tt = 0; tt < 4; ++tt) {
            const int tk = wave * 8 + rnd * 4 + tt; const int j0 = lane, j1 = 64 + lane; const unsigned pf = prefix[tt];
            const int G = __popcll(__ballot(k0[tt] > pf)) + __popcll(__ballot(k1[tt] > pf)); const int need = 13 - G;
            const unsigned long long e0 = __ballot(k0[tt] == pf), e1 = __ballot(k1[tt] == pf);
            const unsigned long long lt = (1ull << lane) - 1ull;
            const int rk0 = __popcll(e0 & lt), rk1 = __popcll(e0) + __popcll(e1 & lt);
            const bool s0 = (k0[tt] > pf) || (k0[tt] == pf && rk0 < need) || j0 == 0 || j0 == qblk || j0 == qblk - 1;
            const bool s1 = (k1[tt] > pf) || (k1[tt] == pf && rk1 < need) || j1 == qblk || j1 == qblk - 1;
            const unsigned long long m0 = __ballot(s0), m1 = __ballot(s1);
            if (lane == 0) { selm[tk * 4 + 0] = (unsigned)m0; selm[tk * 4 + 1] = (unsigned)(m0 >> 32); selm[tk * 4 + 2] = (unsigned)m1; selm[tk * 4 + 3] = (unsigned)(m1 >> 32); }
        }
        }
    } else {
        if (tid < 256) selm[tid] = 0xffffffffu;
    }
    __syncthreads();
    at_axpy_rows<true>(fc.o, gp[0] * inv_lc, W);

    {
        Flash fs; flash_init(fs);
        const int tbw = qblk >= 8 ? qblk - 8 : 0;
        const LAS unsigned char* vprev = VB; bool first = true;
#define SEL_HEAD() \
            LAS unsigned char* kb = KB + (it & 1) * 8192; LAS unsigned char* vb = VB + vs * 8192; V_NEXT(); \
            at_store_k(kb, tid, kr); at_store_v(vb, tid, vr); if (!(VAR & 2)) __syncthreads(); \
            if (ti < qblk) { if (!(VAR & 1)) { at_load(ksl, ti + 1, tid, kr); at_load(vsl, ti + 1, tid, vr); } } else { at_load(kwl, tbw, tid, kr); at_load(vwl, tbw, tid, vr); } \
            const unsigned wsel = selm[tl * 4 + (ti >> 5)]; \
            const bool selb = ((wsel >> (ti & 31)) & 1u) != 0u;
        if (!rotB) {
            for (int ti = (VAR & 32) ? qblk : 0; ti <= qblk; ++ti, ++it) {
                SEL_HEAD()
                at_qk(kb, qf, selb ? -fs.mu : NEGINF, r32, hh, p0, p1);
                if (ti == qblk) at_mask<true>(p0, p1, tl, hh);
                flash_update<true>(fs, p0, p1, W); at_pack(p0, p1, pw);
                at_pv(vb, pw, fs.o, lane);
            }
        } else {
            for (int ti = (VAR & 32) ? qblk : 0; ti <= qblk; ++ti, ++it) {
                SEL_HEAD()
                if (!first) at_pv(vprev, pw, fs.o, lane);
                at_qk(kb, qf, selb ? -fs.mu : NEGINF, r32, hh, p0, p1);
                if (ti == qblk) at_mask<true>(p0, p1, tl, hh);
                flash_update<true>(fs, p0, p1, W); at_pack(p0, p1, pw);
                vprev = vb; first = false;
            }
            at_pv(vprev, pw, fs.o, lane);
        }
#undef SEL_HEAD
        const f32x2 ls = lds_swap(fs.l); const float l = ls[0] + ls[1];
        at_axpy_rows<false>(fs.o, gp[1] / fmaxf(l, 1e-30f), W);
    }
    {
        Flash fw; flash_init(fw);
        const int tb = qblk >= 8 ? qblk - 8 : 0;
        const LAS unsigned char* vprev = VB; bool first = true;
#define WIN_HEAD() \
            LAS unsigned char* kb = KB + (it & 1) * 8192; LAS unsigned char* vb = VB + vs * 8192; V_NEXT(); \
            at_store_k(kb, tid, kr); at_store_v(vb, tid, vr); if (!(VAR & 2)) __syncthreads(); \
            if (ti < qblk) { if (!(VAR & 1)) { at_load(kwl, ti + 1, tid, kr); at_load(vwl, ti + 1, tid, vr); } } else if (next_kcmp) at_load(next_kcmp, 0, tid, kr);
        if (!rotB) {
            for (int ti = (VAR & 64) ? qblk : tb; ti <= qblk; ++ti, ++it) {
                WIN_HEAD()
                at_qk(kb, qf, -fw.mu, r32, hh, p0, p1);
                if (ti == qblk - 8) at_mask<false>(p0, p1, tl, hh);
                if (ti == qblk) at_mask<true>(p0, p1, tl, hh);
                flash_update<true>(fw, p0, p1, W); at_pack(p0, p1, pw);
                at_pv(vb, pw, fw.o, lane);
            }
        } else {
            for (int ti = (VAR & 64) ? qblk : tb; ti <= qblk; ++ti, ++it) {
                WIN_HEAD()
                if (!first) at_pv(vprev, pw, fw.o, lane);
                at_qk(kb, qf, -fw.mu, r32, hh, p0, p1);
                if (ti == qblk - 8) at_mask<false>(p0, p1, tl, hh);
                if (ti == qblk) at_mask<true>(p0, p1, tl, hh);
                flash_update<true>(fw, p0, p1, W); at_pack(p0, p1, pw);
                vprev = vb; first = false;
            }
            at_pv(vprev, pw, fw.o, lane);
        }
#undef WIN_HEAD
        const f32x2 ls = lds_swap(fw.l); const float l = ls[0] + ls[1];
        at_axpy_rows<false>(fw.o, gp[2] / fmaxf(l, 1e-30f), W);
    }
#undef V_NEXT
    { const int q = lane >> 1, hf = lane & 1; const LAS float* src = W.ot + q * OT_STRIDE + hf * 32; const int tq = qblk * 64 + wave * 8 + (q >> 2);
      unsigned char* dst = (unsigned char*)Ob + ((size_t)(b * SEQ + tq) * 16 + g * 4 + (q & 3)) * 64 + hf * 32;
#pragma unroll
      for (int c = 0; c < 2; ++c) { unsigned w[4];
#pragma unroll
          for (int e = 0; e < 4; ++e) { const f32x4 a = *(const LAS f32x4*)(src + 16 * c + 4 * e); int x = 0; x = __builtin_amdgcn_cvt_pk_fp8_f32(a.x, a.y, x, false); x = __builtin_amdgcn_cvt_pk_fp8_f32(a.z, a.w, x, true); w[e] = (unsigned)x; }
          *(u32x4*)(dst + 16 * c) = (u32x4){w[0], w[1], w[2], w[3]}; } }
    __syncthreads();
}
template <int VAR>
DI void attn_phase(Frame& F, bf16_t* Ob) {
    int it = 0;
    const bf16_t* kcmp_all = (const bf16_t*)(F.ws + WS_CMPO);
    const bool bal = (F.G == 256);
    const int bg0 = F.vcu >> 4, sft = F.vcu & 15;
    const int nun = bal ? 8 : (2048 - F.vcu + F.G - 1) / F.G;
    auto unit_of = [&](int i, int& bg, int& qblk) {
        if (bal) { const int base = (i >> 1) * 32; bg = bg0; qblk = 127 - ((i & 1) ? base + 31 - sft : base + sft); }
        else { const int u = F.vcu + i * F.G; bg = u >> 7; qblk = 127 - (u & 127); } };
    u32x4 kr;
    if (nun > 0) { int bg, qb; unit_of(0, bg, qb); at_load(kcmp_all + (size_t)bg * 512 * 64, 0, F.tid, kr); }
#pragma unroll 1
    for (int i = 0; i < nun; ++i) {
        int bg, qb, nbg = 0, nqb = 0; unit_of(i, bg, qb);
        const bf16_t* nk = nullptr; if (i + 1 < nun) { unit_of(i + 1, nbg, nqb); nk = kcmp_all + (size_t)nbg * 512 * 64; }
        attn_unit<VAR>(F, bg, qb, it, Ob, kr, nk);
    }
}

constexpr int NPHASE = 18;
__global__ void __launch_bounds__(NTHR, 2) fwd_kernel(Args args) {
    extern __shared__ __attribute__((aligned(16))) unsigned char lds_raw[];
    cg::grid_group grid = cg::this_grid();
    Frame F;
    F.lds = (LAS unsigned char*)lds_raw;
    F.tid = threadIdx.x; F.lane = F.tid & 63; F.wave = __builtin_amdgcn_readfirstlane(F.tid >> 6);
    F.G = gridDim.x; { const int bx = blockIdx.x; F.vcu = (F.G % 8 == 0) ? (bx % 8) * (F.G / 8) + bx / 8 : bx; }
    F.in = args.in; F.out = args.out; F.ws = args.ws;
    unsigned char* ws = args.ws;
    const int lo = args.ph_lo, hi = args.ph_hi;
    volatile LAS unsigned* bar_st = (volatile LAS unsigned*)(F.lds + LDS_BYTES - 64);
    if (F.tid < 16) bar_st[F.tid] = 0u;
    __syncthreads();
    XcdBarrier xbar; xbar.bar = (unsigned*)(ws + WS_CTL) + CW_BAR; xbar.x = 0; xbar.st = bar_st;
#ifndef PHMASK
#define PHMASK 0xFFFFFFFFu
#endif
#define IN(k) (((PHMASK >> (k)) & 1u) && lo <= (k) && (k) < hi)
#ifdef TPH_LO
    unsigned long long tp0 = __builtin_amdgcn_s_memrealtime(), tp1 = tp0;
#define STAMP(k) do { if ((k) == TPH_LO - 1) tp0 = __builtin_amdgcn_s_memrealtime(); if ((k) == TPH_HI) tp1 = __builtin_amdgcn_s_memrealtime(); } while (0)
#else
#define STAMP(k) do { } while (0)
#endif
#define SEAM(k) do { if (IN(k) && IN((k) + 1)) { if ((k) == 0) { grid.sync(); xbar = xcd_barrier_post((unsigned*)(ws + WS_CTL) + CW_BAR, bar_st); } else xcd_barrier(xbar); } STAMP(k); } while (0)

    if (IN(0)) { p0_prep(F); } SEAM(0);
    if (IN(1)) { GemmPlain g; g.A = (const char*)(ws + WS_XB); g.K = 1024; g.lda2 = 2048; g.ldb2 = 2048; g.Bt = (const char*)(ws + WS_W0IN); g.ord.init(T, L0N, F.G, (int)blockIdx.x);
        g.C = (bf16_t*)(ws + WS_Z); g.ldc = L0N; pg8::gemm_phase(F.lds, g); } SEAM(1);
#ifdef XSYNC_N
    for (int xs = 0; xs < XSYNC_N; ++xs) grid.sync();
#endif
#ifdef XGEMM_K
    { grid.sync(); const unsigned long long xt0 = __builtin_amdgcn_s_memrealtime();
      GemmPlain g; g.A = (const char*)(ws + WS_XB); g.K = XGEMM_K; g.lda2 = 2048; g.ldb2 = 2048; g.Bt = (const char*)(ws + WS_W0IN); g.ord.init(T, XGEMM_N, F.G, (int)blockIdx.x);
      g.C = (bf16_t*)F.out; g.ldc = XGEMM_N; pg8::gemm_phase(F.lds, g); grid.sync(); (void)xt0; }
#endif
    if (IN(2)) { for (int u = F.vcu; u < 512; u += F.G) lru_tile<false>(F, u >> 7, u & 127); } SEAM(2);
    if (IN(3)) { for (int u = F.vcu; u < 512; u += F.G) lru_tile<true>(F, u >> 7, u & 127); } SEAM(3);
    bf16_t* const OA = (bf16_t*)F.out; bf16_t* const OB = OA + (size_t)T * D;
    if (IN(4)) { GemmResid<true, false> g; g.A = (const char*)(ws + WS_XB); g.K = 1024; g.lda2 = 2048; g.ldb2 = 2048; g.Bt = (const char*)(ws + WS_W0OUT); g.ord.init(T, D, F.G, (int)blockIdx.x);
        g.res32 = F.in[0]; g.res16 = nullptr; g.out = OA; pg8::gemm_phase(F.lds, g); } SEAM(4);
#define MOE_LAYER(layer, pb, SRC, FIN, DST16) do { \
        if (IN(pb)) { ln_router_phase(F, layer, SRC); } SEAM(pb); \
        if (IN((pb) + 1)) { MoeTab tab = moe_tables(F, layer); \
            GemmMoeUp g; g.A = (const char*)(ws + WS_X8); g.K = 512; g.lda2 = 1024; g.ldb2 = 1024; g.Bt = (const char*)(ws + ((layer) ? WS_WGU1 : WS_WGU0)); g.G = F.G; g.c = (int)blockIdx.x; \
            g.tab = tab; g.list = (const unsigned*)(ws + WS_LIST); g.H = (bf16_t*)(ws + WS_H); pg8::gemm_phase(F.lds, g); } SEAM((pb) + 1); \
        if (IN((pb) + 2)) { MoeTab tab = moe_tables(F, layer); \
            GemmMoeDown g; g.A = (const char*)(ws + WS_H); g.K = 256; g.lda2 = 512; g.ldb2 = 512; g.Bt = (const char*)(ws + ((layer) ? WS_WD1 : WS_WD0)); g.G = F.G; g.c = (int)blockIdx.x; \
            g.tab = tab; g.Y = (bf16_t*)(ws + WS_Y); pg8::gemm_phase(F.lds, g); } SEAM((pb) + 2); \
        if (IN((pb) + 3)) { MoeTab tab = moe_tables(F, layer); ln2_phase<FIN>(F, layer, tab, DST16, F.out, (unsigned char*)OB); } } while (0)
    MOE_LAYER(0, 5, OA, false, OA); SEAM(8);
    if (IN(9)) { GemmL1In g; g.A = (const char*)OB; g.K = 512; g.lda2 = 1024; g.ldb2 = 1024; g.Bt = (const char*)(ws + WS_W1IN); g.ord.init(T, L1NP, F.G, (int)blockIdx.x);
        g.Q = (bf16_t*)(ws + WS_Q); g.KV = ws + WS_KV; g.gates = (float*)(ws + WS_GATES); g.cosT = (const float*)(ws + WS_COS); g.sinT = (const float*)(ws + WS_SIN); pg8::gemm_phase(F.lds, g); } SEAM(9);
    if (IN(10)) { GemmCmp1 g; g.A = (const char*)(ws + WS_KV); g.K = 2048; g.lda2 = 2048; g.ldb2 = 4096; g.Bt = (const char*)(ws + WS_WC1); g.G = F.G; g.c = (int)blockIdx.x;
        g.cbias = (const float*)(ws + WS_SMALL + SM_CBIAS); g.Hd = (bf16_t*)(ws + WS_CMPH); pg8::gemm_phase(F.lds, g); p0_moe1(F, F.G >= 128 ? 64 : 0); } SEAM(10);
    if (IN(11)) { GemmCmp2 g; g.A = (const char*)(ws + WS_CMPH); g.K = 256; g.lda2 = 512; g.ldb2 = 512; g.Bt = (const char*)(ws + WS_WC2); g.G = F.G; g.c = (int)blockIdx.x;
        g.O = (bf16_t*)(ws + WS_CMPO); pg8::gemm_phase(F.lds, g); } SEAM(11);
#ifdef XATT_VAR
    { xcd_barrier(xbar); attn_phase<XATT_VAR>(F, (bf16_t*)(ws + WS_XB)); xcd_barrier(xbar); }
#endif
    if (IN(12)) { attn_phase<0>(F, (bf16_t*)(ws + WS_XB)); } SEAM(12);
    if (IN(13)) { GemmResid<false, true> g; g.A = (const char*)(ws + WS_XB); g.K = 512; g.lda2 = 1024; g.ldb2 = 1024; g.Bt = (const char*)(ws + WS_W1OUT); g.ord.init(T, D, F.G, (int)blockIdx.x);
        g.res32 = nullptr; g.res16 = OA; g.out = OB; pg8::gemm_phase(F.lds, g); } SEAM(13);
    MOE_LAYER(1, 14, OB, true, nullptr);
#undef MOE_LAYER
#ifdef TPH_LO
    grid.sync(); STAMP(17);
    if (blockIdx.x == 0 && threadIdx.x == 0) { const unsigned long long span = (tp1 - tp0) * TPH_MUL, ts = __builtin_amdgcn_s_memrealtime(); while (__builtin_amdgcn_s_memrealtime() - ts < span) __builtin_amdgcn_s_sleep(32); }
#endif
#undef IN
#undef SEAM
}

extern "C" void kernel_launch(void* const* d_in, const int* in_sizes, int n_in, void* d_out, int out_size, void* d_ws, size_t ws_size, hipStream_t stream) {
    static int grid = 0;
    if (grid == 0) {
        if (n_in != 41 || out_size != T * D || ws_size < WS_END) { fprintf(stderr, "kernel_launch: unexpected problem (n_in %d out %d ws %zu, need %zu)\n", n_in, out_size, ws_size, (size_t)WS_END); grid = -1; return; }
        int dev = 0, cus = 0, per_cu = 0;
        hipGetDevice(&dev); hipDeviceGetAttribute(&cus, hipDeviceAttributeMultiprocessorCount, dev);
        hipFuncSetAttribute((const void*)fwd_kernel, hipFuncAttributeMaxDynamicSharedMemorySize, LDS_BYTES);
        hipOccupancyMaxActiveBlocksPerMultiprocessor(&per_cu, (const void*)fwd_kernel, NTHR, LDS_BYTES);
        if (per_cu < 1) { fprintf(stderr, "kernel_launch: occupancy query says %d blocks/CU\n", per_cu); per_cu = 1; }
        grid = cus * per_cu; if (grid > cus) grid = cus;
        (void)hipGetLastError();
    }
    if (grid < 0) return;
    Args a{};
    for (int i = 0; i < 41; ++i) a.in[i] = (const float*)d_in[i];
    a.out = (float*)d_out; a.ws = (unsigned char*)d_ws; a.ph_lo = 0; a.ph_hi = NPHASE;
    void* kargs[] = {&a};
    hipError_t e = hipLaunchCooperativeKernel((const void*)fwd_kernel, dim3(grid), dim3(NTHR), kargs, LDS_BYTES, stream);
    if (e != hipSuccess) fprintf(stderr, "cooperative launch failed: %s (grid %d)\n", hipGetErrorString(e), grid);
}
```
